# Optimizing an MI355X kernel written in HIP

```python
import jax, jax.numpy as jnp
from jax import lax
import numpy as np

D_MODEL = 1024
BATCH = 8
SEQ = 2048
DEPTH = 1

CHUNK = 64
N_META = 16
Q_BLOCK = 128
N_HEADS_A = 8
HEAD_DIM_A = 64
ATTN_WIDTH = N_HEADS_A * HEAD_DIM_A
KV_LATENT = 128
IDX_HEADS = 8
IDX_DIM = 32
TOPK_MAX = 256
ATTN_SCALE = HEAD_DIM_A ** -0.5
IDX_SCALE = (IDX_HEADS ** -0.5) * (IDX_DIM ** -0.5)
POOL_WINDOWS = (2, 4, 8, 16)
POOL_WIDTH = 512
POOL_GROUP = POOL_WIDTH // len(POOL_WINDOWS)
IN_SIZES = (ATTN_WIDTH, KV_LATENT, IDX_HEADS * IDX_DIM, IDX_DIM, IDX_HEADS, POOL_WIDTH, 2 * D_MODEL)
IN_WIDTH = sum(IN_SIZES)
N_GROUPS = 4
EXPERTS_PER_GROUP = 8
TOP_E = 2
EXPERT_HIDDEN = 256
EPS = 1e-6

kernel_name = 'hybrid_dsa_pool_hmoe_stream_block'


def _rmsnorm(x, g):
    xf = x.astype(jnp.float32)
    y = xf * lax.rsqrt(jnp.mean(xf * xf, axis=-1, keepdims=True) + EPS)
    return (y * g.astype(jnp.float32)).astype(x.dtype)


def _chunk_ids(n):
    p = jnp.arange(n, dtype=jnp.int32)
    return jnp.where(p < N_META, 0, 1 + (p - N_META) // CHUNK)


def _sparse_attention(q_abs, iq, iw, c, ik, w_uv, k_top):
    B, T, _ = c.shape
    nb = -(-T // Q_BLOCK)
    pad = nb * Q_BLOCK - T
    key_chunk = _chunk_ids(T)
    q_chunk = _chunk_ids(nb * Q_BLOCK).reshape(nb, Q_BLOCK)

    def to_blocks(a):
        a = jnp.pad(a, [(0, 0), (0, pad)] + [(0, 0)] * (a.ndim - 2))
        return jnp.moveaxis(a.reshape((B, nb, Q_BLOCK) + a.shape[2:]), 1, 0)

    def block(args):
        qa, qi, qw, qc = args
        admissible = key_chunk[None, :] <= qc[:, None]
        rel = jax.nn.relu(jnp.einsum('bqhd,bsd->bqhs', qi, ik))
        score = jnp.einsum('bqhs,bqh->bqs', rel, qw)
        score = jnp.where(admissible[None], score, -jnp.inf)
        _, sel = lax.top_k(score, k_top)
        valid = key_chunk[sel] <= qc[None, :, None]
        c_sel = jax.vmap(lambda cb, ib: cb[ib])(c, sel)
        logits = jnp.einsum('bqhc,bqkc->bqhk', qa, c_sel).astype(jnp.float32) * ATTN_SCALE
        logits = jnp.where(valid[:, :, None, :], logits, -jnp.inf)
        p = jax.nn.softmax(logits, axis=-1).astype(c.dtype)
        o_lat = jnp.einsum('bqhk,bqkc->bqhc', p, c_sel)
        o = jnp.einsum('bqhc,chd->bqhd', o_lat, w_uv)
        return o.reshape(B, Q_BLOCK, ATTN_WIDTH)

    out = lax.map(block, (to_blocks(q_abs), to_blocks(iq), to_blocks(iw), q_chunk))
    return jnp.moveaxis(out, 0, 1).reshape(B, nb * Q_BLOCK, ATTN_WIDTH)[:, :T]


def _multiscale_pool(v, w_pool, pool_scale):
    B, T, _ = v.shape
    G = len(POOL_WINDOWS)
    vg = v.reshape(B, T, G, POOL_GROUP).astype(jnp.float32)
    cs = jnp.concatenate([jnp.zeros((B, 1, G, POOL_GROUP), jnp.float32), jnp.cumsum(vg, axis=1)], axis=1)
    pos = jnp.arange(1, T + 1, dtype=jnp.float32)
    outs = []
    for g, w in enumerate(POOL_WINDOWS):
        csg = cs[:, :, g]
        lower = jnp.concatenate([jnp.zeros((B, w - 1, POOL_GROUP), jnp.float32), csg[:, :T - w + 1]], axis=1)
        mean = (csg[:, 1:] - lower) / jnp.minimum(pos, float(w))[None, :, None]
        outs.append(mean - vg[:, :, g])
    d = jnp.stack(outs, axis=2).astype(v.dtype)
    y = jnp.einsum('btgc,gcd->btgd', d, w_pool).reshape(B, T, POOL_WIDTH)
    return y * pool_scale


def _hier_moe(u, w_gr, b_gr, w_er, b_er, w_gate, w_up, w_down):
    B, T, D = u.shape
    uf = u.reshape(B * T, D)
    g_logits = (uf @ w_gr).astype(jnp.float32) + b_gr.astype(jnp.float32)
    g_probs = jax.nn.softmax(g_logits, axis=-1)
    g_sel = jnp.argmax(g_logits, axis=-1)
    p_g = jnp.take_along_axis(g_probs, g_sel[:, None], axis=1)[:, 0]
    e_logits = jnp.einsum('nd,dge->nge', uf, w_er).astype(jnp.float32) + b_er.astype(jnp.float32)
    e_sel = jnp.take_along_axis(e_logits, g_sel[:, None, None], axis=1)[:, 0]
    top_v, top_i = lax.top_k(e_sel, TOP_E)
    p_e = jax.nn.softmax(top_v, axis=-1)
    within = jnp.sum(jax.nn.one_hot(top_i, EXPERTS_PER_GROUP, dtype=jnp.float32) * p_e[..., None], axis=1)
    gate = (jax.nn.one_hot(g_sel, N_GROUPS, dtype=jnp.float32)[:, :, None]
            * within[:, None, :] * p_g[:, None, None]).astype(u.dtype)
    y = jnp.zeros_like(uf)
    for g in range(N_GROUPS):
        hg = jax.nn.silu(jnp.einsum('nd,edf->nef', uf, w_gate[g])) * jnp.einsum('nd,edf->nef', uf, w_up[g])
        y = y + jnp.einsum('nef,efd->nd', hg * gate[:, g, :, None], w_down[g])
    return y.reshape(B, T, D)


def setup_inputs(seed: int = 0) -> dict:
    key = jax.random.key(seed)
    ks = jax.random.split(key, 21)
    f32 = jnp.float32
    D, L = D_MODEL, DEPTH
    nrm = lambda k, shape, fan: jax.random.normal(k, shape, f32) * (fan ** -0.5)
    gain = lambda k, shape: 1.0 + 0.02 * jax.random.normal(k, shape, f32)
    return {
        'x': jax.random.normal(ks[0], (BATCH, SEQ, D), f32),
        'meta_tokens': jax.random.normal(ks[1], (N_META, D), f32),
        'norm1_g': gain(ks[2], (L, D)),
        'w_in': nrm(ks[3], (L, D, IN_WIDTH), D),
        'kv_norm_g': gain(ks[4], (L, KV_LATENT)),
        'w_uk': nrm(ks[5], (L, KV_LATENT, N_HEADS_A, HEAD_DIM_A), KV_LATENT),
        'w_uv': nrm(ks[6], (L, KV_LATENT, N_HEADS_A, HEAD_DIM_A), KV_LATENT),
        'w_pool': nrm(ks[7], (L, len(POOL_WINDOWS), POOL_GROUP, POOL_GROUP), POOL_GROUP),
        'pool_scale': gain(ks[8], (L, POOL_WIDTH)),
        'w_branch_attn': nrm(ks[9], (L, ATTN_WIDTH, D), ATTN_WIDTH),
        'w_branch_pool': nrm(ks[10], (L, POOL_WIDTH, D), POOL_WIDTH),
        'w_out': nrm(ks[11], (L, D, D), D),
        'norm2_g': gain(ks[12], (L, D)),
        'w_group_router': nrm(ks[13], (L, D, N_GROUPS), D),
        'b_group_router': 0.01 * jax.random.normal(ks[14], (L, N_GROUPS), f32),
        'w_expert_router': nrm(ks[15], (L, D, N_GROUPS, EXPERTS_PER_GROUP), D),
        'b_expert_router': 0.01 * jax.random.normal(ks[16], (L, N_GROUPS, EXPERTS_PER_GROUP), f32),
        'w_expert_gate': nrm(ks[17], (L, N_GROUPS, EXPERTS_PER_GROUP, D, EXPERT_HIDDEN), D),
        'w_expert_up': nrm(ks[18], (L, N_GROUPS, EXPERTS_PER_GROUP, D, EXPERT_HIDDEN), D),
        'w_expert_down': nrm(ks[19], (L, N_GROUPS, EXPERTS_PER_GROUP, EXPERT_HIDDEN, D), EXPERT_HIDDEN),
        'final_norm_g': gain(ks[20], (D,)),
    }


def reference(x, meta_tokens, norm1_g, w_in, kv_norm_g, w_uk, w_uv, w_pool, pool_scale,
              w_branch_attn, w_branch_pool, w_out, norm2_g, w_group_router, b_group_router,
              w_expert_router, b_expert_router, w_expert_gate, w_expert_up, w_expert_down,
              final_norm_g):
    B, S, D = x.shape
    k_top = min(TOPK_MAX, S // 4)
    meta = jnp.broadcast_to(meta_tokens.astype(x.dtype)[None], (B, N_META, D))
    h = jnp.concatenate([meta, x], axis=1)
    T = S + N_META
    split_at = [int(v) for v in np.cumsum(IN_SIZES)[:-1]]
    for l in range(DEPTH):
        u = _rmsnorm(h, norm1_g[l])
        q, c, iq, ik, iw, pv, gates = jnp.split(u @ w_in[l], split_at, axis=-1)
        q = q.reshape(B, T, N_HEADS_A, HEAD_DIM_A)
        c = _rmsnorm(c, kv_norm_g[l])
        q_abs = jnp.einsum('bthd,chd->bthc', q, w_uk[l])
        iq = iq.reshape(B, T, IDX_HEADS, IDX_DIM)
        iw = iw * IDX_SCALE
        attn = _sparse_attention(q_abs, iq, iw, c, ik, w_uv[l], k_top)
        pool = _multiscale_pool(pv, w_pool[l], pool_scale[l])
        g_attn, g_pool = jnp.split(jax.nn.sigmoid(gates), 2, axis=-1)
        merged = g_attn * (attn @ w_branch_attn[l]) + g_pool * (pool @ w_branch_pool[l])
        h = h + merged @ w_out[l]
        h = h + _hier_moe(_rmsnorm(h, norm2_g[l]), w_group_router[l], b_group_router[l],
                          w_expert_router[l], b_expert_router[l], w_expert_gate[l],
                          w_expert_up[l], w_expert_down[l])
    return _rmsnorm(h, final_norm_g)[:, N_META:]
```

```cpp
#include <hip/hip_runtime.h>
#include <stdint.h>
#include <stdio.h>

#ifndef N_LAUNCHES
#define N_LAUNCHES 9
#endif

#define LAS __attribute__((address_space(3)))
typedef unsigned short bf16_t;
typedef short bf16x8 __attribute__((ext_vector_type(8)));
typedef short s16x4 __attribute__((ext_vector_type(4)));
typedef float f32x4 __attribute__((ext_vector_type(4)));
typedef float f32x16 __attribute__((ext_vector_type(16)));
typedef unsigned u32x4 __attribute__((ext_vector_type(4)));
typedef unsigned u32x2 __attribute__((ext_vector_type(2)));

constexpr int NB = 8, SEQ = 2048, TT = 2064, DM = 1024;
constexpr int MALL = NB * TT;
constexpr int MPAD = 16640;
constexpr int NTOK = NB * SEQ;
constexpr int INW = 3496, INP = 3584;
constexpr float EPS = 1e-6f;
constexpr float ATTN_SCALE = 0.125f;
constexpr float IDX_SCALE = 0.0625f;
constexpr float LOG2E = 1.4426950408889634f;
constexpr int NPH = 9;
constexpr int LISTCAP = 16384;
constexpr int YROWS = 40960;

constexpr size_t AL(size_t x) { return (x + 255) & ~(size_t)255; }
constexpr size_t WS_BAR   = 0;
constexpr size_t WS_CNT   = WS_BAR + 16384;
constexpr size_t WS_ZERO_BYTES = 16384 + 256;
constexpr size_t WS_WIN   = AL(WS_CNT + 256);
constexpr size_t WS_WUK   = AL(WS_WIN + (size_t)INP * DM * 2);
constexpr size_t WS_WUV   = AL(WS_WUK + 8 * 128 * 64 * 2);
constexpr size_t WS_WF    = AL(WS_WUV + 8 * 64 * 128 * 2);
constexpr size_t WS_WA    = AL(WS_WF + 1024 * 512 * 2);
constexpr size_t WS_WO    = AL(WS_WA + 1024 * 512 * 2);
constexpr size_t WS_W1    = AL(WS_WO + 1024 * 1024 * 2);
constexpr size_t WS_W2    = AL(WS_W1 + (size_t)32 * 512 * 1024 * 2);
constexpr size_t WS_U     = AL(WS_W2 + (size_t)32 * 1024 * 256 * 2);
constexpr size_t WS_LIST  = AL(WS_U + (size_t)MPAD * DM * 2);
constexpr size_t WS_WTS   = AL(WS_LIST + (size_t)32 * LISTCAP * 4);
constexpr size_t WS_TOKROW= AL(WS_WTS + (size_t)32 * LISTCAP * 4);
constexpr size_t WS_UNION = AL(WS_TOKROW + (size_t)NTOK * 2 * 4);
constexpr size_t WS_Q     = WS_UNION;
constexpr size_t WS_C     = AL(WS_Q + (size_t)MPAD * 512 * 2);
constexpr size_t WS_IQ    = AL(WS_C + (size_t)MPAD * 128 * 2);
constexpr size_t WS_IK    = AL(WS_IQ + (size_t)MPAD * 256 * 2);
constexpr size_t WS_IW    = AL(WS_IK + (size_t)MPAD * 32 * 2);
constexpr size_t WS_PV    = AL(WS_IW + (size_t)MPAD * 8 * 4);
constexpr size_t WS_GATES = AL(WS_PV + (size_t)MPAD * 512 * 2);
constexpr size_t WS_ATTN  = AL(WS_GATES + (size_t)MPAD * 2048 * 2);
constexpr size_t WS_DD    = AL(WS_ATTN + (size_t)NTOK * 512 * 2);
constexpr size_t WS_ENDA  = AL(WS_DD + (size_t)NTOK * 512 * 2);
constexpr size_t WS_HID   = WS_UNION;
constexpr size_t WS_Y     = AL(WS_HID + (size_t)YROWS * 256 * 2);
constexpr size_t WS_ENDB  = AL(WS_Y + (size_t)YROWS * 1024 * 2);
constexpr size_t WS_END   = WS_ENDA > WS_ENDB ? WS_ENDA : WS_ENDB;

constexpr int LDS_BYTES = 156 * 1024;
constexpr int LDS_BARW  = LDS_BYTES - 16;

struct Params {
    const float *x, *meta, *norm1_g, *w_in, *kv_norm_g, *w_uk, *w_uv, *w_pool, *pool_scale, *w_ba, *w_bp, *w_out, *norm2_g,
                *w_gr, *b_gr, *w_er, *b_er, *w_eg, *w_eu, *w_ed, *final_g;
    float* out; unsigned char* ws; int ph_lo, ph_hi;
};

typedef __bf16 bf16v2_t __attribute__((ext_vector_type(2)));
typedef float f32x2 __attribute__((ext_vector_type(2)));
__device__ __forceinline__ unsigned cvt_pk_bf16(float lo, float hi) { const f32x2 v = {lo, hi}; return __builtin_bit_cast(unsigned, __builtin_convertvector(v, bf16v2_t)); }
__device__ __forceinline__ float bf_lo(unsigned u) { return __uint_as_float(u << 16); }
__device__ __forceinline__ float bf_hi(unsigned u) { return __uint_as_float(u & 0xffff0000u); }
__device__ __forceinline__ float wave_sum(float v) {
#pragma unroll
    for (int o = 1; o < 64; o <<= 1) v += __shfl_xor(v, o);
    return v;
}
__device__ __forceinline__ void st4bf(bf16_t* p, f32x4 v) { u32x2 o; o.x = cvt_pk_bf16(v[0], v[1]); o.y = cvt_pk_bf16(v[2], v[3]); *(u32x2*)p = o; }
__device__ __forceinline__ f32x4 mfma16(bf16x8 a, bf16x8 b, f32x4 c) { return __builtin_amdgcn_mfma_f32_16x16x32_bf16(a, b, c, 0, 0, 0); }
__device__ __forceinline__ f32x16 mfma32(bf16x8 a, bf16x8 b, f32x16 c) { return __builtin_amdgcn_mfma_f32_32x32x16_bf16(a, b, c, 0, 0, 0); }

#define XB_TMO      128
#define XB_XCNT(j)  (256  + 64 * (j))
#define XB_XSUB(j)  (1280 + 64 * (j))
#define XB_XGEN(j)  (2304 + 64 * (j))
#define XB_TOP      3328
#define XB_TOPGEN   3392
#define XCD_BAR_WORDS 3456
#define XB_SPIN_CAP (1u << 20)
__device__ __forceinline__ unsigned xb_ld(unsigned* p)              { return __hip_atomic_load(p, __ATOMIC_RELAXED, __HIP_MEMORY_SCOPE_AGENT); }
__device__ __forceinline__ unsigned xb_add(unsigned* p, unsigned v) { return __hip_atomic_fetch_add(p, v, __ATOMIC_RELAXED, __HIP_MEMORY_SCOPE_AGENT); }
__device__ __forceinline__ unsigned xb_xcc_id() { return (unsigned)__builtin_amdgcn_s_getreg((3 << 11) | 20) & 0xFu; }
#define XB_SPIN(cond, bar) do { unsigned _sp = 0; while (cond) { __builtin_amdgcn_s_sleep(1); \
    if ((++_sp & 255u) == 0u) { if (xb_ld(&(bar)[XB_TMO])) break; if (_sp > XB_SPIN_CAP) { atomicAdd(&(bar)[XB_TMO], 1u); break; } } } } while (0)
struct XcdBarrier { unsigned* bar; unsigned x; volatile LAS unsigned* st; };
__device__ __forceinline__ XcdBarrier xcd_barrier_post(unsigned* bar, volatile LAS unsigned* st) {
    XcdBarrier b; b.bar = bar; b.x = xb_xcc_id(); b.st = st;
    if (threadIdx.x == 0) (void)xb_add(&bar[XB_XCNT(b.x)], 1u);
    return b;
}
__device__ __forceinline__ void xcd_barrier_complete(unsigned* bar, unsigned x, unsigned& nloc, unsigned& nx) {
    const unsigned G = gridDim.x * gridDim.y * gridDim.z;
    unsigned sum, cnt, mine, sp = 0u;
    for (;;) {
        sum = 0u; cnt = 0u; mine = 0u;
#pragma unroll
        for (unsigned j = 0; j < 16; ++j) { const unsigned c = xb_ld(&bar[XB_XCNT(j)]); sum += c; cnt += (c > 0u) ? 1u : 0u; mine = (j == x) ? c : mine; }
        if (sum == G) break;
        __builtin_amdgcn_s_sleep(1);
        if ((++sp & 255u) == 0u) { if (xb_ld(&bar[XB_TMO])) break; if (sp > XB_SPIN_CAP) { atomicAdd(&bar[XB_TMO], 1u); break; } }
    }
    nloc = mine > 0u ? mine : 1u; nx = cnt > 0u ? cnt : 1u;
}
__device__ __forceinline__ void xcd_barrier(const XcdBarrier& b) {
    asm volatile("s_waitcnt vmcnt(0)" ::: "memory");
    __syncthreads();
    if (threadIdx.x == 0) {
        unsigned* bar = b.bar;
        __builtin_amdgcn_s_waitcnt(0);
        unsigned nloc = b.st[0], nx = b.st[1];
        if (nloc == 0u) { xcd_barrier_complete(bar, b.x, nloc, nx); b.st[0] = nloc; b.st[1] = nx; }
        const unsigned old = xb_add(&bar[XB_XSUB(b.x)], 1u);
        const unsigned gen = old / nloc;
        if (old + 1u == (gen + 1u) * nloc) {
            __builtin_amdgcn_fence(__ATOMIC_RELEASE, "agent");
            asm volatile("s_waitcnt vmcnt(0)" ::: "memory");
            const unsigned og = xb_add(&bar[XB_TOP], 1u);
            const unsigned tg = og / nx;
            if (og + 1u == (tg + 1u) * nx) xb_add(&bar[XB_TOPGEN], 1u);
            else XB_SPIN(xb_ld(&bar[XB_TOPGEN]) == tg, bar);
            __builtin_amdgcn_fence(__ATOMIC_ACQUIRE, "agent");
            xb_add(&bar[XB_XGEN(b.x)], 1u);
            asm volatile("s_waitcnt vmcnt(0)" ::: "memory");
        } else {
            XB_SPIN(xb_ld(&bar[XB_XGEN(b.x)]) == gen, bar);
            __builtin_amdgcn_fence(__ATOMIC_ACQUIRE, "agent");
            asm volatile("s_waitcnt vmcnt(0)" ::: "memory");
        }
    }
    __syncthreads();
}

struct TJob { const float* src; bf16_t* dst; int src_ld, dst_ld, N, ktiles, ntiles, nbatch; size_t sbs, dbs; };
__device__ __forceinline__ TJob tjob(const Params& p, int j) {
    bf16_t* win = (bf16_t*)(p.ws + WS_WIN); bf16_t* w1 = (bf16_t*)(p.ws + WS_W1);
    TJob J;
    switch (j) {
    case 0:  J = TJob{p.w_in,        win,                 INW, 1024, 936, 16, 15, 1, 0, 0}; break;
    case 1:  J = TJob{p.w_in + 936,  win + 1024 * 1024,   INW, 1024, 512, 16, 8, 1, 0, 0}; break;
    case 2:  J = TJob{p.w_in + 1448, win + 1536 * 1024,   INW, 1024, 2048, 16, 32, 1, 0, 0}; break;
    case 3:  J = TJob{p.w_uv, (bf16_t*)(p.ws + WS_WUV),   512, 128, 64, 2, 1, 8, 64, 64 * 128}; break;
    case 4:  J = TJob{p.w_ba, (bf16_t*)(p.ws + WS_WA),    1024, 512, 1024, 8, 16, 1, 0, 0}; break;
    case 5:  J = TJob{p.w_out, (bf16_t*)(p.ws + WS_WO),   1024, 1024, 1024, 16, 16, 1, 0, 0}; break;
    case 6:  J = TJob{p.w_eg,       w1,                   256, 1024, 128, 16, 2, 32, 262144, 524288}; break;
    case 7:  J = TJob{p.w_eg + 128, w1 + 256 * 1024,      256, 1024, 128, 16, 2, 32, 262144, 524288}; break;
    case 8:  J = TJob{p.w_eu,       w1 + 128 * 1024,      256, 1024, 128, 16, 2, 32, 262144, 524288}; break;
    case 9:  J = TJob{p.w_eu + 128, w1 + 384 * 1024,      256, 1024, 128, 16, 2, 32, 262144, 524288}; break;
    default: J = TJob{p.w_ed, (bf16_t*)(p.ws + WS_W2),    1024, 256, 1024, 4, 16, 32, 262144, 262144}; break;
    }
    return J;
}
constexpr int NTJOBS = 11;
__device__ __forceinline__ int tjob_tiles(int j) {
    constexpr int t[NTJOBS] = {240, 128, 512, 16, 128, 256, 1024, 1024, 1024, 1024, 2048};
    return t[j];
}
constexpr int P0_TILES = 240 + 128 + 512 + 16 + 128 + 256 + 4096 + 2048;
constexpr int P0_WUK = 16, P0_WF = 512, P0_PAD = 11, P0_NORM = MPAD / 8;
constexpr int P0_ITEMS = P0_TILES + P0_WUK + P0_WF + P0_PAD + P0_NORM;

__device__ __forceinline__ void p0_phase(const Params& p, LAS char* lds) {
    const int tid = threadIdx.x, wid = tid >> 6, lane = tid & 63;
    LAS float* tile = (LAS float*)lds;
    for (int it = blockIdx.x; it < P0_ITEMS; it += gridDim.x) {
        int r = it;
        if (r < P0_TILES) {
            int j = 0;
#pragma unroll 1
            for (; j < NTJOBS - 1; ++j) { const int n = tjob_tiles(j); if (r < n) break; r -= n; }
            const TJob J = tjob(p, j);
            const int per = J.ktiles * J.ntiles, bi = r / per, rr = r % per, kt = rr / J.ntiles, nt = rr % J.ntiles;
            const float* src = J.src + (size_t)bi * J.sbs; bf16_t* dst = J.dst + (size_t)bi * J.dbs;
            const int k0 = kt * 64, n0 = nt * 64;
#pragma unroll
            for (int i = 0; i < 2; ++i) {
                const int kk = (tid >> 4) + 32 * i, n4 = (tid & 15) * 4;
                f32x4 v = {0.f, 0.f, 0.f, 0.f};
                if (n0 + n4 < J.N) v = *(const f32x4*)(src + (size_t)(k0 + kk) * J.src_ld + n0 + n4);
                tile[kk * 65 + n4 + 0] = v[0]; tile[kk * 65 + n4 + 1] = v[1]; tile[kk * 65 + n4 + 2] = v[2]; tile[kk * 65 + n4 + 3] = v[3];
            }
            __syncthreads();
            {
                const int n = tid >> 3, kc = tid & 7;
                if (n0 + n < J.N) {
                    const LAS float* s = tile + (kc * 8) * 65 + n;
                    u32x4 o; o.x = cvt_pk_bf16(s[0], s[65]); o.y = cvt_pk_bf16(s[130], s[195]); o.z = cvt_pk_bf16(s[260], s[325]); o.w = cvt_pk_bf16(s[390], s[455]);
                    *(u32x4*)(dst + (size_t)(n0 + n) * J.dst_ld + k0 + kc * 8) = o;
                }
            }
            __syncthreads();
            continue;
        }
        r -= P0_TILES;
        if (r < P0_WUK) {
            const int o = r * 4096 + tid * 8, h = o >> 13, c = (o >> 6) & 127, d = o & 63;
            const float* s = p.w_uk + c * 512 + h * 64 + d;
            const f32x4 a = *(const f32x4*)s, b = *(const f32x4*)(s + 4);
            u32x4 w; w.x = cvt_pk_bf16(a[0], a[1]); w.y = cvt_pk_bf16(a[2], a[3]); w.z = cvt_pk_bf16(b[0], b[1]); w.w = cvt_pk_bf16(b[2], b[3]);
            *(u32x4*)((bf16_t*)(p.ws + WS_WUK) + o) = w;
            continue;
        }
        r -= P0_WUK;
        if (r < P0_WF) {
            const int k = r, g = k >> 7;
            LAS float* coef = (LAS float*)lds;
            if (tid < 128) coef[tid] = p.w_pool[(size_t)k * 128 + tid] * p.pool_scale[g * 128 + tid];
            __syncthreads();
            float a0 = 0.f, a1 = 0.f;
            const float* wb = p.w_bp + (size_t)(g * 128) * 1024 + tid;
#pragma unroll 8
            for (int d = 0; d < 128; ++d) { const float cf = coef[d]; a0 += cf * wb[(size_t)d * 1024]; a1 += cf * wb[(size_t)d * 1024 + 512]; }
            bf16_t* wf = (bf16_t*)(p.ws + WS_WF);
            wf[(size_t)tid * 512 + k] = (bf16_t)(cvt_pk_bf16(a0, 0.f) & 0xffff);
            wf[(size_t)(tid + 512) * 512 + k] = (bf16_t)(cvt_pk_bf16(a1, 0.f) & 0xffff);
            __syncthreads();
            continue;
        }
        r -= P0_WF;
        if (r < P0_PAD) {
            bf16_t* win = (bf16_t*)(p.ws + WS_WIN) + (size_t)(936 + r * 8) * 1024;
            const u32x4 z = {0u, 0u, 0u, 0u};
            *(u32x4*)(win + tid * 8) = z; *(u32x4*)(win + 4096 + tid * 8) = z;
            continue;
        }
        r -= P0_PAD;
        {
            const int R = r * 8 + wid;
            bf16_t* urow = (bf16_t*)(p.ws + WS_U) + (size_t)R * 1024;
            if (R < MALL) {
                const int b = R / TT, t = R - b * TT;
                const float* src = (t < 16) ? (p.meta + (size_t)t * 1024) : (p.x + ((size_t)b * SEQ + (t - 16)) * 1024);
                f32x4 v[4]; float ss = 0.f;
#pragma unroll
                for (int j = 0; j < 4; ++j) { v[j] = *(const f32x4*)(src + j * 256 + lane * 4); ss += v[j][0] * v[j][0] + v[j][1] * v[j][1] + v[j][2] * v[j][2] + v[j][3] * v[j][3]; }
                ss = wave_sum(ss);
                const float rstd = rsqrtf(ss * (1.f / 1024.f) + EPS);
#pragma unroll
                for (int j = 0; j < 4; ++j) { const f32x4 g = *(const f32x4*)(p.norm1_g + j * 256 + lane * 4); st4bf(urow + j * 256 + lane * 4, v[j] * rstd * g); }
            } else {
                const u32x2 z = {0u, 0u};
#pragma unroll
                for (int j = 0; j < 4; ++j) *(u32x2*)(urow + j * 256 + lane * 4) = z;
            }
        }
    }
}

constexpr int G_ROWB = 96, G_AB = 256 * G_ROWB, G_STAGE = 2 * G_AB;
__device__ __forceinline__ void gemm_kloop(f32x4 (&acc)[2][2][4][2], const bf16_t* a0, const bf16_t* a1, const bf16_t* b0, const bf16_t* b1, int nk,
                                           LAS char* lds, int tid, int wr, int wc, int fr, int fq) {
    const int so0 = (tid >> 2) * G_ROWB + (tid & 3) * 16, so1 = so0 + 128 * G_ROWB;
    u32x4 ra0 = *(const u32x4*)a0, ra1 = *(const u32x4*)a1, rb0 = *(const u32x4*)b0, rb1 = *(const u32x4*)b1;
    *(LAS u32x4*)(lds + so0) = ra0; *(LAS u32x4*)(lds + so1) = ra1; *(LAS u32x4*)(lds + G_AB + so0) = rb0; *(LAS u32x4*)(lds + G_AB + so1) = rb1;
    __syncthreads();
    const int aoff = (wr * 64 + fr) * G_ROWB + fq * 16, boff = G_AB + (wc * 32 + fr) * G_ROWB + fq * 16;
#pragma unroll 1
    for (int kt = 0; kt < nk; ++kt) {
        const bool more = kt + 1 < nk;
        if (more) { a0 += 32; a1 += 32; b0 += 32; b1 += 32; ra0 = *(const u32x4*)a0; ra1 = *(const u32x4*)a1; rb0 = *(const u32x4*)b0; rb1 = *(const u32x4*)b1; }
        LAS char* cur = lds + (kt & 1) * G_STAGE;
        bf16x8 af[2][4], bfr[2][2];
#pragma unroll
        for (int ai = 0; ai < 2; ++ai)
#pragma unroll
            for (int m = 0; m < 4; ++m) af[ai][m] = *(LAS bf16x8*)(cur + aoff + (ai * 128 + m * 16) * G_ROWB);
#pragma unroll
        for (int bj = 0; bj < 2; ++bj)
#pragma unroll
            for (int n = 0; n < 2; ++n) bfr[bj][n] = *(LAS bf16x8*)(cur + boff + (bj * 128 + n * 16) * G_ROWB);
#pragma unroll
        for (int ai = 0; ai < 2; ++ai)
#pragma unroll
            for (int bj = 0; bj < 2; ++bj)
#pragma unroll
                for (int m = 0; m < 4; ++m)
#pragma unroll
                    for (int n = 0; n < 2; ++n) acc[ai][bj][m][n] = mfma16(bfr[bj][n], af[ai][m], acc[ai][bj][m][n]);
        if (more) {
            LAS char* nx = lds + ((kt + 1) & 1) * G_STAGE;
            *(LAS u32x4*)(nx + so0) = ra0; *(LAS u32x4*)(nx + so1) = ra1; *(LAS u32x4*)(nx + G_AB + so0) = rb0; *(LAS u32x4*)(nx + G_AB + so1) = rb1;
        }
        __syncthreads();
    }
}
__device__ __forceinline__ void zero_acc(f32x4 (&acc)[2][2][4][2]) {
#pragma unroll
    for (int ai = 0; ai < 2; ++ai)
#pragma unroll
        for (int bj = 0; bj < 2; ++bj)
#pragma unroll
            for (int m = 0; m < 4; ++m)
#pragma unroll
                for (int n = 0; n < 2; ++n) acc[ai][bj][m][n] = (f32x4){0.f, 0.f, 0.f, 0.f};
}
#define FOR_ACC(ai, bj, m, n) \
    _Pragma("unroll") for (int ai = 0; ai < 2; ++ai) _Pragma("unroll") for (int bj = 0; bj < 2; ++bj) \
    _Pragma("unroll") for (int m = 0; m < 4; ++m) _Pragma("unroll") for (int n = 0; n < 2; ++n)

__device__ __forceinline__ void p1_phase(const Params& p, LAS char* lds) {
    const int tid = threadIdx.x, wid = tid >> 6, lane = tid & 63, wr = wid >> 2, wc = wid & 3, fr = lane & 15, fq = lane >> 4;
    const bf16_t* U = (const bf16_t*)(p.ws + WS_U); const bf16_t* W = (const bf16_t*)(p.ws + WS_WIN);
    bf16_t* Q = (bf16_t*)(p.ws + WS_Q); bf16_t* C = (bf16_t*)(p.ws + WS_C); bf16_t* IQ = (bf16_t*)(p.ws + WS_IQ); bf16_t* IK = (bf16_t*)(p.ws + WS_IK);
    float* IW = (float*)(p.ws + WS_IW); bf16_t* PV = (bf16_t*)(p.ws + WS_PV); bf16_t* GT = (bf16_t*)(p.ws + WS_GATES);
    constexpr int NPM = MPAD / 256, NPN = INP / 256;
    for (int u = blockIdx.x; u < NPM * NPN; u += gridDim.x) {
        const int pm = u / NPN, pn = u % NPN;
        f32x4 acc[2][2][4][2]; zero_acc(acc);
        const bf16_t* a0 = U + (size_t)(pm * 256 + (tid >> 2)) * 1024 + (tid & 3) * 8;
        const bf16_t* b0 = W + (size_t)(pn * 256 + (tid >> 2)) * 1024 + (tid & 3) * 8;
        gemm_kloop(acc, a0, a0 + 128 * 1024, b0, b0 + 128 * 1024, 32, lds, tid, wr, wc, fr, fq);
        const int rowb = pm * 256 + wr * 64 + fr, colb = wc * 32 + 4 * fq;
        if (pn < 2) {
            FOR_ACC(ai, bj, m, n) st4bf(Q + (size_t)(rowb + ai * 128 + m * 16) * 512 + pn * 256 + bj * 128 + colb + n * 16, acc[ai][bj][m][n]);
        } else if (pn == 2) {
            LAS float* part = (LAS float*)lds;
#pragma unroll
            for (int ai = 0; ai < 2; ++ai)
#pragma unroll
                for (int m = 0; m < 4; ++m) {
                    float s = 0.f;
#pragma unroll
                    for (int n = 0; n < 2; ++n) { const f32x4 v = acc[ai][0][m][n]; s += v[0] * v[0] + v[1] * v[1] + v[2] * v[2] + v[3] * v[3]; }
                    s += __shfl_xor(s, 16); s += __shfl_xor(s, 32);
                    if (fq == 0) part[(ai * 128 + wr * 64 + m * 16 + fr) * 4 + wc] = s;
                }
            __syncthreads();
#pragma unroll
            for (int ai = 0; ai < 2; ++ai)
#pragma unroll
                for (int m = 0; m < 4; ++m) {
                    const int lr = ai * 128 + wr * 64 + m * 16 + fr;
                    const f32x4 ps = *(LAS f32x4*)(part + lr * 4);
                    const float rstd = rsqrtf((ps[0] + ps[1] + ps[2] + ps[3]) * (1.f / 128.f) + EPS);
                    const size_t R = (size_t)(rowb + ai * 128 + m * 16);
#pragma unroll
                    for (int n = 0; n < 2; ++n) {
                        const f32x4 g = *(const f32x4*)(p.kv_norm_g + colb + n * 16);
                        st4bf(C + R * 128 + colb + n * 16, acc[ai][0][m][n] * rstd * g);
                        st4bf(IQ + R * 256 + colb + n * 16, acc[ai][1][m][n]);
                    }
                }
            __syncthreads();
        } else if (pn == 3) {
#pragma unroll
            for (int ai = 0; ai < 2; ++ai)
#pragma unroll
                for (int m = 0; m < 4; ++m) {
                    const size_t R = (size_t)(rowb + ai * 128 + m * 16);
#pragma unroll
                    for (int n = 0; n < 2; ++n) {
                        st4bf(IQ + R * 256 + 128 + colb + n * 16, acc[ai][0][m][n]);
                        if (wc == 0) st4bf(IK + R * 32 + n * 16 + 4 * fq, acc[ai][1][m][n]);
                        if (wc == 1 && n == 0 && fq < 2) *(f32x4*)(IW + R * 8 + 4 * fq) = acc[ai][1][m][n] * IDX_SCALE;
                    }
                }
        } else if (pn < 6) {
            FOR_ACC(ai, bj, m, n) st4bf(PV + (size_t)(rowb + ai * 128 + m * 16) * 512 + (pn - 4) * 256 + bj * 128 + colb + n * 16, acc[ai][bj][m][n]);
        } else {
            FOR_ACC(ai, bj, m, n) {
                f32x4 v = acc[ai][bj][m][n];
#pragma unroll
                for (int r = 0; r < 4; ++r) v[r] = __builtin_amdgcn_rcpf(1.f + __expf(-v[r]));
                st4bf(GT + (size_t)(rowb + ai * 128 + m * 16) * 2048 + (pn - 6) * 256 + bj * 128 + colb + n * 16, v);
            }
        }
    }
}

constexpr int SC_STRIDE = 2068;
constexpr int SC_BYTES = 16 * SC_STRIDE * 4;
constexpr int MASK_OFF = SC_BYTES;
constexpr int QS_STRIDE = 136;

__device__ __forceinline__ int kv_off(int row, int ch) { return 256 * row + 16 * (ch ^ (((row & 3) << 2) | ((row >> 2) & 3))); }
__device__ __forceinline__ unsigned f2ord(float f) { const unsigned u = __float_as_uint(f); return (u & 0x80000000u) ? ~u : (u | 0x80000000u); }

__device__ __forceinline__ void attn_item(const Params& p, int b, int j, int half, LAS char* lds) {
    int tid_ = threadIdx.x; asm volatile("" : "+v"(tid_));
    const int tid = tid_, wid = __builtin_amdgcn_readfirstlane(tid >> 6), lane = tid & 63, fr = lane & 15, fq = lane >> 4;
    const int nadm = 16 + 64 * j;
    const int t0 = 16 + 64 * (j - 1) + 32 * half;
    const size_t Rq0 = (size_t)b * TT + t0, Rk0 = (size_t)b * TT;
    const bf16_t* Q = (const bf16_t*)(p.ws + WS_Q); const bf16_t* C = (const bf16_t*)(p.ws + WS_C); const bf16_t* IQ = (const bf16_t*)(p.ws + WS_IQ);
    const bf16_t* IK = (const bf16_t*)(p.ws + WS_IK); const float* IW = (const float*)(p.ws + WS_IW);
    LAS unsigned* maskw = (LAS unsigned*)(lds + MASK_OFF);
    const int h = wid;

    {
        const bf16_t* Wuk = (const bf16_t*)(p.ws + WS_WUK) + (size_t)h * 128 * 64;
        bf16x8 bq[2][2];
#pragma unroll
        for (int qt = 0; qt < 2; ++qt)
#pragma unroll
            for (int ks = 0; ks < 2; ++ks) bq[qt][ks] = *(const bf16x8*)(Q + (Rq0 + qt * 16 + fr) * 512 + h * 64 + ks * 32 + fq * 8);
        LAS bf16_t* qs = (LAS bf16_t*)lds + (size_t)h * 32 * QS_STRIDE;
#pragma unroll
        for (int ct = 0; ct < 8; ++ct) {
            const bf16x8 a0 = *(const bf16x8*)(Wuk + (ct * 16 + fr) * 64 + fq * 8), a1 = *(const bf16x8*)(Wuk + (ct * 16 + fr) * 64 + 32 + fq * 8);
#pragma unroll
            for (int qt = 0; qt < 2; ++qt) {
                f32x4 d = {0.f, 0.f, 0.f, 0.f};
                d = mfma16(a0, bq[qt][0], d); d = mfma16(a1, bq[qt][1], d);
                d = d * (ATTN_SCALE * LOG2E);
                u32x2 o; o.x = cvt_pk_bf16(d[0], d[1]); o.y = cvt_pk_bf16(d[2], d[3]);
                *(LAS u32x2*)(qs + (qt * 16 + fr) * QS_STRIDE + ct * 16 + 4 * fq) = o;
            }
        }
    }
    __syncthreads();
    bf16x8 qf[8];
    {
        const LAS bf16_t* qs = (const LAS bf16_t*)lds + (size_t)h * 32 * QS_STRIDE + (lane & 31) * QS_STRIDE + (lane >> 5) * 8;
#pragma unroll
        for (int ks = 0; ks < 8; ++ks) qf[ks] = *(const LAS bf16x8*)(qs + ks * 16);
    }
    __syncthreads();

    if (nadm <= 256) {
        for (int idx = tid; idx < 32 * 66; idx += 512) {
            const int w = idx % 66; const int lo = w * 32;
            unsigned v = 0u;
            if (lo + 32 <= nadm) v = 0xffffffffu; else if (lo < nadm) v = (1u << (nadm - lo)) - 1u;
            maskw[idx] = v;
        }
    } else {
        LAS float* sc = (LAS float*)lds;
        const int nkt = nadm >> 4;
#pragma unroll 1
        for (int sub = 0; sub < 2; ++sub) {
            {
                bf16x8 bq[8]; float wq[8];
                const size_t Rq = Rq0 + sub * 16 + fr;
#pragma unroll
                for (int hh = 0; hh < 8; ++hh) { bq[hh] = *(const bf16x8*)(IQ + Rq * 256 + hh * 32 + fq * 8); }
                { const f32x4 w0 = *(const f32x4*)(IW + Rq * 8), w1 = *(const f32x4*)(IW + Rq * 8 + 4);
                  wq[0] = w0[0]; wq[1] = w0[1]; wq[2] = w0[2]; wq[3] = w0[3]; wq[4] = w1[0]; wq[5] = w1[1]; wq[6] = w1[2]; wq[7] = w1[3]; }
#pragma unroll 1
                for (int kt = wid; kt < nkt; kt += 8) {
                    const bf16x8 a = *(const bf16x8*)(IK + (Rk0 + kt * 16 + fr) * 32 + fq * 8);
                    f32x4 s = {0.f, 0.f, 0.f, 0.f};
#pragma unroll
                    for (int hh = 0; hh < 8; ++hh) {
                        f32x4 d = {0.f, 0.f, 0.f, 0.f};
                        d = mfma16(a, bq[hh], d);
#pragma unroll
                        for (int r = 0; r < 4; ++r) s[r] += fmaxf(d[r], 0.f) * wq[hh];
                    }
                    *(LAS f32x4*)(sc + fr * SC_STRIDE + kt * 16 + 4 * fq) = s;
                }
            }
            __syncthreads();
#pragma unroll 1
            for (int qq = 0; qq < 2; ++qq) {
                const int ql = 2 * wid + qq;
                unsigned key[33];
#pragma unroll
                for (int i = 0; i < 33; ++i) { const int k = lane + 64 * i; const unsigned o = f2ord(sc[ql * SC_STRIDE + k]); key[i] = (k < nadm) ? o : 0u; }
                unsigned prefix = 0u; bool exact = false;
#pragma unroll 1
                for (int bit = 31; bit >= 0; --bit) {
                    const unsigned cand = prefix | (1u << bit);
                    int c = 0;
#pragma unroll
                    for (int i = 0; i < 33; ++i) c += __popcll(__ballot(key[i] >= cand));
                    if (c >= 256) prefix = cand;
                    if (c == 256) { exact = true; break; }
                }
                int need = 0;
                if (!exact) {
                    int cg = 0;
#pragma unroll
                    for (int i = 0; i < 33; ++i) cg += __popcll(__ballot(key[i] > prefix));
                    need = 256 - cg;
                }
                int running = 0;
                const unsigned long long lt = (1ull << lane) - 1ull;
#pragma unroll
                for (int i = 0; i < 33; ++i) {
                    bool sel;
                    if (exact) sel = key[i] >= prefix;
                    else {
                        const bool eq = key[i] == prefix;
                        const unsigned long long be = __ballot(eq);
                        const int rank = running + __popcll(be & lt);
                        sel = (key[i] > prefix) || (eq && rank < need);
                        running += __popcll(be);
                    }
                    const unsigned long long bs = __ballot(sel);
                    if (lane == 0) { maskw[(sub * 16 + ql) * 66 + 2 * i] = (unsigned)bs; maskw[(sub * 16 + ql) * 66 + 2 * i + 1] = (unsigned)(bs >> 32); }
                }
            }
            __syncthreads();
        }
    }
    __syncthreads();

    const int ntile = (nadm + 31) >> 5;
    f32x16 O[4];
#pragma unroll
    for (int mt = 0; mt < 4; ++mt)
#pragma unroll
        for (int r = 0; r < 16; ++r) O[mt][r] = 0.f;
    float mrun = -1e30f, lrun = 0.f;
    {
        const bf16_t* kvsrc = C + (Rk0 + (tid >> 4)) * 128 + (tid & 15) * 8;
        const int kvdst = kv_off(tid >> 4, tid & 15);
        u32x4 rr = *(const u32x4*)kvsrc;
        *(LAS u32x4*)(lds + kvdst) = rr;
        __syncthreads();
        const int hq = lane >> 5, ql = lane & 31;
        const int tg = lane >> 4, ti = lane & 15, tq = ti >> 2, tp = ti & 3;
#pragma unroll 1
        for (int T = 0; T < ntile; ++T) {
            const bool more = T + 1 < ntile;
            if (more) rr = *(const u32x4*)(kvsrc + (size_t)(T + 1) * 32 * 128);
            LAS char* kb = lds + (T & 1) * 8192;
            f32x16 S;
#pragma unroll
            for (int r = 0; r < 16; ++r) S[r] = 0.f;
#pragma unroll
            for (int ks = 0; ks < 8; ++ks) {
                const bf16x8 a = *(LAS bf16x8*)(kb + kv_off(ql, 2 * ks + hq));
                S = mfma32(a, qf[ks], S);
            }
            const unsigned mw = maskw[ql * 66 + T] >> (4 * hq);
            float mx = -INFINITY;
#pragma unroll
            for (int r = 0; r < 16; ++r) {
                const int bit = (r & 3) + 8 * (r >> 2);
                S[r] = ((mw >> bit) & 1u) ? S[r] : -INFINITY;
                mx = fmaxf(mx, S[r]);
            }
            mx = fmaxf(mx, __shfl_xor(mx, 32));
            const float mnew = fmaxf(mrun, mx);
            const float alpha = __builtin_amdgcn_exp2f(mrun - mnew);
            float rs = 0.f;
#pragma unroll
            for (int r = 0; r < 16; ++r) { S[r] = __builtin_amdgcn_exp2f(S[r] - mnew); rs += S[r]; }
            rs += __shfl_xor(rs, 32);
            lrun = lrun * alpha + rs; mrun = mnew;
#pragma unroll
            for (int mt = 0; mt < 4; ++mt)
#pragma unroll
                for (int r = 0; r < 16; ++r) O[mt][r] *= alpha;
            bf16x8 pf[2];
#pragma unroll
            for (int s2 = 0; s2 < 2; ++s2) {
                u32x4 w;
                w.x = cvt_pk_bf16(S[8 * s2 + 0], S[8 * s2 + 1]); w.y = cvt_pk_bf16(S[8 * s2 + 2], S[8 * s2 + 3]);
                w.z = cvt_pk_bf16(S[8 * s2 + 4], S[8 * s2 + 5]); w.w = cvt_pk_bf16(S[8 * s2 + 6], S[8 * s2 + 7]);
                pf[s2] = __builtin_bit_cast(bf16x8, w);
            }
#pragma unroll
            for (int mt = 0; mt < 4; ++mt)
#pragma unroll
                for (int s2 = 0; s2 < 2; ++s2) {
                    const int colb = 32 * mt + 16 * (tg & 1) + 4 * tp;
                    const int row1 = 16 * s2 + 4 * (tg >> 1) + tq;
                    const s16x4 v0 = __builtin_amdgcn_ds_read_tr16_b64_v4i16((LAS s16x4*)(kb + kv_off(row1, colb >> 3) + (colb & 7) * 2));
                    const s16x4 v1 = __builtin_amdgcn_ds_read_tr16_b64_v4i16((LAS s16x4*)(kb + kv_off(row1 + 8, colb >> 3) + (colb & 7) * 2));
                    bf16x8 a; a[0] = v0[0]; a[1] = v0[1]; a[2] = v0[2]; a[3] = v0[3]; a[4] = v1[0]; a[5] = v1[1]; a[6] = v1[2]; a[7] = v1[3];
                    O[mt] = mfma32(a, pf[s2], O[mt]);
                }
            if (more) *(LAS u32x4*)(lds + ((T + 1) & 1) * 8192 + kvdst) = rr;
            __syncthreads();
        }
    }
    {
        const float inv = 1.f / lrun;
        const int hq = lane >> 5, ql = lane & 31;
        LAS bf16_t* os = (LAS bf16_t*)(lds + 16384) + (size_t)h * 32 * QS_STRIDE;
#pragma unroll
        for (int mt = 0; mt < 4; ++mt)
#pragma unroll
            for (int rg = 0; rg < 4; ++rg) {
                u32x2 o; o.x = cvt_pk_bf16(O[mt][4 * rg] * inv, O[mt][4 * rg + 1] * inv); o.y = cvt_pk_bf16(O[mt][4 * rg + 2] * inv, O[mt][4 * rg + 3] * inv);
                *(LAS u32x2*)(os + ql * QS_STRIDE + 32 * mt + 8 * rg + 4 * hq) = o;
            }
        __syncthreads();
        const bf16_t* Wuv = (const bf16_t*)(p.ws + WS_WUV) + (size_t)h * 64 * 128;
        bf16_t* AT = (bf16_t*)(p.ws + WS_ATTN);
        const size_t n0 = (size_t)b * SEQ + (t0 - 16);
        bf16x8 bo[2][4];
#pragma unroll
        for (int qt = 0; qt < 2; ++qt)
#pragma unroll
            for (int ks = 0; ks < 4; ++ks) bo[qt][ks] = *(LAS bf16x8*)(os + (qt * 16 + fr) * QS_STRIDE + ks * 32 + fq * 8);
#pragma unroll
        for (int dt = 0; dt < 4; ++dt) {
            bf16x8 a[4];
#pragma unroll
            for (int ks = 0; ks < 4; ++ks) a[ks] = *(const bf16x8*)(Wuv + (dt * 16 + fr) * 128 + ks * 32 + fq * 8);
#pragma unroll
            for (int qt = 0; qt < 2; ++qt) {
                f32x4 d = {0.f, 0.f, 0.f, 0.f};
#pragma unroll
                for (int ks = 0; ks < 4; ++ks) d = mfma16(a[ks], bo[qt][ks], d);
                st4bf(AT + (n0 + qt * 16 + fr) * 512 + h * 64 + dt * 16 + 4 * fq, d);
            }
        }
    }
    __syncthreads();
}

__device__ __forceinline__ void p2_phase(const Params& p, LAS char* lds) {
    const int tid = threadIdx.x;
    {
        const bf16_t* PV = (const bf16_t*)(p.ws + WS_PV); bf16_t* DD = (bf16_t*)(p.ws + WS_DD);
        for (int rc = blockIdx.x; rc < NTOK / 64; rc += gridDim.x) {
#pragma unroll 1
            for (int it = 0; it < 8; ++it) {
                const int idx = tid + 512 * it, r = idx >> 6, ch8 = idx & 63;
                const int n = rc * 64 + r, b = n >> 11, s = n & 2047;
                const size_t R = (size_t)b * TT + 16 + s;
                const int g = ch8 >> 4, w = 2 << g;
                float a[8];
#pragma unroll
                for (int e = 0; e < 8; ++e) a[e] = 0.f;
                u32x4 self = {0u, 0u, 0u, 0u};
                for (int i = 0; i < w; ++i) {
                    const u32x4 v = *(const u32x4*)(PV + (R - i) * 512 + ch8 * 8);
                    if (i == 0) self = v;
                    a[0] += bf_lo(v.x); a[1] += bf_hi(v.x); a[2] += bf_lo(v.y); a[3] += bf_hi(v.y); a[4] += bf_lo(v.z); a[5] += bf_hi(v.z); a[6] += bf_lo(v.w); a[7] += bf_hi(v.w);
                }
                const float iw = 1.f / (float)w;
                u32x4 o;
                o.x = cvt_pk_bf16(a[0] * iw - bf_lo(self.x), a[1] * iw - bf_hi(self.x)); o.y = cvt_pk_bf16(a[2] * iw - bf_lo(self.y), a[3] * iw - bf_hi(self.y));
                o.z = cvt_pk_bf16(a[4] * iw - bf_lo(self.z), a[5] * iw - bf_hi(self.z)); o.w = cvt_pk_bf16(a[6] * iw - bf_lo(self.w), a[7] * iw - bf_hi(self.w));
                *(u32x4*)(DD + (size_t)n * 512 + ch8 * 8) = o;
            }
        }
    }
    for (int x = blockIdx.x; x < 256; x += gridDim.x) {
        const int b = x & 7, r = x >> 3;
#pragma unroll 1
        for (int rep = 0; rep < 2; ++rep) attn_item(p, b, rep == 0 ? 32 - (r >> 1) : 1 + (r >> 1), r & 1, lds);
    }
}

__device__ __forceinline__ void p3_phase(const Params& p, LAS char* lds) {
    const int tid = threadIdx.x, wid = tid >> 6, lane = tid & 63, wr = wid >> 2, wc = wid & 3, fr = lane & 15, fq = lane >> 4;
    const bf16_t* AT = (const bf16_t*)(p.ws + WS_ATTN); const bf16_t* DD = (const bf16_t*)(p.ws + WS_DD);
    const bf16_t* WA = (const bf16_t*)(p.ws + WS_WA); const bf16_t* WF = (const bf16_t*)(p.ws + WS_WF);
    const bf16_t* GT = (const bf16_t*)(p.ws + WS_GATES); bf16_t* MG = (bf16_t*)(p.ws + WS_U);
    for (int u = blockIdx.x; u < 64 * 4; u += gridDim.x) {
        const int pm = u >> 2, pn = u & 3;
        f32x4 acc[2][2][4][2];
        const int rowb = pm * 256 + wr * 64 + fr, colb = pn * 256 + wc * 32 + 4 * fq;
        {
            zero_acc(acc);
            const bf16_t* a0 = AT + (size_t)(pm * 256 + (tid >> 2)) * 512 + (tid & 3) * 8;
            const bf16_t* b0 = WA + (size_t)(pn * 256 + (tid >> 2)) * 512 + (tid & 3) * 8;
            gemm_kloop(acc, a0, a0 + 128 * 512, b0, b0 + 128 * 512, 16, lds, tid, wr, wc, fr, fq);
            FOR_ACC(ai, bj, m, n) {
                const int nrow = rowb + ai * 128 + m * 16, col = colb + bj * 128 + n * 16;
                const size_t R = (size_t)nrow + 16 + 16 * (nrow >> 11);
                const u32x2 g = *(const u32x2*)(GT + R * 2048 + col);
                f32x4 v = acc[ai][bj][m][n];
                v[0] *= bf_lo(g.x); v[1] *= bf_hi(g.x); v[2] *= bf_lo(g.y); v[3] *= bf_hi(g.y);
                st4bf(MG + (size_t)nrow * 1024 + col, v);
            }
        }
        {
            zero_acc(acc);
            const bf16_t* a0 = DD + (size_t)(pm * 256 + (tid >> 2)) * 512 + (tid & 3) * 8;
            const bf16_t* b0 = WF + (size_t)(pn * 256 + (tid >> 2)) * 512 + (tid & 3) * 8;
            gemm_kloop(acc, a0, a0 + 128 * 512, b0, b0 + 128 * 512, 16, lds, tid, wr, wc, fr, fq);
            FOR_ACC(ai, bj, m, n) {
                const int nrow = rowb + ai * 128 + m * 16, col = colb + bj * 128 + n * 16;
                const size_t R = (size_t)nrow + 16 + 16 * (nrow >> 11);
                const u32x2 g = *(const u32x2*)(GT + R * 2048 + 1024 + col);
                const u32x2 pr = *(const u32x2*)(MG + (size_t)nrow * 1024 + col);
                f32x4 v = acc[ai][bj][m][n];
                v[0] = v[0] * bf_lo(g.x) + bf_lo(pr.x); v[1] = v[1] * bf_hi(g.x) + bf_hi(pr.x); v[2] = v[2] * bf_lo(g.y) + bf_lo(pr.y); v[3] = v[3] * bf_hi(g.y) + bf_hi(pr.y);
                st4bf(MG + (size_t)nrow * 1024 + col, v);
            }
        }
    }
}

__device__ __forceinline__ void p4_phase(const Params& p, LAS char* lds) {
    const int tid = threadIdx.x, wid = tid >> 6, lane = tid & 63, wr = wid >> 2, wc = wid & 3, fr = lane & 15, fq = lane >> 4;
    const bf16_t* MG = (const bf16_t*)(p.ws + WS_U); const bf16_t* WO = (const bf16_t*)(p.ws + WS_WO);
    for (int u = blockIdx.x; u < 64 * 4; u += gridDim.x) {
        const int pm = u >> 2, pn = u & 3;
        f32x4 acc[2][2][4][2]; zero_acc(acc);
        const bf16_t* a0 = MG + (size_t)(pm * 256 + (tid >> 2)) * 1024 + (tid & 3) * 8;
        const bf16_t* b0 = WO + (size_t)(pn * 256 + (tid >> 2)) * 1024 + (tid & 3) * 8;
        gemm_kloop(acc, a0, a0 + 128 * 1024, b0, b0 + 128 * 1024, 32, lds, tid, wr, wc, fr, fq);
        const int rowb = pm * 256 + wr * 64 + fr, colb = pn * 256 + wc * 32 + 4 * fq;
        FOR_ACC(ai, bj, m, n) {
            const size_t off = (size_t)(rowb + ai * 128 + m * 16) * 1024 + colb + bj * 128 + n * 16;
            *(f32x4*)(p.out + off) = *(const f32x4*)(p.x + off) + acc[ai][bj][m][n];
        }
    }
}

__device__ __forceinline__ void p5_phase(const Params& p, LAS char* lds) {
    const int tid = threadIdx.x, wid = tid >> 6, lane = tid & 63;
    LAS float* WL = (LAS float*)lds;
    LAS int* lcnt = (LAS int*)(lds + 147456);
    LAS int* lbase = lcnt + 32;
    LAS int* tk_e = lbase + 32;
    LAS int* tk_r = tk_e + 128;
    LAS float* tk_w = (LAS float*)(tk_r + 128);
#pragma unroll
    for (int i = 0; i < 2; ++i) { const int k = tid + 512 * i; const f32x4 v = *(const f32x4*)(p.w_gr + (size_t)k * 4); WL[k] = v[0]; WL[1024 + k] = v[1]; WL[2048 + k] = v[2]; WL[3072 + k] = v[3]; }
#pragma unroll 1
    for (int i = 0; i < 16; ++i) { const int idx = tid + 512 * i, k = idx >> 3, e4 = (idx & 7) * 4; const f32x4 v = *(const f32x4*)(p.w_er + (size_t)k * 32 + e4);
        WL[(4 + e4) * 1024 + k] = v[0]; WL[(5 + e4) * 1024 + k] = v[1]; WL[(6 + e4) * 1024 + k] = v[2]; WL[(7 + e4) * 1024 + k] = v[3]; }
    bf16_t* U2 = (bf16_t*)(p.ws + WS_U);
    int* cnt = (int*)(p.ws + WS_CNT); int* list = (int*)(p.ws + WS_LIST); float* wts = (float*)(p.ws + WS_WTS); int* tokrow = (int*)(p.ws + WS_TOKROW);
    for (int chunk = blockIdx.x; chunk < NTOK / 64; chunk += gridDim.x) {
        if (tid < 32) lcnt[tid] = 0;
        __syncthreads();
#pragma unroll 1
        for (int i = 0; i < 8; ++i) {
            const int tl = wid + 8 * i, n = chunk * 64 + tl;
            f32x4 v[4]; float ss = 0.f;
#pragma unroll
            for (int j = 0; j < 4; ++j) { v[j] = *(const f32x4*)(p.out + (size_t)n * 1024 + j * 256 + lane * 4); ss += v[j][0] * v[j][0] + v[j][1] * v[j][1] + v[j][2] * v[j][2] + v[j][3] * v[j][3]; }
            ss = wave_sum(ss);
            const float rstd = rsqrtf(ss * (1.f / 1024.f) + EPS);
#pragma unroll
            for (int j = 0; j < 4; ++j) { const f32x4 g = *(const f32x4*)(p.norm2_g + j * 256 + lane * 4); v[j] = v[j] * rstd * g; st4bf(U2 + (size_t)n * 1024 + j * 256 + lane * 4, v[j]); }
            float L[36];
#pragma unroll
            for (int o = 0; o < 36; ++o) {
                float s = 0.f;
#pragma unroll
                for (int j = 0; j < 4; ++j) { const f32x4 w = *(LAS f32x4*)(WL + o * 1024 + j * 256 + lane * 4); s += v[j][0] * w[0] + v[j][1] * w[1] + v[j][2] * w[2] + v[j][3] * w[3]; }
                L[o] = wave_sum(s);
            }
            float gl[4];
#pragma unroll
            for (int g = 0; g < 4; ++g) gl[g] = L[g] + p.b_gr[g];
            int gs = 0; float gm = gl[0];
#pragma unroll
            for (int g = 1; g < 4; ++g) if (gl[g] > gm) { gm = gl[g]; gs = g; }
            float gsum = 0.f;
#pragma unroll
            for (int g = 0; g < 4; ++g) gsum += __expf(gl[g] - gm);
            const float pg = 1.f / gsum;
            float el[8];
#pragma unroll
            for (int e = 0; e < 8; ++e) {
                const float l0 = L[4 + e] + p.b_er[e], l1 = L[12 + e] + p.b_er[8 + e], l2 = L[20 + e] + p.b_er[16 + e], l3 = L[28 + e] + p.b_er[24 + e];
                el[e] = gs == 0 ? l0 : (gs == 1 ? l1 : (gs == 2 ? l2 : l3));
            }
            int i1 = 0; float v1 = el[0];
#pragma unroll
            for (int e = 1; e < 8; ++e) if (el[e] > v1) { v1 = el[e]; i1 = e; }
            int i2 = (i1 == 0) ? 1 : 0; float v2 = -INFINITY;
#pragma unroll
            for (int e = 0; e < 8; ++e) if (e != i1 && el[e] > v2) { v2 = el[e]; i2 = e; }
            const float e2 = __expf(v2 - v1), p1 = 1.f / (1.f + e2), p2 = e2 * p1;
            if (lane == 0) {
                const int ea = gs * 8 + i1, eb = gs * 8 + i2;
                tk_e[tl * 2] = ea; tk_e[tl * 2 + 1] = eb;
                tk_r[tl * 2] = __hip_atomic_fetch_add(&lcnt[ea], 1, __ATOMIC_RELAXED, __HIP_MEMORY_SCOPE_WORKGROUP); tk_r[tl * 2 + 1] = __hip_atomic_fetch_add(&lcnt[eb], 1, __ATOMIC_RELAXED, __HIP_MEMORY_SCOPE_WORKGROUP);
                tk_w[tl * 2] = pg * p1; tk_w[tl * 2 + 1] = pg * p2;
            }
        }
        __syncthreads();
        if (tid < 32) lbase[tid] = atomicAdd(&cnt[tid], lcnt[tid]);
        __syncthreads();
        if (tid < 128) {
            const int e = tk_e[tid], slot = lbase[e] + tk_r[tid], n = chunk * 64 + (tid >> 1);
            list[e * LISTCAP + slot] = n; wts[e * LISTCAP + slot] = tk_w[tid]; tokrow[n * 2 + (tid & 1)] = e * LISTCAP + slot;
        }
        __syncthreads();
    }
}

__device__ __forceinline__ void moe_tables(const Params& p, LAS int* tb) {
    if (threadIdx.x == 0) {
        const int* cnt = (const int*)(p.ws + WS_CNT);
        int acc = 0;
        for (int e = 0; e < 32; ++e) { const int c = __hip_atomic_load(cnt + e, __ATOMIC_RELAXED, __HIP_MEMORY_SCOPE_AGENT); tb[e] = c; tb[32 + e] = acc; acc += (c + 255) >> 8; }
        tb[64] = acc;
    }
    __syncthreads();
}

__device__ __forceinline__ void p6_phase(const Params& p, LAS char* lds) {
    const int tid = threadIdx.x, wid = tid >> 6, lane = tid & 63, wr = wid >> 2, wc = wid & 3, fr = lane & 15, fq = lane >> 4;
    LAS int* tb = (LAS int*)(lds + 2 * G_STAGE);
    moe_tables(p, tb);
    const int ntiles = tb[64];
    const bf16_t* U2 = (const bf16_t*)(p.ws + WS_U); const bf16_t* W1 = (const bf16_t*)(p.ws + WS_W1);
    const int* list = (const int*)(p.ws + WS_LIST); const float* wts = (const float*)(p.ws + WS_WTS); bf16_t* HID = (bf16_t*)(p.ws + WS_HID);
    for (int u = blockIdx.x; u < ntiles * 2; u += gridDim.x) {
        const int ti = u >> 1, pn = u & 1;
        int e = 0;
#pragma unroll 1
        for (int q = 1; q < 32; ++q) if (tb[32 + q] <= ti) e = q;
        const int rt = ti - tb[32 + e], ce = tb[e];
        const int s0 = rt * 256 + (tid >> 2), s1 = s0 + 128;
        const int tok0 = s0 < ce ? list[e * LISTCAP + s0] : 0, tok1 = s1 < ce ? list[e * LISTCAP + s1] : 0;
        f32x4 acc[2][2][4][2]; zero_acc(acc);
        const bf16_t* b0 = W1 + ((size_t)e * 512 + pn * 256 + (tid >> 2)) * 1024 + (tid & 3) * 8;
        gemm_kloop(acc, U2 + (size_t)tok0 * 1024 + (tid & 3) * 8, U2 + (size_t)tok1 * 1024 + (tid & 3) * 8, b0, b0 + 128 * 1024, 32, lds, tid, wr, wc, fr, fq);
        const size_t rowbase = (size_t)(tb[32 + e] + rt) * 256;
#pragma unroll
        for (int ai = 0; ai < 2; ++ai)
#pragma unroll
            for (int m = 0; m < 4; ++m) {
                const int lr = ai * 128 + wr * 64 + m * 16 + fr, slot = rt * 256 + lr;
                const float w = slot < ce ? wts[e * LISTCAP + slot] : 0.f;
#pragma unroll
                for (int n = 0; n < 2; ++n) {
                    const f32x4 g = acc[ai][0][m][n], uu = acc[ai][1][m][n]; f32x4 hv;
#pragma unroll
                    for (int r = 0; r < 4; ++r) hv[r] = g[r] * __builtin_amdgcn_rcpf(1.f + __expf(-g[r])) * uu[r] * w;
                    st4bf(HID + (rowbase + lr) * 256 + pn * 128 + wc * 32 + n * 16 + 4 * fq, hv);
                }
            }
    }
}

__device__ __forceinline__ void p7_phase(const Params& p, LAS char* lds) {
    const int tid = threadIdx.x, wid = tid >> 6, lane = tid & 63, wr = wid >> 2, wc = wid & 3, fr = lane & 15, fq = lane >> 4;
    LAS int* tb = (LAS int*)(lds + 2 * G_STAGE);
    moe_tables(p, tb);
    const int ntiles = tb[64];
    const bf16_t* HID = (const bf16_t*)(p.ws + WS_HID); const bf16_t* W2 = (const bf16_t*)(p.ws + WS_W2); bf16_t* Y = (bf16_t*)(p.ws + WS_Y);
    for (int u = blockIdx.x; u < ntiles * 4; u += gridDim.x) {
        const int ti = u >> 2, pn = u & 3;
        int e = 0;
#pragma unroll 1
        for (int q = 1; q < 32; ++q) if (tb[32 + q] <= ti) e = q;
        f32x4 acc[2][2][4][2]; zero_acc(acc);
        const bf16_t* a0 = HID + ((size_t)ti * 256 + (tid >> 2)) * 256 + (tid & 3) * 8;
        const bf16_t* b0 = W2 + ((size_t)e * 1024 + pn * 256 + (tid >> 2)) * 256 + (tid & 3) * 8;
        gemm_kloop(acc, a0, a0 + 128 * 256, b0, b0 + 128 * 256, 8, lds, tid, wr, wc, fr, fq);
        FOR_ACC(ai, bj, m, n) st4bf(Y + ((size_t)ti * 256 + ai * 128 + wr * 64 + m * 16 + fr) * 1024 + pn * 256 + bj * 128 + wc * 32 + n * 16 + 4 * fq, acc[ai][bj][m][n]);
    }
}

__device__ __forceinline__ void p8_phase(const Params& p, LAS char* lds) {
    const int tid = threadIdx.x, wid = tid >> 6, lane = tid & 63;
    LAS int* tb = (LAS int*)lds;
    moe_tables(p, tb);
    const bf16_t* Y = (const bf16_t*)(p.ws + WS_Y); const int* tokrow = (const int*)(p.ws + WS_TOKROW);
    for (int n = blockIdx.x * 8 + wid; n < NTOK; n += gridDim.x * 8) {
        const int r1 = tokrow[n * 2], r2 = tokrow[n * 2 + 1];
        const size_t y1 = (size_t)tb[32 + (r1 >> 14)] * 256 + (r1 & 16383), y2 = (size_t)tb[32 + (r2 >> 14)] * 256 + (r2 & 16383);
        f32x4 v[4]; float ss = 0.f;
#pragma unroll
        for (int j = 0; j < 4; ++j) {
            v[j] = *(const f32x4*)(p.out + (size_t)n * 1024 + j * 256 + lane * 4);
            const u32x2 a = *(const u32x2*)(Y + y1 * 1024 + j * 256 + lane * 4), c = *(const u32x2*)(Y + y2 * 1024 + j * 256 + lane * 4);
            v[j][0] += bf_lo(a.x) + bf_lo(c.x); v[j][1] += bf_hi(a.x) + bf_hi(c.x); v[j][2] += bf_lo(a.y) + bf_lo(c.y); v[j][3] += bf_hi(a.y) + bf_hi(c.y);
            ss += v[j][0] * v[j][0] + v[j][1] * v[j][1] + v[j][2] * v[j][2] + v[j][3] * v[j][3];
        }
        ss = wave_sum(ss);
        const float rstd = rsqrtf(ss * (1.f / 1024.f) + EPS);
#pragma unroll
        for (int j = 0; j < 4; ++j) { const f32x4 g = *(const f32x4*)(p.final_g + j * 256 + lane * 4); *(f32x4*)(p.out + (size_t)n * 1024 + j * 256 + lane * 4) = v[j] * rstd * g; }
    }
}

__global__ void __launch_bounds__(512, 2) fwd_kernel(Params p) {
    extern __shared__ __attribute__((aligned(16))) unsigned char smem[];
    LAS char* lds = (LAS char*)smem;
    volatile LAS unsigned* barw = (volatile LAS unsigned*)(lds + LDS_BARW);
    if (threadIdx.x < 2) barw[threadIdx.x] = 0u;
    __syncthreads();
    XcdBarrier bar; bar.bar = (unsigned*)(p.ws + WS_BAR); bar.x = 0; bar.st = nullptr;
    if (N_LAUNCHES == 1) bar = xcd_barrier_post((unsigned*)(p.ws + WS_BAR), barw);
    const int lo = p.ph_lo, hi = p.ph_hi;
#define IN(k) (lo <= (k) && (k) < hi)
#define SEAM(k) do { if (IN(k) && IN((k) + 1)) xcd_barrier(bar); } while (0)
#ifndef PH_MASK
#define PH_MASK 0x7ff
#endif
#define HAS(k) ((PH_MASK >> (k)) & 1)
    if (HAS(0) && IN(0)) { p0_phase(p, lds); } SEAM(0);
    if (HAS(1) && IN(1)) { p1_phase(p, lds); } SEAM(1);
    if (HAS(2) && IN(2)) { p2_phase(p, lds); } SEAM(2);
    if (HAS(3) && IN(3)) { p3_phase(p, lds); } SEAM(3);
    if (HAS(4) && IN(4)) { p4_phase(p, lds); } SEAM(4);
    if (HAS(5) && IN(5)) { p5_phase(p, lds); } SEAM(5);
    if (HAS(6) && IN(6)) { p6_phase(p, lds); } SEAM(6);
    if (HAS(7) && IN(7)) { p7_phase(p, lds); } SEAM(7);
    if (HAS(8) && IN(8)) { p8_phase(p, lds); }
}

extern "C" void kernel_launch(void* const* d_in, const int* in_sizes, int n_in, void* d_out, int out_size, void* d_ws, size_t ws_size, hipStream_t stream) {
    static int grid = 0;
    if (grid == 0) {
        if (n_in != 21 || ws_size < WS_END) { fprintf(stderr, "kernel_launch: unexpected n_in %d or ws_size %zu (< %zu)\n", n_in, ws_size, (size_t)WS_END); grid = -1; return; }
        int dev = 0, cus = 0;
        if (hipGetDevice(&dev) != hipSuccess || hipDeviceGetAttribute(&cus, hipDeviceAttributeMultiprocessorCount, dev) != hipSuccess) { grid = -1; return; }
        if (hipFuncSetAttribute((const void*)fwd_kernel, hipFuncAttributeMaxDynamicSharedMemorySize, LDS_BYTES) != hipSuccess) { fprintf(stderr, "kernel_launch: hipFuncSetAttribute failed\n"); grid = -1; return; }
        grid = cus;
    }
    if (grid < 0) return;
    (void)hipMemsetAsync((char*)d_ws + WS_BAR, 0, WS_ZERO_BYTES, stream);
    Params p{};
    const float** f = (const float**)&p;
    for (int i = 0; i < 21; ++i) f[i] = (const float*)d_in[i];
    p.out = (float*)d_out; p.ws = (unsigned char*)d_ws;
    if (N_LAUNCHES == 1) { p.ph_lo = 0; p.ph_hi = NPH; hipLaunchKernelGGL(fwd_kernel, dim3(grid), dim3(512), LDS_BYTES, stream, p); }
    else for (int k = 0; k < NPH; ++k) { p.ph_lo = k; p.ph_hi = k + 1; hipLaunchKernelGGL(fwd_kernel, dim3(grid), dim3(512), LDS_BYTES, stream, p); }
}
```

```cpp
#include <hip/hip_runtime.h>
#include <stdint.h>
#include <stdio.h>

#ifndef N_LAUNCHES
#define N_LAUNCHES 1
#endif

#define LAS __attribute__((address_space(3)))
typedef unsigned short bf16_t;
typedef short bf16x8 __attribute__((ext_vector_type(8)));
typedef short s16x4 __attribute__((ext_vector_type(4)));
typedef float f32x4 __attribute__((ext_vector_type(4)));
typedef float f32x16 __attribute__((ext_vector_type(16)));
typedef unsigned u32x4 __attribute__((ext_vector_type(4)));
typedef unsigned u32x2 __attribute__((ext_vector_type(2)));

constexpr int NB = 8, SEQ = 2048, TT = 2064, DM = 1024;
constexpr int MALL = NB * TT;
constexpr int MPAD = 16640;
constexpr int NTOK = NB * SEQ;
constexpr int INW = 3496, INP = 3584;
constexpr float EPS = 1e-6f;
constexpr float ATTN_SCALE = 0.125f;
constexpr float IDX_SCALE = 0.0625f;
constexpr float LOG2E = 1.4426950408889634f;
constexpr int NPH = 9;
constexpr int LISTCAP = 16384;
constexpr int YROWS = 40960;

constexpr size_t AL(size_t x) { return (x + 255) & ~(size_t)255; }
constexpr size_t WS_BAR   = 0;
constexpr size_t WS_CNT   = WS_BAR + 16384;
constexpr size_t WS_ZERO_BYTES = 16384 + 256;
constexpr size_t WS_WIN   = AL(WS_CNT + 256);
constexpr size_t WS_WUK   = AL(WS_WIN + (size_t)INP * DM * 2);
constexpr size_t WS_WUV   = AL(WS_WUK + 8 * 128 * 64 * 2);
constexpr size_t WS_WF    = AL(WS_WUV + 8 * 64 * 128 * 2);
constexpr size_t WS_WA    = AL(WS_WF + 1024 * 512 * 2);
constexpr size_t WS_WO    = AL(WS_WA + 1024 * 512 * 2);
constexpr size_t WS_W1    = AL(WS_WO + 1024 * 1024 * 2);
constexpr size_t WS_W2    = AL(WS_W1 + (size_t)32 * 512 * 1024 * 2);
constexpr size_t WS_U     = AL(WS_W2 + (size_t)32 * 1024 * 256 * 2);
constexpr size_t WS_LIST  = AL(WS_U + (size_t)MPAD * DM * 2);
constexpr size_t WS_WTS   = AL(WS_LIST + (size_t)32 * LISTCAP * 4);
constexpr size_t WS_TOKROW= AL(WS_WTS + (size_t)32 * LISTCAP * 4);
constexpr size_t WS_UNION = AL(WS_TOKROW + (size_t)NTOK * 2 * 4);
constexpr size_t WS_Q     = WS_UNION;
constexpr size_t WS_C     = AL(WS_Q + (size_t)MPAD * 512 * 2);
constexpr size_t WS_IQ    = AL(WS_C + (size_t)MPAD * 128 * 2);
constexpr size_t WS_IK    = AL(WS_IQ + (size_t)MPAD * 256 * 2);
constexpr size_t WS_IW    = AL(WS_IK + (size_t)MPAD * 32 * 2);
constexpr size_t WS_PV    = AL(WS_IW + (size_t)MPAD * 8 * 4);
constexpr size_t WS_GATES = AL(WS_PV + (size_t)MPAD * 512 * 2);
constexpr size_t WS_ATTN  = AL(WS_GATES + (size_t)MPAD * 2048 * 2);
constexpr size_t WS_DD    = AL(WS_ATTN + (size_t)NTOK * 512 * 2);
constexpr size_t WS_ENDA  = AL(WS_DD + (size_t)NTOK * 512 * 2);
constexpr size_t WS_HID   = WS_UNION;
constexpr size_t WS_Y     = AL(WS_HID + (size_t)YROWS * 256 * 2);
constexpr size_t WS_ENDB  = AL(WS_Y + (size_t)YROWS * 1024 * 2);
constexpr size_t WS_END   = WS_ENDA > WS_ENDB ? WS_ENDA : WS_ENDB;

constexpr int LDS_BYTES = 156 * 1024;
constexpr int LDS_BARW  = LDS_BYTES - 16;

struct Params {
    const float *x, *meta, *norm1_g, *w_in, *kv_norm_g, *w_uk, *w_uv, *w_pool, *pool_scale, *w_ba, *w_bp, *w_out, *norm2_g,
                *w_gr, *b_gr, *w_er, *b_er, *w_eg, *w_eu, *w_ed, *final_g;
    float* out; unsigned char* ws; int ph_lo, ph_hi;
};

typedef __bf16 bf16v2_t __attribute__((ext_vector_type(2)));
typedef float f32x2 __attribute__((ext_vector_type(2)));
__device__ __forceinline__ unsigned cvt_pk_bf16(float lo, float hi) { const f32x2 v = {lo, hi}; return __builtin_bit_cast(unsigned, __builtin_convertvector(v, bf16v2_t)); }
__device__ __forceinline__ float bf_lo(unsigned u) { return __uint_as_float(u << 16); }
__device__ __forceinline__ float bf_hi(unsigned u) { return __uint_as_float(u & 0xffff0000u); }
__device__ __forceinline__ float wave_sum(float v) {
#pragma unroll
    for (int o = 1; o < 64; o <<= 1) v += __shfl_xor(v, o);
    return v;
}
__device__ __forceinline__ void st4bf(bf16_t* p, f32x4 v) { u32x2 o; o.x = cvt_pk_bf16(v[0], v[1]); o.y = cvt_pk_bf16(v[2], v[3]); *(u32x2*)p = o; }
__device__ __forceinline__ f32x4 mfma16(bf16x8 a, bf16x8 b, f32x4 c) { return __builtin_amdgcn_mfma_f32_16x16x32_bf16(a, b, c, 0, 0, 0); }
__device__ __forceinline__ f32x16 mfma32(bf16x8 a, bf16x8 b, f32x16 c) { return __builtin_amdgcn_mfma_f32_32x32x16_bf16(a, b, c, 0, 0, 0); }

#define XB_TMO      128
#define XB_XCNT(j)  (256  + 64 * (j))
#define XB_XSUB(j)  (1280 + 64 * (j))
#define XB_XGEN(j)  (2304 + 64 * (j))
#define XB_TOP      3328
#define XB_TOPGEN   3392
#define XCD_BAR_WORDS 3456
#define XB_SPIN_CAP (1u << 20)
__device__ __forceinline__ unsigned xb_ld(unsigned* p)              { return __hip_atomic_load(p, __ATOMIC_RELAXED, __HIP_MEMORY_SCOPE_AGENT); }
__device__ __forceinline__ unsigned xb_add(unsigned* p, unsigned v) { return __hip_atomic_fetch_add(p, v, __ATOMIC_RELAXED, __HIP_MEMORY_SCOPE_AGENT); }
__device__ __forceinline__ unsigned xb_xcc_id() { return (unsigned)__builtin_amdgcn_s_getreg((3 << 11) | 20) & 0xFu; }
#define XB_SPIN(cond, bar) do { unsigned _sp = 0; while (cond) { __builtin_amdgcn_s_sleep(1); \
    if ((++_sp & 255u) == 0u) { if (xb_ld(&(bar)[XB_TMO])) break; if (_sp > XB_SPIN_CAP) { atomicAdd(&(bar)[XB_TMO], 1u); break; } } } } while (0)
struct XcdBarrier { unsigned* bar; unsigned x; volatile LAS unsigned* st; };
__device__ __forceinline__ XcdBarrier xcd_barrier_post(unsigned* bar, volatile LAS unsigned* st) {
    XcdBarrier b; b.bar = bar; b.x = xb_xcc_id(); b.st = st;
    if (threadIdx.x == 0) (void)xb_add(&bar[XB_XCNT(b.x)], 1u);
    return b;
}
__device__ __forceinline__ void xcd_barrier_complete(unsigned* bar, unsigned x, unsigned& nloc, unsigned& nx) {
    const unsigned G = gridDim.x * gridDim.y * gridDim.z;
    unsigned sum, cnt, mine, sp = 0u;
    for (;;) {
        sum = 0u; cnt = 0u; mine = 0u;
#pragma unroll
        for (unsigned j = 0; j < 16; ++j) { const unsigned c = xb_ld(&bar[XB_XCNT(j)]); sum += c; cnt += (c > 0u) ? 1u : 0u; mine = (j == x) ? c : mine; }
        if (sum == G) break;
        __builtin_amdgcn_s_sleep(1);
        if ((++sp & 255u) == 0u) { if (xb_ld(&bar[XB_TMO])) break; if (sp > XB_SPIN_CAP) { atomicAdd(&bar[XB_TMO], 1u); break; } }
    }
    nloc = mine > 0u ? mine : 1u; nx = cnt > 0u ? cnt : 1u;
}
__device__ __forceinline__ void xcd_barrier(const XcdBarrier& b) {
    asm volatile("s_waitcnt vmcnt(0)" ::: "memory");
    __syncthreads();
    if (threadIdx.x == 0) {
        unsigned* bar = b.bar;
        __builtin_amdgcn_s_waitcnt(0);
        unsigned nloc = b.st[0], nx = b.st[1];
        if (nloc == 0u) { xcd_barrier_complete(bar, b.x, nloc, nx); b.st[0] = nloc; b.st[1] = nx; }
        const unsigned old = xb_add(&bar[XB_XSUB(b.x)], 1u);
        const unsigned gen = old / nloc;
        if (old + 1u == (gen + 1u) * nloc) {
            __builtin_amdgcn_fence(__ATOMIC_RELEASE, "agent");
            asm volatile("s_waitcnt vmcnt(0)" ::: "memory");
            const unsigned og = xb_add(&bar[XB_TOP], 1u);
            const unsigned tg = og / nx;
            if (og + 1u == (tg + 1u) * nx) xb_add(&bar[XB_TOPGEN], 1u);
            else XB_SPIN(xb_ld(&bar[XB_TOPGEN]) == tg, bar);
            __builtin_amdgcn_fence(__ATOMIC_ACQUIRE, "agent");
            xb_add(&bar[XB_XGEN(b.x)], 1u);
            asm volatile("s_waitcnt vmcnt(0)" ::: "memory");
        } else {
            XB_SPIN(xb_ld(&bar[XB_XGEN(b.x)]) == gen, bar);
            __builtin_amdgcn_fence(__ATOMIC_ACQUIRE, "agent");
            asm volatile("s_waitcnt vmcnt(0)" ::: "memory");
        }
    }
    __syncthreads();
}

struct TJob { const float* src; bf16_t* dst; int src_ld, dst_ld, N, ktiles, ntiles, nbatch; size_t sbs, dbs; };
__device__ __forceinline__ TJob tjob(const Params& p, int j) {
    bf16_t* win = (bf16_t*)(p.ws + WS_WIN); bf16_t* w1 = (bf16_t*)(p.ws + WS_W1);
    TJob J;
    switch (j) {
    case 0:  J = TJob{p.w_in,        win,                 INW, 1024, 936, 16, 15, 1, 0, 0}; break;
    case 1:  J = TJob{p.w_in + 936,  win + 1024 * 1024,   INW, 1024, 512, 16, 8, 1, 0, 0}; break;
    case 2:  J = TJob{p.w_in + 1448, win + 1536 * 1024,   INW, 1024, 2048, 16, 32, 1, 0, 0}; break;
    case 3:  J = TJob{p.w_uv, (bf16_t*)(p.ws + WS_WUV),   512, 128, 64, 2, 1, 8, 64, 64 * 128}; break;
    case 4:  J = TJob{p.w_ba, (bf16_t*)(p.ws + WS_WA),    1024, 512, 1024, 8, 16, 1, 0, 0}; break;
    case 5:  J = TJob{p.w_out, (bf16_t*)(p.ws + WS_WO),   1024, 1024, 1024, 16, 16, 1, 0, 0}; break;
    case 6:  J = TJob{p.w_eg,       w1,                   256, 1024, 128, 16, 2, 32, 262144, 524288}; break;
    case 7:  J = TJob{p.w_eg + 128, w1 + 256 * 1024,      256, 1024, 128, 16, 2, 32, 262144, 524288}; break;
    case 8:  J = TJob{p.w_eu,       w1 + 128 * 1024,      256, 1024, 128, 16, 2, 32, 262144, 524288}; break;
    case 9:  J = TJob{p.w_eu + 128, w1 + 384 * 1024,      256, 1024, 128, 16, 2, 32, 262144, 524288}; break;
    default: J = TJob{p.w_ed, (bf16_t*)(p.ws + WS_W2),    1024, 256, 1024, 4, 16, 32, 262144, 262144}; break;
    }
    return J;
}
constexpr int NTJOBS = 11;
__device__ __forceinline__ int tjob_tiles(int j) {
    constexpr int t[NTJOBS] = {240, 128, 512, 16, 128, 256, 1024, 1024, 1024, 1024, 2048};
    return t[j];
}
constexpr int P0_TILES = 240 + 128 + 512 + 16 + 128 + 256 + 4096 + 2048;
constexpr int P0_WUK = 16, P0_WF = 512, P0_PAD = 11, P0_NORM = MPAD / 8;
constexpr int P0_ITEMS = P0_TILES + P0_WUK + P0_WF + P0_PAD + P0_NORM;

__device__ __forceinline__ void p0_phase(const Params& p, LAS char* lds) {
    const int tid = threadIdx.x, wid = tid >> 6, lane = tid & 63;
    LAS float* tile = (LAS float*)lds;
    for (int it = blockIdx.x; it < P0_ITEMS; it += gridDim.x) {
        int r = it;
        if (r < P0_TILES) {
            int j = 0;
#pragma unroll 1
            for (; j < NTJOBS - 1; ++j) { const int n = tjob_tiles(j); if (r < n) break; r -= n; }
            const TJob J = tjob(p, j);
            const int per = J.ktiles * J.ntiles, bi = r / per, rr = r % per, kt = rr / J.ntiles, nt = rr % J.ntiles;
            const float* src = J.src + (size_t)bi * J.sbs; bf16_t* dst = J.dst + (size_t)bi * J.dbs;
            const int k0 = kt * 64, n0 = nt * 64;
#pragma unroll
            for (int i = 0; i < 2; ++i) {
                const int kk = (tid >> 4) + 32 * i, n4 = (tid & 15) * 4;
                f32x4 v = {0.f, 0.f, 0.f, 0.f};
                if (n0 + n4 < J.N) v = *(const f32x4*)(src + (size_t)(k0 + kk) * J.src_ld + n0 + n4);
                tile[kk * 65 + n4 + 0] = v[0]; tile[kk * 65 + n4 + 1] = v[1]; tile[kk * 65 + n4 + 2] = v[2]; tile[kk * 65 + n4 + 3] = v[3];
            }
            __syncthreads();
            {
                const int n = tid >> 3, kc = tid & 7;
                if (n0 + n < J.N) {
                    const LAS float* s = tile + (kc * 8) * 65 + n;
                    u32x4 o; o.x = cvt_pk_bf16(s[0], s[65]); o.y = cvt_pk_bf16(s[130], s[195]); o.z = cvt_pk_bf16(s[260], s[325]); o.w = cvt_pk_bf16(s[390], s[455]);
                    *(u32x4*)(dst + (size_t)(n0 + n) * J.dst_ld + k0 + kc * 8) = o;
                }
            }
            __syncthreads();
            continue;
        }
        r -= P0_TILES;
        if (r < P0_WUK) {
            const int o = r * 4096 + tid * 8, h = o >> 13, c = (o >> 6) & 127, d = o & 63;
            const float* s = p.w_uk + c * 512 + h * 64 + d;
            const f32x4 a = *(const f32x4*)s, b = *(const f32x4*)(s + 4);
            u32x4 w; w.x = cvt_pk_bf16(a[0], a[1]); w.y = cvt_pk_bf16(a[2], a[3]); w.z = cvt_pk_bf16(b[0], b[1]); w.w = cvt_pk_bf16(b[2], b[3]);
            *(u32x4*)((bf16_t*)(p.ws + WS_WUK) + o) = w;
            continue;
        }
        r -= P0_WUK;
        if (r < P0_WF) {
            const int k = r, g = k >> 7;
            LAS float* coef = (LAS float*)lds;
            if (tid < 128) coef[tid] = p.w_pool[(size_t)k * 128 + tid] * p.pool_scale[g * 128 + tid];
            __syncthreads();
            float a0 = 0.f, a1 = 0.f;
            const float* wb = p.w_bp + (size_t)(g * 128) * 1024 + tid;
#pragma unroll 8
            for (int d = 0; d < 128; ++d) { const float cf = coef[d]; a0 += cf * wb[(size_t)d * 1024]; a1 += cf * wb[(size_t)d * 1024 + 512]; }
            bf16_t* wf = (bf16_t*)(p.ws + WS_WF);
            wf[(size_t)tid * 512 + k] = (bf16_t)(cvt_pk_bf16(a0, 0.f) & 0xffff);
            wf[(size_t)(tid + 512) * 512 + k] = (bf16_t)(cvt_pk_bf16(a1, 0.f) & 0xffff);
            __syncthreads();
            continue;
        }
        r -= P0_WF;
        if (r < P0_PAD) {
            bf16_t* win = (bf16_t*)(p.ws + WS_WIN) + (size_t)(936 + r * 8) * 1024;
            const u32x4 z = {0u, 0u, 0u, 0u};
            *(u32x4*)(win + tid * 8) = z; *(u32x4*)(win + 4096 + tid * 8) = z;
            continue;
        }
        r -= P0_PAD;
        {
            const int R = r * 8 + wid;
            bf16_t* urow = (bf16_t*)(p.ws + WS_U) + (size_t)R * 1024;
            if (R < MALL) {
                const int b = R / TT, t = R - b * TT;
                const float* src = (t < 16) ? (p.meta + (size_t)t * 1024) : (p.x + ((size_t)b * SEQ + (t - 16)) * 1024);
                f32x4 v[4]; float ss = 0.f;
#pragma unroll
                for (int j = 0; j < 4; ++j) { v[j] = *(const f32x4*)(src + j * 256 + lane * 4); ss += v[j][0] * v[j][0] + v[j][1] * v[j][1] + v[j][2] * v[j][2] + v[j][3] * v[j][3]; }
                ss = wave_sum(ss);
                const float rstd = rsqrtf(ss * (1.f / 1024.f) + EPS);
#pragma unroll
                for (int j = 0; j < 4; ++j) { const f32x4 g = *(const f32x4*)(p.norm1_g + j * 256 + lane * 4); st4bf(urow + j * 256 + lane * 4, v[j] * rstd * g); }
            } else {
                const u32x2 z = {0u, 0u};
#pragma unroll
                for (int j = 0; j < 4; ++j) *(u32x2*)(urow + j * 256 + lane * 4) = z;
            }
        }
    }
}

constexpr int G_ROWB = 96, G_AB = 256 * G_ROWB, G_STAGE = 2 * G_AB;
__device__ __forceinline__ void gemm_kloop(f32x4 (&acc)[2][2][4][2], const bf16_t* a0, const bf16_t* a1, const bf16_t* b0, const bf16_t* b1, int nk,
                                           LAS char* lds, int tid, int wr, int wc, int fr, int fq) {
    const int so0 = (tid >> 2) * G_ROWB + (tid & 3) * 16, so1 = so0 + 128 * G_ROWB;
    u32x4 ra0 = *(const u32x4*)a0, ra1 = *(const u32x4*)a1, rb0 = *(const u32x4*)b0, rb1 = *(const u32x4*)b1;
    *(LAS u32x4*)(lds + so0) = ra0; *(LAS u32x4*)(lds + so1) = ra1; *(LAS u32x4*)(lds + G_AB + so0) = rb0; *(LAS u32x4*)(lds + G_AB + so1) = rb1;
    __syncthreads();
    const int aoff = (wr * 64 + fr) * G_ROWB + fq * 16, boff = G_AB + (wc * 32 + fr) * G_ROWB + fq * 16;
#pragma unroll 1
    for (int kt = 0; kt < nk; ++kt) {
        const bool more = kt + 1 < nk;
        if (more) { a0 += 32; a1 += 32; b0 += 32; b1 += 32; ra0 = *(const u32x4*)a0; ra1 = *(const u32x4*)a1; rb0 = *(const u32x4*)b0; rb1 = *(const u32x4*)b1; }
        LAS char* cur = lds + (kt & 1) * G_STAGE;
        bf16x8 af[2][4], bfr[2][2];
#pragma unroll
        for (int ai = 0; ai < 2; ++ai)
#pragma unroll
            for (int m = 0; m < 4; ++m) af[ai][m] = *(LAS bf16x8*)(cur + aoff + (ai * 128 + m * 16) * G_ROWB);
#pragma unroll
        for (int bj = 0; bj < 2; ++bj)
#pragma unroll
            for (int n = 0; n < 2; ++n) bfr[bj][n] = *(LAS bf16x8*)(cur + boff + (bj * 128 + n * 16) * G_ROWB);
#pragma unroll
        for (int ai = 0; ai < 2; ++ai)
#pragma unroll
            for (int bj = 0; bj < 2; ++bj)
#pragma unroll
                for (int m = 0; m < 4; ++m)
#pragma unroll
                    for (int n = 0; n < 2; ++n) acc[ai][bj][m][n] = mfma16(bfr[bj][n], af[ai][m], acc[ai][bj][m][n]);
        if (more) {
            LAS char* nx = lds + ((kt + 1) & 1) * G_STAGE;
            *(LAS u32x4*)(nx + so0) = ra0; *(LAS u32x4*)(nx + so1) = ra1; *(LAS u32x4*)(nx + G_AB + so0) = rb0; *(LAS u32x4*)(nx + G_AB + so1) = rb1;
        }
        __syncthreads();
    }
}
__device__ __forceinline__ void zero_acc(f32x4 (&acc)[2][2][4][2]) {
#pragma unroll
    for (int ai = 0; ai < 2; ++ai)
#pragma unroll
        for (int bj = 0; bj < 2; ++bj)
#pragma unroll
            for (int m = 0; m < 4; ++m)
#pragma unroll
                for (int n = 0; n < 2; ++n) acc[ai][bj][m][n] = (f32x4){0.f, 0.f, 0.f, 0.f};
}
#define FOR_ACC(ai, bj, m, n) \
    _Pragma("unroll") for (int ai = 0; ai < 2; ++ai) _Pragma("unroll") for (int bj = 0; bj < 2; ++bj) \
    _Pragma("unroll") for (int m = 0; m < 4; ++m) _Pragma("unroll") for (int n = 0; n < 2; ++n)

__device__ __forceinline__ void p1_phase(const Params& p, LAS char* lds) {
    const int tid = threadIdx.x, wid = tid >> 6, lane = tid & 63, wr = wid >> 2, wc = wid & 3, fr = lane & 15, fq = lane >> 4;
    const bf16_t* U = (const bf16_t*)(p.ws + WS_U); const bf16_t* W = (const bf16_t*)(p.ws + WS_WIN);
    bf16_t* Q = (bf16_t*)(p.ws + WS_Q); bf16_t* C = (bf16_t*)(p.ws + WS_C); bf16_t* IQ = (bf16_t*)(p.ws + WS_IQ); bf16_t* IK = (bf16_t*)(p.ws + WS_IK);
    float* IW = (float*)(p.ws + WS_IW); bf16_t* PV = (bf16_t*)(p.ws + WS_PV); bf16_t* GT = (bf16_t*)(p.ws + WS_GATES);
    constexpr int NPM = MPAD / 256, NPN = INP / 256;
    for (int u = blockIdx.x; u < NPM * NPN; u += gridDim.x) {
        const int pm = u / NPN, pn = u % NPN;
        f32x4 acc[2][2][4][2]; zero_acc(acc);
        const bf16_t* a0 = U + (size_t)(pm * 256 + (tid >> 2)) * 1024 + (tid & 3) * 8;
        const bf16_t* b0 = W + (size_t)(pn * 256 + (tid >> 2)) * 1024 + (tid & 3) * 8;
        gemm_kloop(acc, a0, a0 + 128 * 1024, b0, b0 + 128 * 1024, 32, lds, tid, wr, wc, fr, fq);
        const int rowb = pm * 256 + wr * 64 + fr, colb = wc * 32 + 4 * fq;
        if (pn < 2) {
            FOR_ACC(ai, bj, m, n) st4bf(Q + (size_t)(rowb + ai * 128 + m * 16) * 512 + pn * 256 + bj * 128 + colb + n * 16, acc[ai][bj][m][n]);
        } else if (pn == 2) {
            LAS float* part = (LAS float*)lds;
#pragma unroll
            for (int ai = 0; ai < 2; ++ai)
#pragma unroll
                for (int m = 0; m < 4; ++m) {
                    float s = 0.f;
#pragma unroll
                    for (int n = 0; n < 2; ++n) { const f32x4 v = acc[ai][0][m][n]; s += v[0] * v[0] + v[1] * v[1] + v[2] * v[2] + v[3] * v[3]; }
                    s += __shfl_xor(s, 16); s += __shfl_xor(s, 32);
                    if (fq == 0) part[(ai * 128 + wr * 64 + m * 16 + fr) * 4 + wc] = s;
                }
            __syncthreads();
#pragma unroll
            for (int ai = 0; ai < 2; ++ai)
#pragma unroll
                for (int m = 0; m < 4; ++m) {
                    const int lr = ai * 128 + wr * 64 + m * 16 + fr;
                    const f32x4 ps = *(LAS f32x4*)(part + lr * 4);
                    const float rstd = rsqrtf((ps[0] + ps[1] + ps[2] + ps[3]) * (1.f / 128.f) + EPS);
                    const size_t R = (size_t)(rowb + ai * 128 + m * 16);
#pragma unroll
                    for (int n = 0; n < 2; ++n) {
                        const f32x4 g = *(const f32x4*)(p.kv_norm_g + colb + n * 16);
                        st4bf(C + R * 128 + colb + n * 16, acc[ai][0][m][n] * rstd * g);
                        st4bf(IQ + R * 256 + colb + n * 16, acc[ai][1][m][n]);
                    }
                }
            __syncthreads();
        } else if (pn == 3) {
#pragma unroll
            for (int ai = 0; ai < 2; ++ai)
#pragma unroll
                for (int m = 0; m < 4; ++m) {
                    const size_t R = (size_t)(rowb + ai * 128 + m * 16);
#pragma unroll
                    for (int n = 0; n < 2; ++n) {
                        st4bf(IQ + R * 256 + 128 + colb + n * 16, acc[ai][0][m][n]);
                        if (wc == 0) st4bf(IK + R * 32 + n * 16 + 4 * fq, acc[ai][1][m][n]);
                        if (wc == 1 && n == 0 && fq < 2) *(f32x4*)(IW + R * 8 + 4 * fq) = acc[ai][1][m][n] * IDX_SCALE;
                    }
                }
        } else if (pn < 6) {
            FOR_ACC(ai, bj, m, n) st4bf(PV + (size_t)(rowb + ai * 128 + m * 16) * 512 + (pn - 4) * 256 + bj * 128 + colb + n * 16, acc[ai][bj][m][n]);
        } else {
            FOR_ACC(ai, bj, m, n) {
                f32x4 v = acc[ai][bj][m][n];
#pragma unroll
                for (int r = 0; r < 4; ++r) v[r] = __builtin_amdgcn_rcpf(1.f + __expf(-v[r]));
                st4bf(GT + (size_t)(rowb + ai * 128 + m * 16) * 2048 + (pn - 6) * 256 + bj * 128 + colb + n * 16, v);
            }
        }
    }
}

constexpr int SC_STRIDE = 2068;
constexpr int SC_BYTES = 16 * SC_STRIDE * 4;
constexpr int MASK_OFF = SC_BYTES;
constexpr int QS_STRIDE = 136;

__device__ __forceinline__ int kv_off(int row, int ch) { return 256 * row + 16 * (ch ^ (((row & 3) << 2) | ((row >> 2) & 3))); }
__device__ __forceinline__ unsigned f2ord(float f) { const unsigned u = __float_as_uint(f); return (u & 0x80000000u) ? ~u : (u | 0x80000000u); }

__device__ __forceinline__ void attn_item(const Params& p, int b, int j, int half, LAS char* lds) {
    int tid_ = threadIdx.x; asm volatile("" : "+v"(tid_));
    const int tid = tid_, wid = __builtin_amdgcn_readfirstlane(tid >> 6), lane = tid & 63, fr = lane & 15, fq = lane >> 4;
    const int nadm = 16 + 64 * j;
    const int t0 = 16 + 64 * (j - 1) + 32 * half;
    const size_t Rq0 = (size_t)b * TT + t0, Rk0 = (size_t)b * TT;
    const bf16_t* Q = (const bf16_t*)(p.ws + WS_Q); const bf16_t* C = (const bf16_t*)(p.ws + WS_C); const bf16_t* IQ = (const bf16_t*)(p.ws + WS_IQ);
    const bf16_t* IK = (const bf16_t*)(p.ws + WS_IK); const float* IW = (const float*)(p.ws + WS_IW);
    LAS unsigned* maskw = (LAS unsigned*)(lds + MASK_OFF);
    const int h = wid;

    {
        const bf16_t* Wuk = (const bf16_t*)(p.ws + WS_WUK) + (size_t)h * 128 * 64;
        bf16x8 bq[2][2];
#pragma unroll
        for (int qt = 0; qt < 2; ++qt)
#pragma unroll
            for (int ks = 0; ks < 2; ++ks) bq[qt][ks] = *(const bf16x8*)(Q + (Rq0 + qt * 16 + fr) * 512 + h * 64 + ks * 32 + fq * 8);
        LAS bf16_t* qs = (LAS bf16_t*)lds + (size_t)h * 32 * QS_STRIDE;
#pragma unroll
        for (int ct = 0; ct < 8; ++ct) {
            const bf16x8 a0 = *(const bf16x8*)(Wuk + (ct * 16 + fr) * 64 + fq * 8), a1 = *(const bf16x8*)(Wuk + (ct * 16 + fr) * 64 + 32 + fq * 8);
#pragma unroll
            for (int qt = 0; qt < 2; ++qt) {
                f32x4 d = {0.f, 0.f, 0.f, 0.f};
                d = mfma16(a0, bq[qt][0], d); d = mfma16(a1, bq[qt][1], d);
                d = d * (ATTN_SCALE * LOG2E);
                u32x2 o; o.x = cvt_pk_bf16(d[0], d[1]); o.y = cvt_pk_bf16(d[2], d[3]);
                *(LAS u32x2*)(qs + (qt * 16 + fr) * QS_STRIDE + ct * 16 + 4 * fq) = o;
            }
        }
    }
    __syncthreads();
    bf16x8 qf[8];
    {
        const LAS bf16_t* qs = (const LAS bf16_t*)lds + (size_t)h * 32 * QS_STRIDE + (lane & 31) * QS_STRIDE + (lane >> 5) * 8;
#pragma unroll
        for (int ks = 0; ks < 8; ++ks) qf[ks] = *(const LAS bf16x8*)(qs + ks * 16);
    }
    __syncthreads();

    if (nadm <= 256) {
        for (int idx = tid; idx < 32 * 66; idx += 512) {
            const int w = idx % 66; const int lo = w * 32;
            unsigned v = 0u;
            if (lo + 32 <= nadm) v = 0xffffffffu; else if (lo < nadm) v = (1u << (nadm - lo)) - 1u;
            maskw[idx] = v;
        }
    } else {
        LAS float* sc = (LAS float*)lds;
        const int nkt = nadm >> 4;
#pragma unroll 1
        for (int sub = 0; sub < 2; ++sub) {
            {
                bf16x8 bq[8]; float wq[8];
                const size_t Rq = Rq0 + sub * 16 + fr;
#pragma unroll
                for (int hh = 0; hh < 8; ++hh) { bq[hh] = *(const bf16x8*)(IQ + Rq * 256 + hh * 32 + fq * 8); }
                { const f32x4 w0 = *(const f32x4*)(IW + Rq * 8), w1 = *(const f32x4*)(IW + Rq * 8 + 4);
                  wq[0] = w0[0]; wq[1] = w0[1]; wq[2] = w0[2]; wq[3] = w0[3]; wq[4] = w1[0]; wq[5] = w1[1]; wq[6] = w1[2]; wq[7] = w1[3]; }
#pragma unroll 1
                for (int kt = wid; kt < nkt; kt += 8) {
                    const bf16x8 a = *(const bf16x8*)(IK + (Rk0 + kt * 16 + fr) * 32 + fq * 8);
                    f32x4 s = {0.f, 0.f, 0.f, 0.f};
#pragma unroll
                    for (int hh = 0; hh < 8; ++hh) {
                        f32x4 d = {0.f, 0.f, 0.f, 0.f};
                        d = mfma16(a, bq[hh], d);
#pragma unroll
                        for (int r = 0; r < 4; ++r) s[r] += fmaxf(d[r], 0.f) * wq[hh];
                    }
                    *(LAS f32x4*)(sc + fr * SC_STRIDE + kt * 16 + 4 * fq) = s;
                }
            }
            __syncthreads();
#pragma unroll 1
            for (int qq = 0; qq < 2; ++qq) {
                const int ql = 2 * wid + qq;
                unsigned key[33];
#pragma unroll
                for (int i = 0; i < 33; ++i) { const int k = lane + 64 * i; const unsigned o = f2ord(sc[ql * SC_STRIDE + k]); key[i] = (k < nadm) ? o : 0u; }
                unsigned prefix = 0u; bool exact = false;
#pragma unroll 1
                for (int bit = 31; bit >= 0; --bit) {
                    const unsigned cand = prefix | (1u << bit);
                    int c = 0;
#pragma unroll
                    for (int i = 0; i < 33; ++i) c += __popcll(__ballot(key[i] >= cand));
                    if (c >= 256) prefix = cand;
                    if (c == 256) { exact = true; break; }
                }
                int need = 0;
                if (!exact) {
                    int cg = 0;
#pragma unroll
                    for (int i = 0; i < 33; ++i) cg += __popcll(__ballot(key[i] > prefix));
                    need = 256 - cg;
                }
                int running = 0;
                const unsigned long long lt = (1ull << lane) - 1ull;
#pragma unroll
                for (int i = 0; i < 33; ++i) {
                    bool sel;
                    if (exact) sel = key[i] >= prefix;
                    else {
                        const bool eq = key[i] == prefix;
                        const unsigned long long be = __ballot(eq);
                        const int rank = running + __popcll(be & lt);
                        sel = (key[i] > prefix) || (eq && rank < need);
                        running += __popcll(be);
                    }
                    const unsigned long long bs = __ballot(sel);
                    if (lane == 0) { maskw[(sub * 16 + ql) * 66 + 2 * i] = (unsigned)bs; maskw[(sub * 16 + ql) * 66 + 2 * i + 1] = (unsigned)(bs >> 32); }
                }
            }
            __syncthreads();
        }
    }
    __syncthreads();

    const int ntile = (nadm + 31) >> 5;
    f32x16 O[4];
#pragma unroll
    for (int mt = 0; mt < 4; ++mt)
#pragma unroll
        for (int r = 0; r < 16; ++r) O[mt][r] = 0.f;
    float mrun = -1e30f, lrun = 0.f;
    {
        const bf16_t* kvsrc = C + (Rk0 + (tid >> 4)) * 128 + (tid & 15) * 8;
        const int kvdst = kv_off(tid >> 4, tid & 15);
        u32x4 rr = *(const u32x4*)kvsrc;
        *(LAS u32x4*)(lds + kvdst) = rr;
        __syncthreads();
        const int hq = lane >> 5, ql = lane & 31;
        const int tg = lane >> 4, ti = lane & 15, tq = ti >> 2, tp = ti & 3;
#pragma unroll 1
        for (int T = 0; T < ntile; ++T) {
            const bool more = T + 1 < ntile;
            if (more) rr = *(const u32x4*)(kvsrc + (size_t)(T + 1) * 32 * 128);
            LAS char* kb = lds + (T & 1) * 8192;
            f32x16 S;
#pragma unroll
            for (int r = 0; r < 16; ++r) S[r] = 0.f;
#pragma unroll
            for (int ks = 0; ks < 8; ++ks) {
                const bf16x8 a = *(LAS bf16x8*)(kb + kv_off(ql, 2 * ks + hq));
                S = mfma32(a, qf[ks], S);
            }
            const unsigned mw = maskw[ql * 66 + T] >> (4 * hq);
            float mx = -INFINITY;
#pragma unroll
            for (int r = 0; r < 16; ++r) {
                const int bit = (r & 3) + 8 * (r >> 2);
                S[r] = ((mw >> bit) & 1u) ? S[r] : -INFINITY;
                mx = fmaxf(mx, S[r]);
            }
            mx = fmaxf(mx, __shfl_xor(mx, 32));
            const float mnew = fmaxf(mrun, mx);
            const float alpha = __builtin_amdgcn_exp2f(mrun - mnew);
            float rs = 0.f;
#pragma unroll
            for (int r = 0; r < 16; ++r) { S[r] = __builtin_amdgcn_exp2f(S[r] - mnew); rs += S[r]; }
            rs += __shfl_xor(rs, 32);
            lrun = lrun * alpha + rs; mrun = mnew;
#pragma unroll
            for (int mt = 0; mt < 4; ++mt)
#pragma unroll
                for (int r = 0; r < 16; ++r) O[mt][r] *= alpha;
            bf16x8 pf[2];
#pragma unroll
            for (int s2 = 0; s2 < 2; ++s2) {
                u32x4 w;
                w.x = cvt_pk_bf16(S[8 * s2 + 0], S[8 * s2 + 1]); w.y = cvt_pk_bf16(S[8 * s2 + 2], S[8 * s2 + 3]);
                w.z = cvt_pk_bf16(S[8 * s2 + 4], S[8 * s2 + 5]); w.w = cvt_pk_bf16(S[8 * s2 + 6], S[8 * s2 + 7]);
                pf[s2] = __builtin_bit_cast(bf16x8, w);
            }
#pragma unroll
            for (int mt = 0; mt < 4; ++mt)
#pragma unroll
                for (int s2 = 0; s2 < 2; ++s2) {
                    const int colb = 32 * mt + 16 * (tg & 1) + 4 * tp;
                    const int row1 = 16 * s2 + 4 * (tg >> 1) + tq;
                    const s16x4 v0 = __builtin_amdgcn_ds_read_tr16_b64_v4i16((LAS s16x4*)(kb + kv_off(row1, colb >> 3) + (colb & 7) * 2));
                    const s16x4 v1 = __builtin_amdgcn_ds_read_tr16_b64_v4i16((LAS s16x4*)(kb + kv_off(row1 + 8, colb >> 3) + (colb & 7) * 2));
                    bf16x8 a; a[0] = v0[0]; a[1] = v0[1]; a[2] = v0[2]; a[3] = v0[3]; a[4] = v1[0]; a[5] = v1[1]; a[6] = v1[2]; a[7] = v1[3];
                    O[mt] = mfma32(a, pf[s2], O[mt]);
                }
            if (more) *(LAS u32x4*)(lds + ((T + 1) & 1) * 8192 + kvdst) = rr;
            __syncthreads();
        }
    }
    {
        const float inv = 1.f / lrun;
        const int hq = lane >> 5, ql = lane & 31;
        LAS bf16_t* os = (LAS bf16_t*)(lds + 16384) + (size_t)h * 32 * QS_STRIDE;
#pragma unroll
        for (int mt = 0; mt < 4; ++mt)
#pragma unroll
            for (int rg = 0; rg < 4; ++rg) {
                u32x2 o; o.x = cvt_pk_bf16(O[mt][4 * rg] * inv, O[mt][4 * rg + 1] * inv); o.y = cvt_pk_bf16(O[mt][4 * rg + 2] * inv, O[mt][4 * rg + 3] * inv);
                *(LAS u32x2*)(os + ql * QS_STRIDE + 32 * mt + 8 * rg + 4 * hq) = o;
            }
        __syncthreads();
        const bf16_t* Wuv = (const bf16_t*)(p.ws + WS_WUV) + (size_t)h * 64 * 128;
        bf16_t* AT = (bf16_t*)(p.ws + WS_ATTN);
        const size_t n0 = (size_t)b * SEQ + (t0 - 16);
        bf16x8 bo[2][4];
#pragma unroll
        for (int qt = 0; qt < 2; ++qt)
#pragma unroll
            for (int ks = 0; ks < 4; ++ks) bo[qt][ks] = *(LAS bf16x8*)(os + (qt * 16 + fr) * QS_STRIDE + ks * 32 + fq * 8);
#pragma unroll
        for (int dt = 0; dt < 4; ++dt) {
            bf16x8 a[4];
#pragma unroll
            for (int ks = 0; ks < 4; ++ks) a[ks] = *(const bf16x8*)(Wuv + (dt * 16 + fr) * 128 + ks * 32 + fq * 8);
#pragma unroll
            for (int qt = 0; qt < 2; ++qt) {
                f32x4 d = {0.f, 0.f, 0.f, 0.f};
#pragma unroll
                for (int ks = 0; ks < 4; ++ks) d = mfma16(a[ks], bo[qt][ks], d);
                st4bf(AT + (n0 + qt * 16 + fr) * 512 + h * 64 + dt * 16 + 4 * fq, d);
            }
        }
    }
    __syncthreads();
}

__device__ __forceinline__ void p2_phase(const Params& p, LAS char* lds) {
    const int tid = threadIdx.x;
    {
        const bf16_t* PV = (const bf16_t*)(p.ws + WS_PV); bf16_t* DD = (bf16_t*)(p.ws + WS_DD);
        for (int rc = blockIdx.x; rc < NTOK / 64; rc += gridDim.x) {
#pragma unroll 1
            for (int it = 0; it < 8; ++it) {
                const int idx = tid + 512 * it, r = idx >> 6, ch8 = idx & 63;
                const int n = rc * 64 + r, b = n >> 11, s = n & 2047;
                const size_t R = (size_t)b * TT + 16 + s;
                const int g = ch8 >> 4, w = 2 << g;
                float a[8];
#pragma unroll
                for (int e = 0; e < 8; ++e) a[e] = 0.f;
                u32x4 self = {0u, 0u, 0u, 0u};
                for (int i = 0; i < w; ++i) {
                    const u32x4 v = *(const u32x4*)(PV + (R - i) * 512 + ch8 * 8);
                    if (i == 0) self = v;
                    a[0] += bf_lo(v.x); a[1] += bf_hi(v.x); a[2] += bf_lo(v.y); a[3] += bf_hi(v.y); a[4] += bf_lo(v.z); a[5] += bf_hi(v.z); a[6] += bf_lo(v.w); a[7] += bf_hi(v.w);
                }
                const float iw = 1.f / (float)w;
                u32x4 o;
                o.x = cvt_pk_bf16(a[0] * iw - bf_lo(self.x), a[1] * iw - bf_hi(self.x)); o.y = cvt_pk_bf16(a[2] * iw - bf_lo(self.y), a[3] * iw - bf_hi(self.y));
                o.z = cvt_pk_bf16(a[4] * iw - bf_lo(self.z), a[5] * iw - bf_hi(self.z)); o.w = cvt_pk_bf16(a[6] * iw - bf_lo(self.w), a[7] * iw - bf_hi(self.w));
                *(u32x4*)(DD + (size_t)n * 512 + ch8 * 8) = o;
            }
        }
    }
    for (int x = blockIdx.x; x < 256; x += gridDim.x) {
        const int b = x & 7, r = x >> 3;
#pragma unroll 1
        for (int rep = 0; rep < 2; ++rep) attn_item(p, b, rep == 0 ? 32 - (r >> 1) : 1 + (r >> 1), r & 1, lds);
    }
}

__device__ __forceinline__ void p3_phase(const Params& p, LAS char* lds) {
    const int tid = threadIdx.x, wid = tid >> 6, lane = tid & 63, wr = wid >> 2, wc = wid & 3, fr = lane & 15, fq = lane >> 4;
    const bf16_t* AT = (const bf16_t*)(p.ws + WS_ATTN); const bf16_t* DD = (const bf16_t*)(p.ws + WS_DD);
    const bf16_t* WA = (const bf16_t*)(p.ws + WS_WA); const bf16_t* WF = (const bf16_t*)(p.ws + WS_WF);
    const bf16_t* GT = (const bf16_t*)(p.ws + WS_GATES); bf16_t* MG = (bf16_t*)(p.ws + WS_U);
    for (int u = blockIdx.x; u < 64 * 4; u += gridDim.x) {
        const int pm = u >> 2, pn = u & 3;
        f32x4 acc[2][2][4][2];
        const int rowb = pm * 256 + wr * 64 + fr, colb = pn * 256 + wc * 32 + 4 * fq;
        {
            zero_acc(acc);
            const bf16_t* a0 = AT + (size_t)(pm * 256 + (tid >> 2)) * 512 + (tid & 3) * 8;
            const bf16_t* b0 = WA + (size_t)(pn * 256 + (tid >> 2)) * 512 + (tid & 3) * 8;
            gemm_kloop(acc, a0, a0 + 128 * 512, b0, b0 + 128 * 512, 16, lds, tid, wr, wc, fr, fq);
            FOR_ACC(ai, bj, m, n) {
                const int nrow = rowb + ai * 128 + m * 16, col = colb + bj * 128 + n * 16;
                const size_t R = (size_t)nrow + 16 + 16 * (nrow >> 11);
                const u32x2 g = *(const u32x2*)(GT + R * 2048 + col);
                f32x4 v = acc[ai][bj][m][n];
                v[0] *= bf_lo(g.x); v[1] *= bf_hi(g.x); v[2] *= bf_lo(g.y); v[3] *= bf_hi(g.y);
                st4bf(MG + (size_t)nrow * 1024 + col, v);
            }
        }
        {
            zero_acc(acc);
            const bf16_t* a0 = DD + (size_t)(pm * 256 + (tid >> 2)) * 512 + (tid & 3) * 8;
            const bf16_t* b0 = WF + (size_t)(pn * 256 + (tid >> 2)) * 512 + (tid & 3) * 8;
            gemm_kloop(acc, a0, a0 + 128 * 512, b0, b0 + 128 * 512, 16, lds, tid, wr, wc, fr, fq);
            FOR_ACC(ai, bj, m, n) {
                const int nrow = rowb + ai * 128 + m * 16, col = colb + bj * 128 + n * 16;
                const size_t R = (size_t)nrow + 16 + 16 * (nrow >> 11);
                const u32x2 g = *(const u32x2*)(GT + R * 2048 + 1024 + col);
                const u32x2 pr = *(const u32x2*)(MG + (size_t)nrow * 1024 + col);
                f32x4 v = acc[ai][bj][m][n];
                v[0] = v[0] * bf_lo(g.x) + bf_lo(pr.x); v[1] = v[1] * bf_hi(g.x) + bf_hi(pr.x); v[2] = v[2] * bf_lo(g.y) + bf_lo(pr.y); v[3] = v[3] * bf_hi(g.y) + bf_hi(pr.y);
                st4bf(MG + (size_t)nrow * 1024 + col, v);
            }
        }
    }
}

__device__ __forceinline__ void p4_phase(const Params& p, LAS char* lds) {
    const int tid = threadIdx.x, wid = tid >> 6, lane = tid & 63, wr = wid >> 2, wc = wid & 3, fr = lane & 15, fq = lane >> 4;
    const bf16_t* MG = (const bf16_t*)(p.ws + WS_U); const bf16_t* WO = (const bf16_t*)(p.ws + WS_WO);
    for (int u = blockIdx.x; u < 64 * 4; u += gridDim.x) {
        const int pm = u >> 2, pn = u & 3;
        f32x4 acc[2][2][4][2]; zero_acc(acc);
        const bf16_t* a0 = MG + (size_t)(pm * 256 + (tid >> 2)) * 1024 + (tid & 3) * 8;
        const bf16_t* b0 = WO + (size_t)(pn * 256 + (tid >> 2)) * 1024 + (tid & 3) * 8;
        gemm_kloop(acc, a0, a0 + 128 * 1024, b0, b0 + 128 * 1024, 32, lds, tid, wr, wc, fr, fq);
        const int rowb = pm * 256 + wr * 64 + fr, colb = pn * 256 + wc * 32 + 4 * fq;
        FOR_ACC(ai, bj, m, n) {
            const size_t off = (size_t)(rowb + ai * 128 + m * 16) * 1024 + colb + bj * 128 + n * 16;
            *(f32x4*)(p.out + off) = *(const f32x4*)(p.x + off) + acc[ai][bj][m][n];
        }
    }
}

__device__ __forceinline__ void p5_phase(const Params& p, LAS char* lds) {
    const int tid = threadIdx.x, wid = tid >> 6, lane = tid & 63;
    LAS float* WL = (LAS float*)lds;
    LAS int* lcnt = (LAS int*)(lds + 147456);
    LAS int* lbase = lcnt + 32;
    LAS int* tk_e = lbase + 32;
    LAS int* tk_r = tk_e + 128;
    LAS float* tk_w = (LAS float*)(tk_r + 128);
#pragma unroll
    for (int i = 0; i < 2; ++i) { const int k = tid + 512 * i; const f32x4 v = *(const f32x4*)(p.w_gr + (size_t)k * 4); WL[k] = v[0]; WL[1024 + k] = v[1]; WL[2048 + k] = v[2]; WL[3072 + k] = v[3]; }
#pragma unroll 1
    for (int i = 0; i < 16; ++i) { const int idx = tid + 512 * i, k = idx >> 3, e4 = (idx & 7) * 4; const f32x4 v = *(const f32x4*)(p.w_er + (size_t)k * 32 + e4);
        WL[(4 + e4) * 1024 + k] = v[0]; WL[(5 + e4) * 1024 + k] = v[1]; WL[(6 + e4) * 1024 + k] = v[2]; WL[(7 + e4) * 1024 + k] = v[3]; }
    bf16_t* U2 = (bf16_t*)(p.ws + WS_U);
    int* cnt = (int*)(p.ws + WS_CNT); int* list = (int*)(p.ws + WS_LIST); float* wts = (float*)(p.ws + WS_WTS); int* tokrow = (int*)(p.ws + WS_TOKROW);
    for (int chunk = blockIdx.x; chunk < NTOK / 64; chunk += gridDim.x) {
        if (tid < 32) lcnt[tid] = 0;
        __syncthreads();
#pragma unroll 1
        for (int i = 0; i < 8; ++i) {
            const int tl = wid + 8 * i, n = chunk * 64 + tl;
            f32x4 v[4]; float ss = 0.f;
#pragma unroll
            for (int j = 0; j < 4; ++j) { v[j] = *(const f32x4*)(p.out + (size_t)n * 1024 + j * 256 + lane * 4); ss += v[j][0] * v[j][0] + v[j][1] * v[j][1] + v[j][2] * v[j][2] + v[j][3] * v[j][3]; }
            ss = wave_sum(ss);
            const float rstd = rsqrtf(ss * (1.f / 1024.f) + EPS);
#pragma unroll
            for (int j = 0; j < 4; ++j) { const f32x4 g = *(const f32x4*)(p.norm2_g + j * 256 + lane * 4); v[j] = v[j] * rstd * g; st4bf(U2 + (size_t)n * 1024 + j * 256 + lane * 4, v[j]); }
            float L[36];
#pragma unroll
            for (int o = 0; o < 36; ++o) {
                float s = 0.f;
#pragma unroll
                for (int j = 0; j < 4; ++j) { const f32x4 w = *(LAS f32x4*)(WL + o * 1024 + j * 256 + lane * 4); s += v[j][0] * w[0] + v[j][1] * w[1] + v[j][2] * w[2] + v[j][3] * w[3]; }
                L[o] = wave_sum(s);
            }
            float gl[4];
#pragma unroll
            for (int g = 0; g < 4; ++g) gl[g] = L[g] + p.b_gr[g];
            int gs = 0; float gm = gl[0];
#pragma unroll
            for (int g = 1; g < 4; ++g) if (gl[g] > gm) { gm = gl[g]; gs = g; }
            float gsum = 0.f;
#pragma unroll
            for (int g = 0; g < 4; ++g) gsum += __expf(gl[g] - gm);
            const float pg = 1.f / gsum;
            float el[8];
#pragma unroll
            for (int e = 0; e < 8; ++e) {
                const float l0 = L[4 + e] + p.b_er[e], l1 = L[12 + e] + p.b_er[8 + e], l2 = L[20 + e] + p.b_er[16 + e], l3 = L[28 + e] + p.b_er[24 + e];
                el[e] = gs == 0 ? l0 : (gs == 1 ? l1 : (gs == 2 ? l2 : l3));
            }
            int i1 = 0; float v1 = el[0];
#pragma unroll
            for (int e = 1; e < 8; ++e) if (el[e] > v1) { v1 = el[e]; i1 = e; }
            int i2 = (i1 == 0) ? 1 : 0; float v2 = -INFINITY;
#pragma unroll
            for (int e = 0; e < 8; ++e) if (e != i1 && el[e] > v2) { v2 = el[e]; i2 = e; }
            const float e2 = __expf(v2 - v1), p1 = 1.f / (1.f + e2), p2 = e2 * p1;
            if (lane == 0) {
                const int ea = gs * 8 + i1, eb = gs * 8 + i2;
                tk_e[tl * 2] = ea; tk_e[tl * 2 + 1] = eb;
                tk_r[tl * 2] = __hip_atomic_fetch_add(&lcnt[ea], 1, __ATOMIC_RELAXED, __HIP_MEMORY_SCOPE_WORKGROUP); tk_r[tl * 2 + 1] = __hip_atomic_fetch_add(&lcnt[eb], 1, __ATOMIC_RELAXED, __HIP_MEMORY_SCOPE_WORKGROUP);
                tk_w[tl * 2] = pg * p1; tk_w[tl * 2 + 1] = pg * p2;
            }
        }
        __syncthreads();
        if (tid < 32) lbase[tid] = atomicAdd(&cnt[tid], lcnt[tid]);
        __syncthreads();
        if (tid < 128) {
            const int e = tk_e[tid], slot = lbase[e] + tk_r[tid], n = chunk * 64 + (tid >> 1);
            list[e * LISTCAP + slot] = n; wts[e * LISTCAP + slot] = tk_w[tid]; tokrow[n * 2 + (tid & 1)] = e * LISTCAP + slot;
        }
        __syncthreads();
    }
}

__device__ __forceinline__ void moe_tables(const Params& p, LAS int* tb) {
    if (threadIdx.x == 0) {
        const int* cnt = (const int*)(p.ws + WS_CNT);
        int acc = 0;
        for (int e = 0; e < 32; ++e) { const int c = __hip_atomic_load(cnt + e, __ATOMIC_RELAXED, __HIP_MEMORY_SCOPE_AGENT); tb[e] = c; tb[32 + e] = acc; acc += (c + 255) >> 8; }
        tb[64] = acc;
    }
    __syncthreads();
}

__device__ __forceinline__ void p6_phase(const Params& p, LAS char* lds) {
    const int tid = threadIdx.x, wid = tid >> 6, lane = tid & 63, wr = wid >> 2, wc = wid & 3, fr = lane & 15, fq = lane >> 4;
    LAS int* tb = (LAS int*)(lds + 2 * G_STAGE);
    moe_tables(p, tb);
    const int ntiles = tb[64];
    const bf16_t* U2 = (const bf16_t*)(p.ws + WS_U); const bf16_t* W1 = (const bf16_t*)(p.ws + WS_W1);
    const int* list = (const int*)(p.ws + WS_LIST); const float* wts = (const float*)(p.ws + WS_WTS); bf16_t* HID = (bf16_t*)(p.ws + WS_HID);
    for (int u = blockIdx.x; u < ntiles * 2; u += gridDim.x) {
        const int ti = u >> 1, pn = u & 1;
        int e = 0;
#pragma unroll 1
        for (int q = 1; q < 32; ++q) if (tb[32 + q] <= ti) e = q;
        const int rt = ti - tb[32 + e], ce = tb[e];
        const int s0 = rt * 256 + (tid >> 2), s1 = s0 + 128;
        const int tok0 = s0 < ce ? list[e * LISTCAP + s0] : 0, tok1 = s1 < ce ? list[e * LISTCAP + s1] : 0;
        f32x4 acc[2][2][4][2]; zero_acc(acc);
        const bf16_t* b0 = W1 + ((size_t)e * 512 + pn * 256 + (tid >> 2)) * 1024 + (tid & 3) * 8;
        gemm_kloop(acc, U2 + (size_t)tok0 * 1024 + (tid & 3) * 8, U2 + (size_t)tok1 * 1024 + (tid & 3) * 8, b0, b0 + 128 * 1024, 32, lds, tid, wr, wc, fr, fq);
        const size_t rowbase = (size_t)(tb[32 + e] + rt) * 256;
#pragma unroll
        for (int ai = 0; ai < 2; ++ai)
#pragma unroll
            for (int m = 0; m < 4; ++m) {
                const int lr = ai * 128 + wr * 64 + m * 16 + fr, slot = rt * 256 + lr;
                const float w = slot < ce ? wts[e * LISTCAP + slot] : 0.f;
#pragma unroll
                for (int n = 0; n < 2; ++n) {
                    const f32x4 g = acc[ai][0][m][n], uu = acc[ai][1][m][n]; f32x4 hv;
#pragma unroll
                    for (int r = 0; r < 4; ++r) hv[r] = g[r] * __builtin_amdgcn_rcpf(1.f + __expf(-g[r])) * uu[r] * w;
                    st4bf(HID + (rowbase + lr) * 256 + pn * 128 + wc * 32 + n * 16 + 4 * fq, hv);
                }
            }
    }
}

__device__ __forceinline__ void p7_phase(const Params& p, LAS char* lds) {
    const int tid = threadIdx.x, wid = tid >> 6, lane = tid & 63, wr = wid >> 2, wc = wid & 3, fr = lane & 15, fq = lane >> 4;
    LAS int* tb = (LAS int*)(lds + 2 * G_STAGE);
    moe_tables(p, tb);
    const int ntiles = tb[64];
    const bf16_t* HID = (const bf16_t*)(p.ws + WS_HID); const bf16_t* W2 = (const bf16_t*)(p.ws + WS_W2); bf16_t* Y = (bf16_t*)(p.ws + WS_Y);
    for (int u = blockIdx.x; u < ntiles * 4; u += gridDim.x) {
        const int ti = u >> 2, pn = u & 3;
        int e = 0;
#pragma unroll 1
        for (int q = 1; q < 32; ++q) if (tb[32 + q] <= ti) e = q;
        f32x4 acc[2][2][4][2]; zero_acc(acc);
        const bf16_t* a0 = HID + ((size_t)ti * 256 + (tid >> 2)) * 256 + (tid & 3) * 8;
        const bf16_t* b0 = W2 + ((size_t)e * 1024 + pn * 256 + (tid >> 2)) * 256 + (tid & 3) * 8;
        gemm_kloop(acc, a0, a0 + 128 * 256, b0, b0 + 128 * 256, 8, lds, tid, wr, wc, fr, fq);
        FOR_ACC(ai, bj, m, n) st4bf(Y + ((size_t)ti * 256 + ai * 128 + wr * 64 + m * 16 + fr) * 1024 + pn * 256 + bj * 128 + wc * 32 + n * 16 + 4 * fq, acc[ai][bj][m][n]);
    }
}

__device__ __forceinline__ void p8_phase(const Params& p, LAS char* lds) {
    const int tid = threadIdx.x, wid = tid >> 6, lane = tid & 63;
    LAS int* tb = (LAS int*)lds;
    moe_tables(p, tb);
    const bf16_t* Y = (const bf16_t*)(p.ws + WS_Y); const int* tokrow = (const int*)(p.ws + WS_TOKROW);
    for (int n = blockIdx.x * 8 + wid; n < NTOK; n += gridDim.x * 8) {
        const int r1 = tokrow[n * 2], r2 = tokrow[n * 2 + 1];
        const size_t y1 = (size_t)tb[32 + (r1 >> 14)] * 256 + (r1 & 16383), y2 = (size_t)tb[32 + (r2 >> 14)] * 256 + (r2 & 16383);
        f32x4 v[4]; float ss = 0.f;
#pragma unroll
        for (int j = 0; j < 4; ++j) {
            v[j] = *(const f32x4*)(p.out + (size_t)n * 1024 + j * 256 + lane * 4);
            const u32x2 a = *(const u32x2*)(Y + y1 * 1024 + j * 256 + lane * 4), c = *(const u32x2*)(Y + y2 * 1024 + j * 256 + lane * 4);
            v[j][0] += bf_lo(a.x) + bf_lo(c.x); v[j][1] += bf_hi(a.x) + bf_hi(c.x); v[j][2] += bf_lo(a.y) + bf_lo(c.y); v[j][3] += bf_hi(a.y) + bf_hi(c.y);
            ss += v[j][0] * v[j][0] + v[j][1] * v[j][1] + v[j][2] * v[j][2] + v[j][3] * v[j][3];
        }
        ss = wave_sum(ss);
        const float rstd = rsqrtf(ss * (1.f / 1024.f) + EPS);
#pragma unroll
        for (int j = 0; j < 4; ++j) { const f32x4 g = *(const f32x4*)(p.final_g + j * 256 + lane * 4); *(f32x4*)(p.out + (size_t)n * 1024 + j * 256 + lane * 4) = v[j] * rstd * g; }
    }
}

__global__ void __launch_bounds__(512, 2) fwd_kernel(Params p) {
    extern __shared__ __attribute__((aligned(16))) unsigned char smem[];
    LAS char* lds = (LAS char*)smem;
    volatile LAS unsigned* barw = (volatile LAS unsigned*)(lds + LDS_BARW);
    if (threadIdx.x < 2) barw[threadIdx.x] = 0u;
    __syncthreads();
    XcdBarrier bar; bar.bar = (unsigned*)(p.ws + WS_BAR); bar.x = 0; bar.st = nullptr;
    if (N_LAUNCHES == 1) bar = xcd_barrier_post((unsigned*)(p.ws + WS_BAR), barw);
    const int lo = p.ph_lo, hi = p.ph_hi;
#define IN(k) (lo <= (k) && (k) < hi)
#define SEAM(k) do { if (IN(k) && IN((k) + 1)) xcd_barrier(bar); } while (0)
#ifndef PH_MASK
#define PH_MASK 0x7ff
#endif
#define HAS(k) ((PH_MASK >> (k)) & 1)
    if (HAS(0) && IN(0)) { p0_phase(p, lds); } SEAM(0);
    if (HAS(1) && IN(1)) { p1_phase(p, lds); } SEAM(1);
    if (HAS(2) && IN(2)) { p2_phase(p, lds); } SEAM(2);
    if (HAS(3) && IN(3)) { p3_phase(p, lds); } SEAM(3);
    if (HAS(4) && IN(4)) { p4_phase(p, lds); } SEAM(4);
    if (HAS(5) && IN(5)) { p5_phase(p, lds); } SEAM(5);
    if (HAS(6) && IN(6)) { p6_phase(p, lds); } SEAM(6);
    if (HAS(7) && IN(7)) { p7_phase(p, lds); } SEAM(7);
    if (HAS(8) && IN(8)) { p8_phase(p, lds); }
}

extern "C" void kernel_launch(void* const* d_in, const int* in_sizes, int n_in, void* d_out, int out_size, void* d_ws, size_t ws_size, hipStream_t stream) {
    static int grid = 0;
    if (grid == 0) {
        if (n_in != 21 || ws_size < WS_END) { fprintf(stderr, "kernel_launch: unexpected n_in %d or ws_size %zu (< %zu)\n", n_in, ws_size, (size_t)WS_END); grid = -1; return; }
        int dev = 0, cus = 0;
        if (hipGetDevice(&dev) != hipSuccess || hipDeviceGetAttribute(&cus, hipDeviceAttributeMultiprocessorCount, dev) != hipSuccess) { grid = -1; return; }
        if (hipFuncSetAttribute((const void*)fwd_kernel, hipFuncAttributeMaxDynamicSharedMemorySize, LDS_BYTES) != hipSuccess) { fprintf(stderr, "kernel_launch: hipFuncSetAttribute failed\n"); grid = -1; return; }
        grid = cus;
    }
    if (grid < 0) return;
    (void)hipMemsetAsync((char*)d_ws + WS_BAR, 0, WS_ZERO_BYTES, stream);
    Params p{};
    const float** f = (const float**)&p;
    for (int i = 0; i < 21; ++i) f[i] = (const float*)d_in[i];
    p.out = (float*)d_out; p.ws = (unsigned char*)d_ws;
    if (N_LAUNCHES == 1) { p.ph_lo = 0; p.ph_hi = NPH; hipLaunchKernelGGL(fwd_kernel, dim3(grid), dim3(512), LDS_BYTES, stream, p); }
    else for (int k = 0; k < NPH; ++k) { p.ph_lo = k; p.ph_hi = k + 1; hipLaunchKernelGGL(fwd_kernel, dim3(grid), dim3(512), LDS_BYTES, stream, p); }
}
```

```cpp
#include <hip/hip_runtime.h>
#include <stdint.h>
#include <stdio.h>

#ifndef DUP_PHASE
#define DUP_PHASE -1
#endif
#ifndef N_LAUNCHES
#define N_LAUNCHES 1
#endif

#define LAS __attribute__((address_space(3)))
typedef unsigned short bf16_t;
typedef short bf16x8 __attribute__((ext_vector_type(8)));
typedef short s16x4 __attribute__((ext_vector_type(4)));
typedef float f32x4 __attribute__((ext_vector_type(4)));
typedef float f32x16 __attribute__((ext_vector_type(16)));
typedef unsigned u32x4 __attribute__((ext_vector_type(4)));
typedef unsigned u32x2 __attribute__((ext_vector_type(2)));

constexpr int NB = 8, SEQ = 2048, TT = 2064, DM = 1024;
constexpr int MALL = NB * TT;
constexpr int MPAD = 16640;
constexpr int NTOK = NB * SEQ;
constexpr int INW = 3496, INP = 3584;
constexpr float EPS = 1e-6f;
constexpr float ATTN_SCALE = 0.125f;
constexpr float IDX_SCALE = 0.0625f;
constexpr float LOG2E = 1.4426950408889634f;
constexpr int NPH = 9;
constexpr int LISTCAP = 16384;
constexpr int YROWS = 40960;

constexpr size_t AL(size_t x) { return (x + 255) & ~(size_t)255; }
constexpr size_t WS_BAR   = 0;
constexpr size_t WS_CNT   = WS_BAR + 16384;
constexpr size_t WS_ZERO_BYTES = 16384 + 256;
constexpr size_t WS_WIN   = AL(WS_CNT + 256);
constexpr size_t WS_WUK   = AL(WS_WIN + (size_t)INP * DM * 2);
constexpr size_t WS_WUV   = AL(WS_WUK + 8 * 128 * 64 * 2);
constexpr size_t WS_WF    = AL(WS_WUV + 8 * 64 * 128 * 2);
constexpr size_t WS_WA    = AL(WS_WF + 1024 * 512 * 2);
constexpr size_t WS_WO    = AL(WS_WA + 1024 * 512 * 2);
constexpr size_t WS_W1    = AL(WS_WO + 1024 * 1024 * 2);
constexpr size_t WS_W2    = AL(WS_W1 + (size_t)32 * 512 * 1024 * 2);
constexpr size_t WS_WRH   = AL(WS_W2 + (size_t)32 * 1024 * 256 * 2);
constexpr size_t WS_WRL   = AL(WS_WRH + 48 * 1024 * 2);
constexpr size_t WS_U     = AL(WS_WRL + 48 * 1024 * 2);
constexpr size_t WS_LIST  = AL(WS_U + (size_t)MPAD * DM * 2);
constexpr size_t WS_WTS   = AL(WS_LIST + (size_t)32 * LISTCAP * 4);
constexpr size_t WS_TOKROW= AL(WS_WTS + (size_t)32 * LISTCAP * 4);
constexpr size_t WS_UNION = AL(WS_TOKROW + (size_t)NTOK * 2 * 4);
constexpr size_t WS_Q     = WS_UNION;
constexpr size_t WS_C     = AL(WS_Q + (size_t)MPAD * 512 * 2);
constexpr size_t WS_IQ    = AL(WS_C + (size_t)MPAD * 128 * 2);
constexpr size_t WS_IK    = AL(WS_IQ + (size_t)MPAD * 256 * 2);
constexpr size_t WS_IW    = AL(WS_IK + (size_t)MPAD * 32 * 2);
constexpr size_t WS_PV    = AL(WS_IW + (size_t)MPAD * 8 * 4);
constexpr size_t WS_GATES = AL(WS_PV + (size_t)MPAD * 512 * 2);
constexpr size_t WS_ATTN  = AL(WS_GATES + (size_t)MPAD * 2048 * 2);
constexpr size_t WS_DD    = AL(WS_ATTN + (size_t)NTOK * 512 * 2);
constexpr size_t WS_ENDA  = AL(WS_DD + (size_t)NTOK * 512 * 2);
constexpr size_t WS_HID   = WS_UNION;
constexpr size_t WS_Y     = AL(WS_HID + (size_t)YROWS * 256 * 2);
constexpr size_t WS_ENDB  = AL(WS_Y + (size_t)YROWS * 1024 * 2);
constexpr size_t WS_END   = WS_ENDA > WS_ENDB ? WS_ENDA : WS_ENDB;

constexpr int LDS_BYTES = 156 * 1024;
constexpr int LDS_BARW  = LDS_BYTES - 16;

struct Params {
    const float *x, *meta, *norm1_g, *w_in, *kv_norm_g, *w_uk, *w_uv, *w_pool, *pool_scale, *w_ba, *w_bp, *w_out, *norm2_g,
                *w_gr, *b_gr, *w_er, *b_er, *w_eg, *w_eu, *w_ed, *final_g;
    float* out; unsigned char* ws; int ph_lo, ph_hi;
};

typedef __bf16 bf16v2_t __attribute__((ext_vector_type(2)));
typedef float f32x2 __attribute__((ext_vector_type(2)));
__device__ __forceinline__ unsigned cvt_pk_bf16(float lo, float hi) { const f32x2 v = {lo, hi}; return __builtin_bit_cast(unsigned, __builtin_convertvector(v, bf16v2_t)); }
__device__ __forceinline__ float bf_lo(unsigned u) { return __uint_as_float(u << 16); }
__device__ __forceinline__ float bf_hi(unsigned u) { return __uint_as_float(u & 0xffff0000u); }
__device__ __forceinline__ float wave_sum(float v) {
#pragma unroll
    for (int o = 1; o < 64; o <<= 1) v += __shfl_xor(v, o);
    return v;
}
__device__ __forceinline__ void st4bf(bf16_t* p, f32x4 v) { u32x2 o; o.x = cvt_pk_bf16(v[0], v[1]); o.y = cvt_pk_bf16(v[2], v[3]); *(u32x2*)p = o; }
__device__ __forceinline__ f32x4 mfma16(bf16x8 a, bf16x8 b, f32x4 c) { return __builtin_amdgcn_mfma_f32_16x16x32_bf16(a, b, c, 0, 0, 0); }
__device__ __forceinline__ f32x16 mfma32(bf16x8 a, bf16x8 b, f32x16 c) { return __builtin_amdgcn_mfma_f32_32x32x16_bf16(a, b, c, 0, 0, 0); }

#define XB_TMO      128
#define XB_XCNT(j)  (256  + 64 * (j))
#define XB_XSUB(j)  (1280 + 64 * (j))
#define XB_XGEN(j)  (2304 + 64 * (j))
#define XB_TOP      3328
#define XB_TOPGEN   3392
#define XCD_BAR_WORDS 3456
#define XB_SPIN_CAP (1u << 20)
__device__ __forceinline__ unsigned xb_ld(unsigned* p)              { return __hip_atomic_load(p, __ATOMIC_RELAXED, __HIP_MEMORY_SCOPE_AGENT); }
__device__ __forceinline__ unsigned xb_add(unsigned* p, unsigned v) { return __hip_atomic_fetch_add(p, v, __ATOMIC_RELAXED, __HIP_MEMORY_SCOPE_AGENT); }
__device__ __forceinline__ unsigned xb_xcc_id() { return (unsigned)__builtin_amdgcn_s_getreg((3 << 11) | 20) & 0xFu; }
#define XB_SPIN(cond, bar) do { unsigned _sp = 0; while (cond) { __builtin_amdgcn_s_sleep(1); \
    if ((++_sp & 255u) == 0u) { if (xb_ld(&(bar)[XB_TMO])) break; if (_sp > XB_SPIN_CAP) { atomicAdd(&(bar)[XB_TMO], 1u); break; } } } } while (0)
struct XcdBarrier { unsigned* bar; unsigned x; volatile LAS unsigned* st; };
__device__ __forceinline__ XcdBarrier xcd_barrier_post(unsigned* bar, volatile LAS unsigned* st) {
    XcdBarrier b; b.bar = bar; b.x = xb_xcc_id(); b.st = st;
    if (threadIdx.x == 0) (void)xb_add(&bar[XB_XCNT(b.x)], 1u);
    return b;
}
__device__ __forceinline__ void xcd_barrier_complete(unsigned* bar, unsigned x, unsigned& nloc, unsigned& nx) {
    const unsigned G = gridDim.x * gridDim.y * gridDim.z;
    unsigned sum, cnt, mine, sp = 0u;
    for (;;) {
        sum = 0u; cnt = 0u; mine = 0u;
#pragma unroll
        for (unsigned j = 0; j < 16; ++j) { const unsigned c = xb_ld(&bar[XB_XCNT(j)]); sum += c; cnt += (c > 0u) ? 1u : 0u; mine = (j == x) ? c : mine; }
        if (sum == G) break;
        __builtin_amdgcn_s_sleep(1);
        if ((++sp & 255u) == 0u) { if (xb_ld(&bar[XB_TMO])) break; if (sp > XB_SPIN_CAP) { atomicAdd(&bar[XB_TMO], 1u); break; } }
    }
    nloc = mine > 0u ? mine : 1u; nx = cnt > 0u ? cnt : 1u;
}
__device__ __forceinline__ void xcd_barrier(const XcdBarrier& b) {
    asm volatile("s_waitcnt vmcnt(0)" ::: "memory");
    __syncthreads();
    if (threadIdx.x == 0) {
        unsigned* bar = b.bar;
        __builtin_amdgcn_s_waitcnt(0);
        unsigned nloc = b.st[0], nx = b.st[1];
        if (nloc == 0u) { xcd_barrier_complete(bar, b.x, nloc, nx); b.st[0] = nloc; b.st[1] = nx; }
        const unsigned old = xb_add(&bar[XB_XSUB(b.x)], 1u);
        const unsigned gen = old / nloc;
        if (old + 1u == (gen + 1u) * nloc) {
            __builtin_amdgcn_fence(__ATOMIC_RELEASE, "agent");
            asm volatile("s_waitcnt vmcnt(0)" ::: "memory");
            const unsigned og = xb_add(&bar[XB_TOP], 1u);
            const unsigned tg = og / nx;
            if (og + 1u == (tg + 1u) * nx) xb_add(&bar[XB_TOPGEN], 1u);
            else XB_SPIN(xb_ld(&bar[XB_TOPGEN]) == tg, bar);
            __builtin_amdgcn_fence(__ATOMIC_ACQUIRE, "agent");
            xb_add(&bar[XB_XGEN(b.x)], 1u);
            asm volatile("s_waitcnt vmcnt(0)" ::: "memory");
        } else {
            XB_SPIN(xb_ld(&bar[XB_XGEN(b.x)]) == gen, bar);
            __builtin_amdgcn_fence(__ATOMIC_ACQUIRE, "agent");
            asm volatile("s_waitcnt vmcnt(0)" ::: "memory");
        }
    }
    __syncthreads();
}

struct TJob { const float* src; bf16_t* dst; int src_ld, dst_ld, N, ktiles, ntiles, nbatch; size_t sbs, dbs; };
__device__ __forceinline__ TJob tjob(const Params& p, int j) {
    bf16_t* win = (bf16_t*)(p.ws + WS_WIN); bf16_t* w1 = (bf16_t*)(p.ws + WS_W1);
    TJob J;
    switch (j) {
    case 0:  J = TJob{p.w_in,        win,                 INW, 1024, 936, 16, 15, 1, 0, 0}; break;
    case 1:  J = TJob{p.w_in + 936,  win + 1024 * 1024,   INW, 1024, 512, 16, 8, 1, 0, 0}; break;
    case 2:  J = TJob{p.w_in + 1448, win + 1536 * 1024,   INW, 1024, 2048, 16, 32, 1, 0, 0}; break;
    case 3:  J = TJob{p.w_uv, (bf16_t*)(p.ws + WS_WUV),   512, 128, 64, 2, 1, 8, 64, 64 * 128}; break;
    case 4:  J = TJob{p.w_ba, (bf16_t*)(p.ws + WS_WA),    1024, 512, 1024, 8, 16, 1, 0, 0}; break;
    case 5:  J = TJob{p.w_out, (bf16_t*)(p.ws + WS_WO),   1024, 1024, 1024, 16, 16, 1, 0, 0}; break;
    case 6:  J = TJob{p.w_eg,       w1,                   256, 1024, 128, 16, 2, 32, 262144, 524288}; break;
    case 7:  J = TJob{p.w_eg + 128, w1 + 256 * 1024,      256, 1024, 128, 16, 2, 32, 262144, 524288}; break;
    case 8:  J = TJob{p.w_eu,       w1 + 128 * 1024,      256, 1024, 128, 16, 2, 32, 262144, 524288}; break;
    case 9:  J = TJob{p.w_eu + 128, w1 + 384 * 1024,      256, 1024, 128, 16, 2, 32, 262144, 524288}; break;
    default: J = TJob{p.w_ed, (bf16_t*)(p.ws + WS_W2),    1024, 256, 1024, 4, 16, 32, 262144, 262144}; break;
    }
    return J;
}
constexpr int NTJOBS = 11;
__device__ __forceinline__ int tjob_tiles(int j) {
    constexpr int t[NTJOBS] = {240, 128, 512, 16, 128, 256, 1024, 1024, 1024, 1024, 2048};
    return t[j];
}
constexpr int P0_TILES = 240 + 128 + 512 + 16 + 128 + 256 + 4096 + 2048;
constexpr int P0_WUK = 16, P0_WF = 512, P0_PAD = 11, P0_WR = 48, P0_NORM = MPAD / 8;
constexpr int P0_ITEMS = P0_TILES + P0_WUK + P0_WF + P0_PAD + P0_WR + P0_NORM;

__device__ __forceinline__ void p0_phase(const Params& p, LAS char* lds) {
    const int tid = threadIdx.x, wid = tid >> 6, lane = tid & 63;
    LAS float* tile = (LAS float*)lds;
    for (int it = blockIdx.x; it < P0_ITEMS; it += gridDim.x) {
        int r = it;
        if (r < P0_TILES) {
            int j = 0;
#pragma unroll 1
            for (; j < NTJOBS - 1; ++j) { const int n = tjob_tiles(j); if (r < n) break; r -= n; }
            const TJob J = tjob(p, j);
            const int per = J.ktiles * J.ntiles, bi = r / per, rr = r % per, kt = rr / J.ntiles, nt = rr % J.ntiles;
            const float* src = J.src + (size_t)bi * J.sbs; bf16_t* dst = J.dst + (size_t)bi * J.dbs;
            const int k0 = kt * 64, n0 = nt * 64;
#pragma unroll
            for (int i = 0; i < 2; ++i) {
                const int kk = (tid >> 4) + 32 * i, n4 = (tid & 15) * 4;
                f32x4 v = {0.f, 0.f, 0.f, 0.f};
                if (n0 + n4 < J.N) v = *(const f32x4*)(src + (size_t)(k0 + kk) * J.src_ld + n0 + n4);
                tile[kk * 65 + n4 + 0] = v[0]; tile[kk * 65 + n4 + 1] = v[1]; tile[kk * 65 + n4 + 2] = v[2]; tile[kk * 65 + n4 + 3] = v[3];
            }
            __syncthreads();
            {
                const int n = tid >> 3, kc = tid & 7;
                if (n0 + n < J.N) {
                    const LAS float* s = tile + (kc * 8) * 65 + n;
                    u32x4 o; o.x = cvt_pk_bf16(s[0], s[65]); o.y = cvt_pk_bf16(s[130], s[195]); o.z = cvt_pk_bf16(s[260], s[325]); o.w = cvt_pk_bf16(s[390], s[455]);
                    *(u32x4*)(dst + (size_t)(n0 + n) * J.dst_ld + k0 + kc * 8) = o;
                }
            }
            __syncthreads();
            continue;
        }
        r -= P0_TILES;
        if (r < P0_WUK) {
            const int o = r * 4096 + tid * 8, h = o >> 13, c = (o >> 6) & 127, d = o & 63;
            const float* s = p.w_uk + c * 512 + h * 64 + d;
            const f32x4 a = *(const f32x4*)s, b = *(const f32x4*)(s + 4);
            u32x4 w; w.x = cvt_pk_bf16(a[0], a[1]); w.y = cvt_pk_bf16(a[2], a[3]); w.z = cvt_pk_bf16(b[0], b[1]); w.w = cvt_pk_bf16(b[2], b[3]);
            *(u32x4*)((bf16_t*)(p.ws + WS_WUK) + o) = w;
            continue;
        }
        r -= P0_WUK;
        if (r < P0_WF) {
            const int k = r, g = k >> 7;
            LAS float* coef = (LAS float*)lds;
            if (tid < 128) coef[tid] = p.w_pool[(size_t)k * 128 + tid] * p.pool_scale[g * 128 + tid];
            __syncthreads();
            float a0 = 0.f, a1 = 0.f;
            const float* wb = p.w_bp + (size_t)(g * 128) * 1024 + tid;
#pragma unroll 8
            for (int d = 0; d < 128; ++d) { const float cf = coef[d]; a0 += cf * wb[(size_t)d * 1024]; a1 += cf * wb[(size_t)d * 1024 + 512]; }
            bf16_t* wf = (bf16_t*)(p.ws + WS_WF);
            wf[(size_t)tid * 512 + k] = (bf16_t)(cvt_pk_bf16(a0, 0.f) & 0xffff);
            wf[(size_t)(tid + 512) * 512 + k] = (bf16_t)(cvt_pk_bf16(a1, 0.f) & 0xffff);
            __syncthreads();
            continue;
        }
        r -= P0_WF;
        if (r < P0_PAD) {
            bf16_t* win = (bf16_t*)(p.ws + WS_WIN) + (size_t)(936 + r * 8) * 1024;
            const u32x4 z = {0u, 0u, 0u, 0u};
            *(u32x4*)(win + tid * 8) = z; *(u32x4*)(win + 4096 + tid * 8) = z;
            continue;
        }
        r -= P0_PAD;
        if (r < P0_WR) {
            bf16_t* wh = (bf16_t*)(p.ws + WS_WRH) + (size_t)r * 1024; bf16_t* wl = (bf16_t*)(p.ws + WS_WRL) + (size_t)r * 1024;
#pragma unroll
            for (int i = 0; i < 2; ++i) {
                const int k = tid + 512 * i;
                const float w = r < 4 ? p.w_gr[(size_t)k * 4 + r] : (r < 36 ? p.w_er[(size_t)k * 32 + (r - 4)] : 0.f);
                const unsigned h = cvt_pk_bf16(w, 0.f) & 0xffffu;
                wh[k] = (bf16_t)h; wl[k] = (bf16_t)(cvt_pk_bf16(w - bf_lo(h), 0.f) & 0xffffu);
            }
            continue;
        }
        r -= P0_WR;
        {
            const int R = r * 8 + wid;
            bf16_t* urow = (bf16_t*)(p.ws + WS_U) + (size_t)R * 1024;
            if (R < MALL) {
                const int b = R / TT, t = R - b * TT;
                const float* src = (t < 16) ? (p.meta + (size_t)t * 1024) : (p.x + ((size_t)b * SEQ + (t - 16)) * 1024);
                f32x4 v[4]; float ss = 0.f;
#pragma unroll
                for (int j = 0; j < 4; ++j) { v[j] = *(const f32x4*)(src + j * 256 + lane * 4); ss += v[j][0] * v[j][0] + v[j][1] * v[j][1] + v[j][2] * v[j][2] + v[j][3] * v[j][3]; }
                ss = wave_sum(ss);
                const float rstd = rsqrtf(ss * (1.f / 1024.f) + EPS);
#pragma unroll
                for (int j = 0; j < 4; ++j) { const f32x4 g = *(const f32x4*)(p.norm1_g + j * 256 + lane * 4); st4bf(urow + j * 256 + lane * 4, v[j] * rstd * g); }
            } else {
                const u32x2 z = {0u, 0u};
#pragma unroll
                for (int j = 0; j < 4; ++j) *(u32x2*)(urow + j * 256 + lane * 4) = z;
            }
        }
    }
}

namespace g8 {
constexpr int BM = 256, BK = 64, HALF = 128, HTB = HALF * BK * 2, STAGE_BYTES = 8 * HTB, NXCD = 8, WGM = 8;
__device__ __forceinline__ int lds_byte(int r, int c) { const int st = (r >> 4) * 2 + (c >> 5), rr = r & 15, cc = c & 31, ob = rr * 64 + cc * 2; return st * 1024 + (ob ^ (((ob >> 9) & 1) << 5)); }
__device__ __forceinline__ void stage_rc(int b, int& R, int& C) { const int st = b / 1024, sb = b % 1024, swz = sb ^ (((sb >> 9) & 1) << 5); R = (st >> 1) * 16 + swz / 64; C = (st & 1) * 32 + (swz % 64) / 2; }

struct Unit { const char* A; const char* B; int i0, i1, i2, i3; unsigned va[2][2]; };

struct TileOrder {
    int nM, nN, nwg, G, c;
    __device__ __forceinline__ void init(int nM_, int nN_, int G_, int c_) { nM = nM_; nN = nN_; nwg = nM * nN; G = G_; c = c_; }
    __device__ __forceinline__ bool tile(int i, int& pm, int& pn) const {
        const long L = (long)i * G + c; if (L >= nwg) return false;
        int wgid = (int)L; { const int q = nwg / NXCD, r = nwg % NXCD, xcd = wgid % NXCD, off = wgid / NXCD; wgid = (xcd < r ? xcd * (q + 1) : r * (q + 1) + (xcd - r) * q) + off; }
        const int nig = WGM * nN, gid = wgid / nig, fm = gid * WGM, gsz = (nM - fm) < WGM ? (nM - fm) : WGM;
        pm = fm + ((wgid % nig) % gsz); pn = (wgid % nig) / gsz; return true;
    }
};

template <class Epi, class Sched, bool GATHER>
__device__ __forceinline__ void gemm_phase(LAS char* lds, const int K, const Sched& S, const Epi& E) {
    const int tid = threadIdx.x, wid = __builtin_amdgcn_readfirstlane(tid >> 6), lane = tid & 63, wr = wid >> 2, wc = wid & 3, fr = lane & 15, fq = lane >> 4;
    const int nt = K / BK;
    unsigned voff[2];
#pragma unroll
    for (int i = 0; i < 2; ++i) { int R_, C_; stage_rc(tid * 16 + i * 8192, R_, C_); voff[i] = (unsigned)(R_ * K + C_) * 2u; }
    const size_t kstep = (size_t)(BK * 2);
    const size_t hstep = (size_t)HALF * K * 2;
    const unsigned ldsw = (unsigned)wid * 1024u;
    const int aoff = lds_byte(wr * 64 + fr, fq * 8), boff = lds_byte(wc * 32 + fr, fq * 8);
#define G8_SA(b, h) (((b) * 2 + (h)) * HTB)
#define G8_SB(b, h) ((4 + (b) * 2 + (h)) * HTB)
#define G8_GLDS(bufoff, ptr, i_) __builtin_amdgcn_global_load_lds((const unsigned*)(ptr), (LAS unsigned*)(lds + (bufoff) + ldsw + (i_) * 8192), 16, 0, 0)
#define G8_STAGE_B(bufoff, gbase) do { _Pragma("unroll") for (int _i = 0; _i < 2; ++_i) G8_GLDS(bufoff, (const char*)(gbase) + voff[_i], _i); } while (0)
#define G8_STAGE_A(bufoff, abase, vA, h) do { _Pragma("unroll") for (int _i = 0; _i < 2; ++_i) \
        G8_GLDS(bufoff, GATHER ? ((const char*)(abase) + (vA)[h][_i]) : ((const char*)(abase) + (size_t)(h) * hstep + voff[_i]), _i); } while (0)
#define G8_LDA(dst, b, h) do { _Pragma("unroll") for (int m = 0; m < 4; ++m) _Pragma("unroll") for (int k = 0; k < 2; ++k) dst[m][k] = *(const LAS bf16x8*)(lds + G8_SA(b, h) + aoff + m * 2048 + k * 1024); } while (0)
#define G8_LDB(dst, b, h) do { _Pragma("unroll") for (int n = 0; n < 2; ++n) _Pragma("unroll") for (int k = 0; k < 2; ++k) dst[n][k] = *(const LAS bf16x8*)(lds + G8_SB(b, h) + boff + n * 2048 + k * 1024); } while (0)
#define G8_MMA(ai, bj, At, Bt) do { __builtin_amdgcn_s_setprio(1); _Pragma("unroll") for (int m = 0; m < 4; ++m) _Pragma("unroll") for (int n = 0; n < 2; ++n) _Pragma("unroll") for (int k = 0; k < 2; ++k) \
        acc[ai][bj][m][n] = __builtin_amdgcn_mfma_f32_16x16x32_bf16(Bt[n][k], At[m][k], acc[ai][bj][m][n], 0, 0, 0); __builtin_amdgcn_s_setprio(0); } while (0)
#define G8_WAIT_V(n) asm volatile("s_waitcnt vmcnt(" #n ")" ::: "memory")
#define G8_WAIT_L(n) asm volatile("s_waitcnt lgkmcnt(" #n ")" ::: "memory")
#define G8_BAR __builtin_amdgcn_s_barrier()
#define G8_SCHED __builtin_amdgcn_sched_barrier(0)
    Unit cur, nxt; int ui = 0;
    cur.A = nullptr; cur.B = nullptr; cur.i0 = cur.i1 = cur.i2 = cur.i3 = 0; cur.va[0][0] = cur.va[0][1] = cur.va[1][0] = cur.va[1][1] = 0u; nxt = cur;
    if (!S.next(0, cur, tid)) return;
    f32x4 acc[2][2][4][2];
#pragma unroll
    for (int a = 0; a < 2; ++a)
#pragma unroll
        for (int b = 0; b < 2; ++b)
#pragma unroll
            for (int m = 0; m < 4; ++m)
#pragma unroll
                for (int n = 0; n < 2; ++n) acc[a][b][m][n] = (f32x4){0.f, 0.f, 0.f, 0.f};
    bf16x8 At[4][2], B0[2][2], B1[2][2];
    G8_STAGE_B(G8_SB(0, 0), cur.B); G8_STAGE_B(G8_SB(0, 1), cur.B + hstep); G8_STAGE_A(G8_SA(0, 0), cur.A, cur.va, 0); G8_STAGE_A(G8_SA(0, 1), cur.A, cur.va, 1);
    if (wr == 1) G8_BAR;
    G8_WAIT_V(2); G8_BAR;
    G8_STAGE_B(G8_SB(1, 0), cur.B + kstep); G8_STAGE_A(G8_SA(1, 0), cur.A + kstep, cur.va, 0); G8_STAGE_B(G8_SB(1, 1), cur.B + hstep + kstep);
    G8_WAIT_V(6); G8_BAR;
    for (;;) {
        const bool has_next = S.next(ui + 1, nxt, tid);
        if (!has_next) nxt = cur;
#pragma unroll 1
        for (int t = 0; t < nt; t += 2) {
            const bool last = (t == nt - 2);
            const char* a1 = cur.A + (size_t)(t + 1) * kstep;
            const char* a2 = last ? nxt.A : cur.A + (size_t)(t + 2) * kstep; const char* b2 = last ? nxt.B : cur.B + (size_t)(t + 2) * kstep;
            const char* a3 = a2 + kstep; const char* b3 = b2 + kstep;
            G8_LDB(B0, 0, 0); G8_LDB(B1, 0, 1); G8_SCHED; G8_LDA(At, 0, 0); G8_STAGE_A(G8_SA(1, 1), a1, cur.va, 1);
            if (GATHER && last) {
#pragma unroll
                for (int h = 0; h < 2; ++h)
#pragma unroll
                    for (int i = 0; i < 2; ++i) cur.va[h][i] = nxt.va[h][i];
            }
            G8_WAIT_V(8); G8_WAIT_L(0); G8_BAR; G8_MMA(0, 0, At, B0); G8_MMA(0, 1, At, B1); G8_BAR; G8_SCHED;
            G8_LDA(At, 0, 1); G8_STAGE_B(G8_SB(0, 0), b2); G8_STAGE_B(G8_SB(0, 1), b2 + hstep); G8_STAGE_A(G8_SA(0, 0), a2, cur.va, 0);
            G8_WAIT_V(8); G8_WAIT_L(0); G8_BAR; G8_MMA(1, 0, At, B0); G8_MMA(1, 1, At, B1); G8_BAR; G8_SCHED;
            G8_LDB(B0, 1, 0); G8_LDB(B1, 1, 1); G8_SCHED; G8_LDA(At, 1, 0); G8_STAGE_A(G8_SA(0, 1), a2, cur.va, 1);
            G8_WAIT_V(8); G8_WAIT_L(0); G8_BAR; G8_MMA(0, 0, At, B0); G8_MMA(0, 1, At, B1); G8_BAR; G8_SCHED;
            G8_LDA(At, 1, 1); G8_STAGE_B(G8_SB(1, 0), b3); G8_STAGE_B(G8_SB(1, 1), b3 + hstep); G8_STAGE_A(G8_SA(1, 0), a3, cur.va, 0);
            G8_WAIT_V(8); G8_WAIT_L(0); G8_BAR; G8_MMA(1, 0, At, B0); G8_MMA(1, 1, At, B1); G8_BAR; G8_SCHED;
        }
        if (wr == 0) G8_BAR;
        { int efr = fr, efq = fq; asm volatile("" : "+v"(efr), "+v"(efq));
          E(acc, cur, wr, wc, efr, efq, lds + STAGE_BYTES); }
        if (!has_next) break;
#pragma unroll
        for (int a = 0; a < 2; ++a)
#pragma unroll
            for (int b = 0; b < 2; ++b)
#pragma unroll
                for (int m = 0; m < 4; ++m)
#pragma unroll
                    for (int n = 0; n < 2; ++n) acc[a][b][m][n] = (f32x4){0.f, 0.f, 0.f, 0.f};
        cur = nxt; ++ui;
        if (wr == 1) G8_BAR;
    }
    G8_WAIT_V(0);
    G8_BAR;
#undef G8_SA
#undef G8_SB
#undef G8_GLDS
#undef G8_STAGE_A
#undef G8_STAGE_B
#undef G8_LDA
#undef G8_LDB
#undef G8_MMA
#undef G8_WAIT_V
#undef G8_WAIT_L
#undef G8_BAR
#undef G8_SCHED
}
}
constexpr int GX_OFF = g8::STAGE_BYTES;

#define FOR_ACC(ai, bj, m, n) \
    _Pragma("unroll") for (int ai = 0; ai < 2; ++ai) _Pragma("unroll") for (int bj = 0; bj < 2; ++bj) \
    _Pragma("unroll") for (int m = 0; m < 4; ++m) _Pragma("unroll") for (int n = 0; n < 2; ++n)
__device__ __forceinline__ int vcu_id() { const int G = gridDim.x, bx = blockIdx.x; return (G % 8 == 0) ? (bx % 8) * (G / 8) + bx / 8 : bx; }

struct P1Sched {
    g8::TileOrder T; const char* U; const char* W;
    __device__ __forceinline__ bool next(int i, g8::Unit& u, int) const {
        int pm, pn; if (!T.tile(i, pm, pn)) return false;
        u.A = U + (size_t)pm * 256 * 1024 * 2; u.B = W + (size_t)pn * 256 * 1024 * 2; u.i0 = pm; u.i1 = pn; return true;
    }
};
struct P1Epi {
    const Params* pp;
    __device__ __forceinline__ void operator()(f32x4 (&acc)[2][2][4][2], const g8::Unit& u, int wr, int wc, int fr, int fq, LAS char* xl) const {
        const Params& p = *pp;
        bf16_t* Q = (bf16_t*)(p.ws + WS_Q); bf16_t* C = (bf16_t*)(p.ws + WS_C); bf16_t* IQ = (bf16_t*)(p.ws + WS_IQ); bf16_t* IK = (bf16_t*)(p.ws + WS_IK);
        float* IW = (float*)(p.ws + WS_IW); bf16_t* PV = (bf16_t*)(p.ws + WS_PV); bf16_t* GT = (bf16_t*)(p.ws + WS_GATES);
        const int pm = u.i0, pn = u.i1;
        const int rowb = pm * 256 + wr * 64 + fr, colb = wc * 32 + 4 * fq;
        if (pn < 2) {
            FOR_ACC(ai, bj, m, n) st4bf(Q + (size_t)(rowb + ai * 128 + m * 16) * 512 + pn * 256 + bj * 128 + colb + n * 16, acc[ai][bj][m][n]);
        } else if (pn == 2) {
            LAS float* part = (LAS float*)xl;
#pragma unroll
            for (int ai = 0; ai < 2; ++ai)
#pragma unroll
                for (int m = 0; m < 4; ++m) {
                    float s = 0.f;
#pragma unroll
                    for (int n = 0; n < 2; ++n) { const f32x4 v = acc[ai][0][m][n]; s += v[0] * v[0] + v[1] * v[1] + v[2] * v[2] + v[3] * v[3]; }
                    s += __shfl_xor(s, 16); s += __shfl_xor(s, 32);
                    if (fq == 0) part[(ai * 128 + wr * 64 + m * 16 + fr) * 4 + wc] = s;
                }
            __syncthreads();
#pragma unroll
            for (int ai = 0; ai < 2; ++ai)
#pragma unroll
                for (int m = 0; m < 4; ++m) {
                    const int lr = ai * 128 + wr * 64 + m * 16 + fr;
                    const f32x4 ps = *(LAS f32x4*)(part + lr * 4);
                    const float rstd = rsqrtf((ps[0] + ps[1] + ps[2] + ps[3]) * (1.f / 128.f) + EPS);
                    const size_t R = (size_t)(rowb + ai * 128 + m * 16);
#pragma unroll
                    for (int n = 0; n < 2; ++n) {
                        const f32x4 g = *(const f32x4*)(p.kv_norm_g + colb + n * 16);
                        st4bf(C + R * 128 + colb + n * 16, acc[ai][0][m][n] * rstd * g);
                        st4bf(IQ + R * 256 + colb + n * 16, acc[ai][1][m][n]);
                    }
                }
            __syncthreads();
        } else if (pn == 3) {
#pragma unroll
            for (int ai = 0; ai < 2; ++ai)
#pragma unroll
                for (int m = 0; m < 4; ++m) {
                    const size_t R = (size_t)(rowb + ai * 128 + m * 16);
#pragma unroll
                    for (int n = 0; n < 2; ++n) {
                        st4bf(IQ + R * 256 + 128 + colb + n * 16, acc[ai][0][m][n]);
                        if (wc == 0) st4bf(IK + R * 32 + n * 16 + 4 * fq, acc[ai][1][m][n]);
                        if (wc == 1 && n == 0 && fq < 2) *(f32x4*)(IW + R * 8 + 4 * fq) = acc[ai][1][m][n] * IDX_SCALE;
                    }
                }
        } else if (pn < 6) {
            FOR_ACC(ai, bj, m, n) st4bf(PV + (size_t)(rowb + ai * 128 + m * 16) * 512 + (pn - 4) * 256 + bj * 128 + colb + n * 16, acc[ai][bj][m][n]);
        } else {
            FOR_ACC(ai, bj, m, n) {
                f32x4 v = acc[ai][bj][m][n];
#pragma unroll
                for (int r = 0; r < 4; ++r) v[r] = __builtin_amdgcn_rcpf(1.f + __expf(-v[r]));
                st4bf(GT + (size_t)(rowb + ai * 128 + m * 16) * 2048 + (pn - 6) * 256 + bj * 128 + colb + n * 16, v);
            }
        }
    }
};
__device__ __forceinline__ void p1_phase(const Params& p, LAS char* lds) {
    P1Sched S; S.T.init(MPAD / 256, INP / 256, gridDim.x, blockIdx.x); S.U = (const char*)(p.ws + WS_U); S.W = (const char*)(p.ws + WS_WIN);
    P1Epi E{&p};
    g8::gemm_phase<P1Epi, P1Sched, false>(lds, 1024, S, E);
}
constexpr int SC_STRIDE = 2068;
constexpr int SC_BYTES = 16 * SC_STRIDE * 4;
constexpr int MASK_OFF = SC_BYTES;
constexpr int QS_STRIDE = 136;
constexpr float DEFER_THR = 6.0f;

__device__ __forceinline__ int kv_off(int row, int ch) { return 256 * row + 16 * (ch ^ (((row & 3) << 2) | ((row >> 2) & 3))); }
__device__ __forceinline__ unsigned f2ord(float f) { const unsigned u = __float_as_uint(f); return (u & 0x80000000u) ? ~u : (u | 0x80000000u); }
__device__ __forceinline__ int wave_sum_dpp(int v) {
    v += __builtin_amdgcn_update_dpp(0, v, 0x111, 0xf, 0xf, false);
    v += __builtin_amdgcn_update_dpp(0, v, 0x112, 0xf, 0xf, false);
    v += __builtin_amdgcn_update_dpp(0, v, 0x114, 0xf, 0xf, false);
    v += __builtin_amdgcn_update_dpp(0, v, 0x118, 0xf, 0xf, false);
    v += __builtin_amdgcn_update_dpp(0, v, 0x142, 0xa, 0xf, false);
    v += __builtin_amdgcn_update_dpp(0, v, 0x143, 0xc, 0xf, false);
    return __builtin_amdgcn_readlane(v, 63);
}

__device__ __forceinline__ void attn_item(const Params& p, int b, int j, int half, LAS char* lds) {
    int tid_ = threadIdx.x; asm volatile("" : "+v"(tid_));
    const int tid = tid_, wid = __builtin_amdgcn_readfirstlane(tid >> 6), lane = tid & 63, fr = lane & 15, fq = lane >> 4;
    const int nadm = 16 + 64 * j;
    const int t0 = 16 + 64 * (j - 1) + 32 * half;
    const size_t Rq0 = (size_t)b * TT + t0, Rk0 = (size_t)b * TT;
    const bf16_t* Q = (const bf16_t*)(p.ws + WS_Q); const bf16_t* C = (const bf16_t*)(p.ws + WS_C); const bf16_t* IQ = (const bf16_t*)(p.ws + WS_IQ);
    const bf16_t* IK = (const bf16_t*)(p.ws + WS_IK); const float* IW = (const float*)(p.ws + WS_IW);
    LAS unsigned* maskw = (LAS unsigned*)(lds + MASK_OFF);
    const int h = wid;

    {
        const bf16_t* Wuk = (const bf16_t*)(p.ws + WS_WUK) + (size_t)h * 128 * 64;
        bf16x8 bq[2][2];
#pragma unroll
        for (int qt = 0; qt < 2; ++qt)
#pragma unroll
            for (int ks = 0; ks < 2; ++ks) bq[qt][ks] = *(const bf16x8*)(Q + (Rq0 + qt * 16 + fr) * 512 + h * 64 + ks * 32 + fq * 8);
        LAS bf16_t* qs = (LAS bf16_t*)lds + (size_t)h * 32 * QS_STRIDE;
#pragma unroll
        for (int ct = 0; ct < 8; ++ct) {
            const bf16x8 a0 = *(const bf16x8*)(Wuk + (ct * 16 + fr) * 64 + fq * 8), a1 = *(const bf16x8*)(Wuk + (ct * 16 + fr) * 64 + 32 + fq * 8);
#pragma unroll
            for (int qt = 0; qt < 2; ++qt) {
                f32x4 d = {0.f, 0.f, 0.f, 0.f};
                d = mfma16(a0, bq[qt][0], d); d = mfma16(a1, bq[qt][1], d);
                d = d * (ATTN_SCALE * LOG2E);
                u32x2 o; o.x = cvt_pk_bf16(d[0], d[1]); o.y = cvt_pk_bf16(d[2], d[3]);
                *(LAS u32x2*)(qs + (qt * 16 + fr) * QS_STRIDE + ct * 16 + 4 * fq) = o;
            }
        }
    }
    __syncthreads();
    bf16x8 qf[8];
    {
        const LAS bf16_t* qs = (const LAS bf16_t*)lds + (size_t)h * 32 * QS_STRIDE + (lane & 31) * QS_STRIDE + (lane >> 5) * 8;
#pragma unroll
        for (int ks = 0; ks < 8; ++ks) qf[ks] = *(const LAS bf16x8*)(qs + ks * 16);
    }
    __syncthreads();

    if (nadm <= 256) {
        for (int idx = tid; idx < 32 * 66; idx += 512) {
            const int w = idx % 66; const int lo = w * 32;
            unsigned v = 0u;
            if (lo + 32 <= nadm) v = 0xffffffffu; else if (lo < nadm) v = (1u << (nadm - lo)) - 1u;
            maskw[idx] = v;
        }
    } else {
        LAS float* sc = (LAS float*)lds;
        const int nkt = nadm >> 4;
        const int ni = (nadm + 63) >> 6;
#pragma unroll 1
        for (int sub = 0; sub < 2; ++sub) {
            {
                bf16x8 bq[8]; float wq[8];
                const size_t Rq = Rq0 + sub * 16 + fr;
#pragma unroll
                for (int hh = 0; hh < 8; ++hh) { bq[hh] = *(const bf16x8*)(IQ + Rq * 256 + hh * 32 + fq * 8); }
                { const f32x4 w0 = *(const f32x4*)(IW + Rq * 8), w1 = *(const f32x4*)(IW + Rq * 8 + 4);
                  wq[0] = w0[0]; wq[1] = w0[1]; wq[2] = w0[2]; wq[3] = w0[3]; wq[4] = w1[0]; wq[5] = w1[1]; wq[6] = w1[2]; wq[7] = w1[3]; }
                const bf16_t* ikp = IK + (Rk0 + fr) * 32 + fq * 8;
                bf16x8 a = *(const bf16x8*)(ikp + (size_t)wid * 16 * 32);
#pragma unroll 1
                for (int kt = wid; kt < nkt; kt += 8) {
                    const int ktn = (kt + 8 < nkt) ? kt + 8 : kt;
                    const bf16x8 an = *(const bf16x8*)(ikp + (size_t)ktn * 16 * 32);
                    f32x4 s = {0.f, 0.f, 0.f, 0.f};
#pragma unroll
                    for (int hh = 0; hh < 8; ++hh) {
                        f32x4 d = {0.f, 0.f, 0.f, 0.f};
                        d = mfma16(a, bq[hh], d);
#pragma unroll
                        for (int r = 0; r < 4; ++r) s[r] += fmaxf(d[r], 0.f) * wq[hh];
                    }
                    *(LAS f32x4*)(sc + fr * SC_STRIDE + kt * 16 + 4 * fq) = s;
                    a = an;
                }
            }
            __syncthreads();
#pragma unroll 1
            for (int qq = 0; qq < 2; ++qq) {
                const int ql = 2 * wid + qq;
                unsigned key[33];
                int nadm_q = nadm; asm volatile("" : "+s"(nadm_q));
#pragma unroll
                for (int i = 0; i < 33; ++i) { const int k = lane + 64 * i; const unsigned o = f2ord(sc[ql * SC_STRIDE + k]); key[i] = (k < nadm_q) ? o : 0u; }
                unsigned prefix = 0u; bool exact = false;
#pragma unroll 1
                for (int bit = 31; bit >= 0; --bit) {
                    const unsigned cand = prefix | (1u << bit);
                    int c = 0;
#pragma unroll
                    for (int g = 0; g < 33; g += 8)
                        if (g < ni) {
#pragma unroll
                            for (int i = g; i < g + 8 && i < 33; ++i) c += (key[i] >= cand) ? 1 : 0;
                        }
                    c = wave_sum_dpp(c);
                    if (c >= 256) prefix = cand;
                    if (c == 256) { exact = true; break; }
                }
                int need = 0;
                if (!exact) {
                    int cg = 0;
#pragma unroll
                    for (int i = 0; i < 33; ++i) cg += (key[i] > prefix) ? 1 : 0;
                    need = 256 - wave_sum_dpp(cg);
                }
                int running = 0;
                const unsigned long long lt = (1ull << lane) - 1ull;
#pragma unroll
                for (int i = 0; i < 33; ++i) {
                    bool sel;
                    if (exact) sel = key[i] >= prefix;
                    else {
                        const bool eq = key[i] == prefix;
                        const unsigned long long be = __ballot(eq);
                        const int rank = running + __popcll(be & lt);
                        sel = (key[i] > prefix) || (eq && rank < need);
                        running += __popcll(be);
                    }
                    const unsigned long long bs = __ballot(sel);
                    if (lane == 0) { maskw[(sub * 16 + ql) * 66 + 2 * i] = (unsigned)bs; maskw[(sub * 16 + ql) * 66 + 2 * i + 1] = (unsigned)(bs >> 32); }
                    __builtin_amdgcn_sched_barrier(0);
                }
            }
            __syncthreads();
        }
    }
    __syncthreads();

    const int ntile = (nadm + 63) >> 6;
    f32x16 O[4];
#pragma unroll
    for (int mt = 0; mt < 4; ++mt)
#pragma unroll
        for (int r = 0; r < 16; ++r) O[mt][r] = 0.f;
    float mrun = -1e30f, lrun = 0.f;
    {
        const bf16_t* kvsrc = C + (Rk0 + (tid >> 4)) * 128 + (tid & 15) * 8;
        const int kvdst0 = kv_off(tid >> 4, tid & 15), kvdst1 = kv_off((tid >> 4) + 32, tid & 15);
        u32x4 rr0 = *(const u32x4*)kvsrc, rr1 = *(const u32x4*)(kvsrc + 32 * 128);
        *(LAS u32x4*)(lds + kvdst0) = rr0; *(LAS u32x4*)(lds + kvdst1) = rr1;
        __syncthreads();
        const int hq = lane >> 5, ql = lane & 31;
        const int tg = lane >> 4, ti = lane & 15, tq = ti >> 2, tp = ti & 3;
#pragma unroll 1
        for (int T = 0; T < ntile; ++T) {
            const bool more = T + 1 < ntile;
            if (more) { rr0 = *(const u32x4*)(kvsrc + (size_t)(T + 1) * 64 * 128); rr1 = *(const u32x4*)(kvsrc + (size_t)(T + 1) * 64 * 128 + 32 * 128); }
            LAS char* kb = lds + (T & 1) * 16384;
            f32x16 S[2];
#pragma unroll
            for (int kh = 0; kh < 2; ++kh) {
#pragma unroll
                for (int r = 0; r < 16; ++r) S[kh][r] = 0.f;
#pragma unroll
                for (int ks = 0; ks < 8; ++ks) {
                    const bf16x8 a = *(LAS bf16x8*)(kb + kv_off(32 * kh + ql, 2 * ks + hq));
                    S[kh] = mfma32(a, qf[ks], S[kh]);
                }
            }
            const u32x2 mw2 = *(LAS u32x2*)(maskw + ql * 66 + 2 * T);
            float mx = -INFINITY;
#pragma unroll
            for (int kh = 0; kh < 2; ++kh) {
                const int mw = (int)((kh ? mw2.y : mw2.x) >> (4 * hq));
#pragma unroll
                for (int r = 0; r < 16; ++r) {
                    const int m = __builtin_amdgcn_sbfe(mw, (r & 3) + 8 * (r >> 2), 1);
                    S[kh][r] = __uint_as_float((__float_as_uint(S[kh][r]) & (unsigned)m) | (~(unsigned)m & 0xff800000u));
                    mx = fmaxf(mx, S[kh][r]);
                }
            }
            mx = fmaxf(mx, __shfl_xor(mx, 32));
            if (__any(mx > mrun + DEFER_THR)) {
                const float mnew = fmaxf(mrun, mx);
                const float alpha = __builtin_amdgcn_exp2f(mrun - mnew);
                lrun *= alpha; mrun = mnew;
#pragma unroll
                for (int mt = 0; mt < 4; ++mt)
#pragma unroll
                    for (int r = 0; r < 16; ++r) O[mt][r] *= alpha;
            }
            float rs = 0.f;
#pragma unroll
            for (int kh = 0; kh < 2; ++kh)
#pragma unroll
                for (int r = 0; r < 16; ++r) { S[kh][r] = __builtin_amdgcn_exp2f(S[kh][r] - mrun); rs += S[kh][r]; }
            rs += __shfl_xor(rs, 32);
            lrun += rs;
            bf16x8 pf[4];
#pragma unroll
            for (int s2 = 0; s2 < 4; ++s2) {
                const int kh = s2 >> 1, o = 8 * (s2 & 1);
                u32x4 w;
                w.x = cvt_pk_bf16(S[kh][o + 0], S[kh][o + 1]); w.y = cvt_pk_bf16(S[kh][o + 2], S[kh][o + 3]);
                w.z = cvt_pk_bf16(S[kh][o + 4], S[kh][o + 5]); w.w = cvt_pk_bf16(S[kh][o + 6], S[kh][o + 7]);
                pf[s2] = __builtin_bit_cast(bf16x8, w);
            }
#pragma unroll
            for (int mt = 0; mt < 4; ++mt)
#pragma unroll
                for (int s2 = 0; s2 < 4; ++s2) {
                    const int colb = 32 * mt + 16 * (tg & 1) + 4 * tp;
                    const int row1 = 16 * s2 + 4 * (tg >> 1) + tq;
                    const s16x4 v0 = __builtin_amdgcn_ds_read_tr16_b64_v4i16((LAS s16x4*)(kb + kv_off(row1, colb >> 3) + (colb & 7) * 2));
                    const s16x4 v1 = __builtin_amdgcn_ds_read_tr16_b64_v4i16((LAS s16x4*)(kb + kv_off(row1 + 8, colb >> 3) + (colb & 7) * 2));
                    bf16x8 a; a[0] = v0[0]; a[1] = v0[1]; a[2] = v0[2]; a[3] = v0[3]; a[4] = v1[0]; a[5] = v1[1]; a[6] = v1[2]; a[7] = v1[3];
                    O[mt] = mfma32(a, pf[s2], O[mt]);
                }
            if (more) { LAS char* nb = lds + ((T + 1) & 1) * 16384; *(LAS u32x4*)(nb + kvdst0) = rr0; *(LAS u32x4*)(nb + kvdst1) = rr1; }
            __syncthreads();
        }
    }
    {
        const float inv = 1.f / lrun;
        const int hq = lane >> 5, ql = lane & 31;
        LAS bf16_t* os = (LAS bf16_t*)(lds + 32768) + (size_t)h * 32 * QS_STRIDE;
#pragma unroll
        for (int mt = 0; mt < 4; ++mt)
#pragma unroll
            for (int rg = 0; rg < 4; ++rg) {
                u32x2 o; o.x = cvt_pk_bf16(O[mt][4 * rg] * inv, O[mt][4 * rg + 1] * inv); o.y = cvt_pk_bf16(O[mt][4 * rg + 2] * inv, O[mt][4 * rg + 3] * inv);
                *(LAS u32x2*)(os + ql * QS_STRIDE + 32 * mt + 8 * rg + 4 * hq) = o;
            }
        __syncthreads();
        const bf16_t* Wuv = (const bf16_t*)(p.ws + WS_WUV) + (size_t)h * 64 * 128;
        bf16_t* AT = (bf16_t*)(p.ws + WS_ATTN);
        const size_t n0 = (size_t)b * SEQ + (t0 - 16);
        bf16x8 bo[2][4];
#pragma unroll
        for (int qt = 0; qt < 2; ++qt)
#pragma unroll
            for (int ks = 0; ks < 4; ++ks) bo[qt][ks] = *(LAS bf16x8*)(os + (qt * 16 + fr) * QS_STRIDE + ks * 32 + fq * 8);
#pragma unroll
        for (int dt = 0; dt < 4; ++dt) {
            bf16x8 a[4];
#pragma unroll
            for (int ks = 0; ks < 4; ++ks) a[ks] = *(const bf16x8*)(Wuv + (dt * 16 + fr) * 128 + ks * 32 + fq * 8);
#pragma unroll
            for (int qt = 0; qt < 2; ++qt) {
                f32x4 d = {0.f, 0.f, 0.f, 0.f};
#pragma unroll
                for (int ks = 0; ks < 4; ++ks) d = mfma16(a[ks], bo[qt][ks], d);
                st4bf(AT + (n0 + qt * 16 + fr) * 512 + h * 64 + dt * 16 + 4 * fq, d);
            }
        }
    }
    __syncthreads();
}

__device__ __forceinline__ void p2_phase(const Params& p, LAS char* lds) {
    const int tid = threadIdx.x;
    {
        const bf16_t* PV = (const bf16_t*)(p.ws + WS_PV); bf16_t* DD = (bf16_t*)(p.ws + WS_DD);
        for (int rc = blockIdx.x; rc < NTOK / 64; rc += gridDim.x) {
            const int n0 = rc * 64, b = n0 >> 11, s0 = n0 & 2047;
            const size_t R0 = (size_t)b * TT + 16 + s0 - 15;
            for (int idx = tid; idx < 79 * 64; idx += 512) *(LAS u32x4*)(lds + idx * 16) = *(const u32x4*)(PV + R0 * 512 + (size_t)idx * 8);
            __syncthreads();
#pragma unroll 1
            for (int it = 0; it < 8; ++it) {
                const int idx = tid + 512 * it, r = idx >> 6, ch8 = idx & 63;
                const int g = ch8 >> 4, w = 2 << g;
                float a[8];
#pragma unroll
                for (int e = 0; e < 8; ++e) a[e] = 0.f;
                const LAS char* src = lds + ((r + 15) * 64 + ch8) * 16;
                const u32x4 self = *(const LAS u32x4*)src;
                for (int i = 0; i < w; ++i) {
                    const u32x4 v = *(const LAS u32x4*)(src - i * 1024);
                    a[0] += bf_lo(v.x); a[1] += bf_hi(v.x); a[2] += bf_lo(v.y); a[3] += bf_hi(v.y); a[4] += bf_lo(v.z); a[5] += bf_hi(v.z); a[6] += bf_lo(v.w); a[7] += bf_hi(v.w);
                }
                const float iw = 1.f / (float)w;
                u32x4 o;
                o.x = cvt_pk_bf16(a[0] * iw - bf_lo(self.x), a[1] * iw - bf_hi(self.x)); o.y = cvt_pk_bf16(a[2] * iw - bf_lo(self.y), a[3] * iw - bf_hi(self.y));
                o.z = cvt_pk_bf16(a[4] * iw - bf_lo(self.z), a[5] * iw - bf_hi(self.z)); o.w = cvt_pk_bf16(a[6] * iw - bf_lo(self.w), a[7] * iw - bf_hi(self.w));
                *(u32x4*)(DD + (size_t)(n0 + r) * 512 + ch8 * 8) = o;
            }
            __syncthreads();
        }
    }
    for (int x = blockIdx.x; x < 256; x += gridDim.x) {
        const int b = x & 7, r = x >> 3;
#pragma unroll 1
        for (int rep = 0; rep < 2; ++rep) attn_item(p, b, rep == 0 ? 32 - (r >> 1) : 1 + (r >> 1), r & 1, lds);
    }
}

struct P3Sched {
    g8::TileOrder T; const char *AT, *DD, *WA, *WF;
    __device__ __forceinline__ bool next(int i, g8::Unit& u, int) const {
        int pm, pn; if (!T.tile(i >> 1, pm, pn)) return false;
        const int br = i & 1;
        u.A = (br ? DD : AT) + (size_t)pm * 256 * 512 * 2; u.B = (br ? WF : WA) + (size_t)pn * 256 * 512 * 2; u.i0 = pm; u.i1 = pn; u.i2 = br; return true;
    }
};
struct P3Epi {
    const Params* pp;
    __device__ __forceinline__ void operator()(f32x4 (&acc)[2][2][4][2], const g8::Unit& u, int wr, int wc, int fr, int fq, LAS char*) const {
        const Params& p = *pp;
        const bf16_t* GT = (const bf16_t*)(p.ws + WS_GATES); bf16_t* MG = (bf16_t*)(p.ws + WS_U);
        const int rowb = u.i0 * 256 + wr * 64 + fr, colb = u.i1 * 256 + wc * 32 + 4 * fq, br = u.i2;
        FOR_ACC(ai, bj, m, n) {
            const int nrow = rowb + ai * 128 + m * 16, col = colb + bj * 128 + n * 16;
            const size_t R = (size_t)nrow + 16 + 16 * (nrow >> 11);
            const u32x2 g = *(const u32x2*)(GT + R * 2048 + br * 1024 + col);
            f32x4 v = acc[ai][bj][m][n];
            v[0] *= bf_lo(g.x); v[1] *= bf_hi(g.x); v[2] *= bf_lo(g.y); v[3] *= bf_hi(g.y);
            if (br) { const u32x2 pr = *(const u32x2*)(MG + (size_t)nrow * 1024 + col); v[0] += bf_lo(pr.x); v[1] += bf_hi(pr.x); v[2] += bf_lo(pr.y); v[3] += bf_hi(pr.y); }
            st4bf(MG + (size_t)nrow * 1024 + col, v);
        }
    }
};
__device__ __forceinline__ void p3_phase(const Params& p, LAS char* lds) {
    P3Sched S; S.T.init(NTOK / 256, 4, gridDim.x, blockIdx.x);
    S.AT = (const char*)(p.ws + WS_ATTN); S.DD = (const char*)(p.ws + WS_DD); S.WA = (const char*)(p.ws + WS_WA); S.WF = (const char*)(p.ws + WS_WF);
    P3Epi E{&p};
    g8::gemm_phase<P3Epi, P3Sched, false>(lds, 512, S, E);
}

struct P4Sched {
    g8::TileOrder T; const char *MG, *WO;
    __device__ __forceinline__ bool next(int i, g8::Unit& u, int) const {
        int pm, pn; if (!T.tile(i, pm, pn)) return false;
        u.A = MG + (size_t)pm * 256 * 1024 * 2; u.B = WO + (size_t)pn * 256 * 1024 * 2; u.i0 = pm; u.i1 = pn; return true;
    }
};
struct P4Epi {
    const Params* pp;
    __device__ __forceinline__ void operator()(f32x4 (&acc)[2][2][4][2], const g8::Unit& u, int wr, int wc, int fr, int fq, LAS char*) const {
        const Params& p = *pp;
        const int rowb = u.i0 * 256 + wr * 64 + fr, colb = u.i1 * 256 + wc * 32 + 4 * fq;
        FOR_ACC(ai, bj, m, n) {
            const size_t off = (size_t)(rowb + ai * 128 + m * 16) * 1024 + colb + bj * 128 + n * 16;
            *(f32x4*)(p.out + off) = *(const f32x4*)(p.x + off) + acc[ai][bj][m][n];
        }
    }
};
__device__ __forceinline__ void p4_phase(const Params& p, LAS char* lds) {
    P4Sched S; S.T.init(NTOK / 256, 4, gridDim.x, blockIdx.x); S.MG = (const char*)(p.ws + WS_U); S.WO = (const char*)(p.ws + WS_WO);
    P4Epi E{&p};
    g8::gemm_phase<P4Epi, P4Sched, false>(lds, 1024, S, E);
}

constexpr int P5_USTR = 1032;
constexpr int P5_ULO = 32 * P5_USTR * 2;
constexpr int P5_PART = 2 * P5_ULO;
constexpr int P5_MISC = P5_PART + 4 * 48 * 32 * 4;
__device__ __forceinline__ void p5_phase(const Params& p, LAS char* lds) {
    const int tid = threadIdx.x, wid = __builtin_amdgcn_readfirstlane(tid >> 6), lane = tid & 63, fr0 = lane & 15, fq0 = lane >> 4;
    LAS bf16_t* Uhi = (LAS bf16_t*)lds; LAS bf16_t* Ulo = (LAS bf16_t*)(lds + P5_ULO);
    LAS float* part = (LAS float*)(lds + P5_PART);
    LAS int* lcnt = (LAS int*)(lds + P5_MISC);
    LAS int* lbase = lcnt + 32;
    LAS int* tk_e = lbase + 32;
    LAS int* tk_r = tk_e + 128;
    LAS float* tk_w = (LAS float*)(tk_r + 128);
    bf16_t* U2 = (bf16_t*)(p.ws + WS_U);
    const bf16_t* WRH = (const bf16_t*)(p.ws + WS_WRH); const bf16_t* WRL = (const bf16_t*)(p.ws + WS_WRL);
    int* cnt = (int*)(p.ws + WS_CNT); int* list = (int*)(p.ws + WS_LIST); float* wts = (float*)(p.ws + WS_WTS); int* tokrow = (int*)(p.ws + WS_TOKROW);
    for (int chunk = blockIdx.x; chunk < NTOK / 64; chunk += gridDim.x) {
        if (tid < 32) lcnt[tid] = 0;
        f32x4 gg[4];
#pragma unroll
        for (int j = 0; j < 4; ++j) gg[j] = *(const f32x4*)(p.norm2_g + j * 256 + lane * 4);
#pragma unroll 1
        for (int pass = 0; pass < 2; ++pass) {
            const int tb0 = chunk * 64 + pass * 32;
            f32x4 v[4][4];
#pragma unroll
            for (int t = 0; t < 4; ++t)
#pragma unroll
                for (int j = 0; j < 4; ++j) v[t][j] = *(const f32x4*)(p.out + (size_t)(tb0 + wid * 4 + t) * 1024 + j * 256 + lane * 4);
#pragma unroll
            for (int t = 0; t < 4; ++t) {
                float ss = 0.f;
#pragma unroll
                for (int j = 0; j < 4; ++j) ss += v[t][j][0] * v[t][j][0] + v[t][j][1] * v[t][j][1] + v[t][j][2] * v[t][j][2] + v[t][j][3] * v[t][j][3];
                ss = wave_sum(ss);
                const float rstd = rsqrtf(ss * (1.f / 1024.f) + EPS);
                const int tl = wid * 4 + t;
#pragma unroll
                for (int j = 0; j < 4; ++j) {
                    const f32x4 u = v[t][j] * rstd * gg[j];
                    u32x2 hi; hi.x = cvt_pk_bf16(u[0], u[1]); hi.y = cvt_pk_bf16(u[2], u[3]);
                    u32x2 lo; lo.x = cvt_pk_bf16(u[0] - bf_lo(hi.x), u[1] - bf_hi(hi.x)); lo.y = cvt_pk_bf16(u[2] - bf_lo(hi.y), u[3] - bf_hi(hi.y));
                    *(u32x2*)(U2 + (size_t)(tb0 + tl) * 1024 + j * 256 + lane * 4) = hi;
                    *(LAS u32x2*)(Uhi + tl * P5_USTR + j * 256 + lane * 4) = hi;
                    *(LAS u32x2*)(Ulo + tl * P5_USTR + j * 256 + lane * 4) = lo;
                }
            }
            __syncthreads();
            {
                const int tw = wid & 1, kq = wid >> 1;
                int fr = fr0, fq = fq0; asm volatile("" : "+v"(fr), "+v"(fq));
                f32x4 acc[3];
#pragma unroll
                for (int ot = 0; ot < 3; ++ot) acc[ot] = (f32x4){0.f, 0.f, 0.f, 0.f};
                const LAS bf16_t* bh = Uhi + (tw * 16 + fr) * P5_USTR + kq * 256 + fq * 8;
                const LAS bf16_t* bl = Ulo + (tw * 16 + fr) * P5_USTR + kq * 256 + fq * 8;
                const bf16_t* ah = WRH + (size_t)fr * 1024 + kq * 256 + fq * 8;
                const bf16_t* al = WRL + (size_t)fr * 1024 + kq * 256 + fq * 8;
#pragma unroll 2
                for (int ks = 0; ks < 8; ++ks) {
                    const bf16x8 bhi = *(const LAS bf16x8*)(bh + ks * 32), blo = *(const LAS bf16x8*)(bl + ks * 32);
#pragma unroll
                    for (int ot = 0; ot < 3; ++ot) {
                        const bf16x8 ahi = *(const bf16x8*)(ah + (size_t)ot * 16 * 1024 + ks * 32), alo = *(const bf16x8*)(al + (size_t)ot * 16 * 1024 + ks * 32);
                        acc[ot] = mfma16(ahi, bhi, acc[ot]); acc[ot] = mfma16(alo, bhi, acc[ot]); acc[ot] = mfma16(ahi, blo, acc[ot]);
                    }
                }
#pragma unroll
                for (int ot = 0; ot < 3; ++ot)
#pragma unroll
                    for (int r = 0; r < 4; ++r) part[(kq * 48 + ot * 16 + 4 * fq + r) * 32 + tw * 16 + fr] = acc[ot][r];
            }
            __syncthreads();
            if (tid < 32) {
                float L[36];
                int tq = tid; asm volatile("" : "+v"(tq));
                const LAS float* pt = part + tq;
#pragma unroll
                for (int o = 0; o < 36; ++o) L[o] = (pt[o * 32] + pt[(48 + o) * 32]) + (pt[(96 + o) * 32] + pt[(144 + o) * 32]);
                float gl[4];
#pragma unroll
                for (int g = 0; g < 4; ++g) gl[g] = L[g] + p.b_gr[g];
                int gs = 0; float gm = gl[0];
#pragma unroll
                for (int g = 1; g < 4; ++g) if (gl[g] > gm) { gm = gl[g]; gs = g; }
                float gsum = 0.f;
#pragma unroll
                for (int g = 0; g < 4; ++g) gsum += __expf(gl[g] - gm);
                const float pg = 1.f / gsum;
                float el[8];
#pragma unroll
                for (int e = 0; e < 8; ++e) {
                    const float l0 = L[4 + e] + p.b_er[e], l1 = L[12 + e] + p.b_er[8 + e], l2 = L[20 + e] + p.b_er[16 + e], l3 = L[28 + e] + p.b_er[24 + e];
                    el[e] = gs == 0 ? l0 : (gs == 1 ? l1 : (gs == 2 ? l2 : l3));
                }
                int i1 = 0; float v1 = el[0];
#pragma unroll
                for (int e = 1; e < 8; ++e) if (el[e] > v1) { v1 = el[e]; i1 = e; }
                int i2 = (i1 == 0) ? 1 : 0; float v2 = -INFINITY;
#pragma unroll
                for (int e = 0; e < 8; ++e) if (e != i1 && el[e] > v2) { v2 = el[e]; i2 = e; }
                const float e2 = __expf(v2 - v1), p1 = 1.f / (1.f + e2), p2 = e2 * p1;
                const int tl = pass * 32 + tid, ea = gs * 8 + i1, eb = gs * 8 + i2;
                tk_e[tl * 2] = ea; tk_e[tl * 2 + 1] = eb;
                tk_r[tl * 2] = __hip_atomic_fetch_add(&lcnt[ea], 1, __ATOMIC_RELAXED, __HIP_MEMORY_SCOPE_WORKGROUP); tk_r[tl * 2 + 1] = __hip_atomic_fetch_add(&lcnt[eb], 1, __ATOMIC_RELAXED, __HIP_MEMORY_SCOPE_WORKGROUP);
                tk_w[tl * 2] = pg * p1; tk_w[tl * 2 + 1] = pg * p2;
            }
            __syncthreads();
        }
        if (tid < 32) lbase[tid] = atomicAdd(&cnt[tid], lcnt[tid]);
        __syncthreads();
        if (tid < 128) {
            const int e = tk_e[tid], slot = lbase[e] + tk_r[tid], n = chunk * 64 + (tid >> 1);
            list[e * LISTCAP + slot] = n; wts[e * LISTCAP + slot] = tk_w[tid]; tokrow[n * 2 + (tid & 1)] = e * LISTCAP + slot;
        }
        __syncthreads();
    }
}

__device__ __forceinline__ void moe_tables(const Params& p, LAS int* tb) {
    if (threadIdx.x == 0) {
        const int* cnt = (const int*)(p.ws + WS_CNT);
        int acc = 0;
        for (int e = 0; e < 32; ++e) { const int c = __hip_atomic_load(cnt + e, __ATOMIC_RELAXED, __HIP_MEMORY_SCOPE_AGENT); tb[e] = c; tb[32 + e] = acc; acc += (c + 255) >> 8; }
        tb[64] = acc;
    }
    __syncthreads();
}

struct P6Sched {
    const LAS int* tb; const char *U2, *W1; const int* list; int G, c, nunits;
    __device__ __forceinline__ bool next(int i, g8::Unit& u, int tid) const {
        const int g = i * G + c; if (g >= nunits) return false;
        int e = 0;
#pragma unroll 1
        for (int q = 1; q < 32; ++q) if (2 * tb[32 + q] <= g) e = q;
        const int nte = tb[33 + e] - tb[32 + e], l = g - 2 * tb[32 + e], pn = l / nte, rt = l - pn * nte, ce = tb[e];
        u.A = U2; u.B = W1 + ((size_t)e * 512 + pn * 256) * 1024 * 2; u.i0 = e; u.i1 = rt; u.i2 = pn; u.i3 = tb[32 + e] + rt;
#pragma unroll
        for (int h = 0; h < 2; ++h)
#pragma unroll
            for (int k = 0; k < 2; ++k) { int sR, sC; g8::stage_rc(tid * 16 + k * 8192, sR, sC); const int slot = rt * 256 + h * 128 + sR; const int tok = slot < ce ? list[e * LISTCAP + slot] : 0; u.va[h][k] = (unsigned)(tok * 1024 + sC) * 2u; }
        return true;
    }
};
struct P6Epi {
    const Params* pp; const LAS int* tb;
    __device__ __forceinline__ void operator()(f32x4 (&acc)[2][2][4][2], const g8::Unit& u, int wr, int wc, int fr, int fq, LAS char*) const {
        const Params& p = *pp;
        const float* wts = (const float*)(p.ws + WS_WTS); bf16_t* HID = (bf16_t*)(p.ws + WS_HID);
        const int e = u.i0, rt = u.i1, pn = u.i2, ce = tb[e];
        const size_t rowbase = (size_t)u.i3 * 256;
#pragma unroll
        for (int ai = 0; ai < 2; ++ai)
#pragma unroll
            for (int m = 0; m < 4; ++m) {
                const int lr = ai * 128 + wr * 64 + m * 16 + fr, slot = rt * 256 + lr;
                const float w = slot < ce ? wts[e * LISTCAP + slot] : 0.f;
#pragma unroll
                for (int n = 0; n < 2; ++n) {
                    const f32x4 g = acc[ai][0][m][n], uu = acc[ai][1][m][n]; f32x4 hv;
#pragma unroll
                    for (int r = 0; r < 4; ++r) hv[r] = g[r] * __builtin_amdgcn_rcpf(1.f + __expf(-g[r])) * uu[r] * w;
                    st4bf(HID + (rowbase + lr) * 256 + pn * 128 + wc * 32 + n * 16 + 4 * fq, hv);
                }
            }
    }
};
__device__ __forceinline__ void p6_phase(const Params& p, LAS char* lds) {
    LAS int* tb = (LAS int*)(lds + GX_OFF);
    moe_tables(p, tb);
    P6Sched S; S.tb = tb; S.U2 = (const char*)(p.ws + WS_U); S.W1 = (const char*)(p.ws + WS_W1); S.list = (const int*)(p.ws + WS_LIST); S.G = gridDim.x; S.c = vcu_id(); S.nunits = tb[64] * 2;
    P6Epi E{&p, tb};
    g8::gemm_phase<P6Epi, P6Sched, true>(lds, 1024, S, E);
}

struct P7Sched {
    const LAS int* tb; const char *HID, *W2; int G, c, nunits;
    __device__ __forceinline__ bool next(int i, g8::Unit& u, int) const {
        const int g = i * G + c; if (g >= nunits) return false;
        int e = 0;
#pragma unroll 1
        for (int q = 1; q < 32; ++q) if (4 * tb[32 + q] <= g) e = q;
        const int nte = tb[33 + e] - tb[32 + e], l = g - 4 * tb[32 + e], pn = l / nte, rt = l - pn * nte, ti = tb[32 + e] + rt;
        u.A = HID + (size_t)ti * 256 * 256 * 2; u.B = W2 + ((size_t)e * 1024 + pn * 256) * 256 * 2; u.i0 = ti; u.i1 = pn; return true;
    }
};
struct P7Epi {
    const Params* pp;
    __device__ __forceinline__ void operator()(f32x4 (&acc)[2][2][4][2], const g8::Unit& u, int wr, int wc, int fr, int fq, LAS char*) const {
        bf16_t* Y = (bf16_t*)(pp->ws + WS_Y);
        FOR_ACC(ai, bj, m, n) st4bf(Y + ((size_t)u.i0 * 256 + ai * 128 + wr * 64 + m * 16 + fr) * 1024 + u.i1 * 256 + bj * 128 + wc * 32 + n * 16 + 4 * fq, acc[ai][bj][m][n]);
    }
};
__device__ __forceinline__ void p7_phase(const Params& p, LAS char* lds) {
    LAS int* tb = (LAS int*)(lds + GX_OFF);
    moe_tables(p, tb);
    P7Sched S; S.tb = tb; S.HID = (const char*)(p.ws + WS_HID); S.W2 = (const char*)(p.ws + WS_W2); S.G = gridDim.x; S.c = vcu_id(); S.nunits = tb[64] * 4;
    P7Epi E{&p};
    g8::gemm_phase<P7Epi, P7Sched, false>(lds, 256, S, E);
}

__device__ __forceinline__ void p8_phase(const Params& p, LAS char* lds) {
    const int tid = threadIdx.x, wid = tid >> 6, lane = tid & 63;
    LAS int* tb = (LAS int*)lds;
    moe_tables(p, tb);
    const bf16_t* Y = (const bf16_t*)(p.ws + WS_Y); const int* tokrow = (const int*)(p.ws + WS_TOKROW);
    for (int n = blockIdx.x * 8 + wid; n < NTOK; n += gridDim.x * 8) {
        const int r1 = tokrow[n * 2], r2 = tokrow[n * 2 + 1];
        const size_t y1 = (size_t)tb[32 + (r1 >> 14)] * 256 + (r1 & 16383), y2 = (size_t)tb[32 + (r2 >> 14)] * 256 + (r2 & 16383);
        f32x4 v[4]; float ss = 0.f;
#pragma unroll
        for (int j = 0; j < 4; ++j) {
            v[j] = *(const f32x4*)(p.out + (size_t)n * 1024 + j * 256 + lane * 4);
            const u32x2 a = *(const u32x2*)(Y + y1 * 1024 + j * 256 + lane * 4), c = *(const u32x2*)(Y + y2 * 1024 + j * 256 + lane * 4);
            v[j][0] += bf_lo(a.x) + bf_lo(c.x); v[j][1] += bf_hi(a.x) + bf_hi(c.x); v[j][2] += bf_lo(a.y) + bf_lo(c.y); v[j][3] += bf_hi(a.y) + bf_hi(c.y);
            ss += v[j][0] * v[j][0] + v[j][1] * v[j][1] + v[j][2] * v[j][2] + v[j][3] * v[j][3];
        }
        ss = wave_sum(ss);
        const float rstd = rsqrtf(ss * (1.f / 1024.f) + EPS);
#pragma unroll
        for (int j = 0; j < 4; ++j) { const f32x4 g = *(const f32x4*)(p.final_g + j * 256 + lane * 4); *(f32x4*)(p.out + (size_t)n * 1024 + j * 256 + lane * 4) = v[j] * rstd * g; }
    }
}

__global__ void __launch_bounds__(512, 2) fwd_kernel(Params p) {
    extern __shared__ __attribute__((aligned(16))) unsigned char smem[];
    LAS char* lds = (LAS char*)smem;
    volatile LAS unsigned* barw = (volatile LAS unsigned*)(lds + LDS_BARW);
    if (threadIdx.x < 2) barw[threadIdx.x] = 0u;
    __syncthreads();
    XcdBarrier bar; bar.bar = (unsigned*)(p.ws + WS_BAR); bar.x = 0; bar.st = nullptr;
    if (N_LAUNCHES == 1) bar = xcd_barrier_post((unsigned*)(p.ws + WS_BAR), barw);
    const int lo = p.ph_lo, hi = p.ph_hi;
#define IN(k) (lo <= (k) && (k) < hi)
#define SEAM(k) do { if (IN(k) && IN((k) + 1)) xcd_barrier(bar); } while (0)
#ifndef PH_MASK
#define PH_MASK 0x7ff
#endif
#define HAS(k) ((PH_MASK >> (k)) & 1)
    if (HAS(0) && IN(0)) { p0_phase(p, lds); if (DUP_PHASE == 0) { xcd_barrier(bar); p0_phase(p, lds); } } SEAM(0);
    if (HAS(1) && IN(1)) { p1_phase(p, lds); if (DUP_PHASE == 1) { xcd_barrier(bar); p1_phase(p, lds); } } SEAM(1);
    if (HAS(2) && IN(2)) { p2_phase(p, lds); if (DUP_PHASE == 2) { xcd_barrier(bar); p2_phase(p, lds); } } SEAM(2);
    if (HAS(3) && IN(3)) { p3_phase(p, lds); if (DUP_PHASE == 3) { xcd_barrier(bar); p3_phase(p, lds); } } SEAM(3);
    if (HAS(4) && IN(4)) { p4_phase(p, lds); if (DUP_PHASE == 4) { xcd_barrier(bar); p4_phase(p, lds); } } SEAM(4);
    if (HAS(5) && IN(5)) { p5_phase(p, lds); if (DUP_PHASE == 5) { xcd_barrier(bar); if (blockIdx.x == 0 && threadIdx.x < 32) ((int*)(p.ws + WS_CNT))[threadIdx.x] = 0; xcd_barrier(bar); p5_phase(p, lds); } } SEAM(5);
    if (HAS(6) && IN(6)) { p6_phase(p, lds); if (DUP_PHASE == 6) { xcd_barrier(bar); p6_phase(p, lds); } } SEAM(6);
    if (HAS(7) && IN(7)) { p7_phase(p, lds); if (DUP_PHASE == 7) { xcd_barrier(bar); p7_phase(p, lds); } } SEAM(7);
    if (HAS(8) && IN(8)) { p8_phase(p, lds); }
}

extern "C" void kernel_launch(void* const* d_in, const int* in_sizes, int n_in, void* d_out, int out_size, void* d_ws, size_t ws_size, hipStream_t stream) {
    static int grid = 0;
    if (grid == 0) {
        if (n_in != 21 || ws_size < WS_END) { fprintf(stderr, "kernel_launch: unexpected n_in %d or ws_size %zu (< %zu)\n", n_in, ws_size, (size_t)WS_END); grid = -1; return; }
        int dev = 0, cus = 0;
        if (hipGetDevice(&dev) != hipSuccess || hipDeviceGetAttribute(&cus, hipDeviceAttributeMultiprocessorCount, dev) != hipSuccess) { grid = -1; return; }
        if (hipFuncSetAttribute((const void*)fwd_kernel, hipFuncAttributeMaxDynamicSharedMemorySize, LDS_BYTES) != hipSuccess) { fprintf(stderr, "kernel_launch: hipFuncSetAttribute failed\n"); grid = -1; return; }
        grid = cus;
    }
    if (grid < 0) return;
    (void)hipMemsetAsync((char*)d_ws + WS_BAR, 0, WS_ZERO_BYTES, stream);
    Params p{};
    const float** f = (const float**)&p;
    for (int i = 0; i < 21; ++i) f[i] = (const float*)d_in[i];
    p.out = (float*)d_out; p.ws = (unsigned char*)d_ws;
    if (N_LAUNCHES == 1) { p.ph_lo = 0; p.ph_hi = NPH; hipLaunchKernelGGL(fwd_kernel, dim3(grid), dim3(512), LDS_BYTES, stream, p); }
    else for (int k = 0; k < NPH; ++k) { p.ph_lo = k; p.ph_hi = k + 1; hipLaunchKernelGGL(fwd_kernel, dim3(grid), dim3(512), LDS_BYTES, stream, p); }
}
```

```cpp
#include <hip/hip_runtime.h>
#include <stdint.h>
#include <stdio.h>

#ifndef DUP_PHASE
#define DUP_PHASE -1
#endif
#ifndef MEAS_SEC
#define MEAS_SEC 0
#endif
#ifndef MEAS_BLK
#define MEAS_BLK 0
#endif
#ifndef MEAS_MULT
#define MEAS_MULT 100
#endif
#ifndef N_LAUNCHES
#define N_LAUNCHES 1
#endif

#define LAS __attribute__((address_space(3)))
typedef unsigned short bf16_t;
typedef short bf16x8 __attribute__((ext_vector_type(8)));
typedef short s16x4 __attribute__((ext_vector_type(4)));
typedef float f32x4 __attribute__((ext_vector_type(4)));
typedef float f32x16 __attribute__((ext_vector_type(16)));
typedef unsigned u32x4 __attribute__((ext_vector_type(4)));
typedef unsigned u32x2 __attribute__((ext_vector_type(2)));

constexpr int NB = 8, SEQ = 2048, TT = 2064, DM = 1024;
constexpr int MALL = NB * TT;
constexpr int MPAD = 16640;
constexpr int NTOK = NB * SEQ;
constexpr int INW = 3496, INP = 3584;
constexpr float EPS = 1e-6f;
constexpr float ATTN_SCALE = 0.125f;
constexpr float IDX_SCALE = 0.0625f;
constexpr float LOG2E = 1.4426950408889634f;
constexpr int NPH = 9;
constexpr int LISTCAP = 16384;
constexpr int YROWS = 40960;

constexpr size_t AL(size_t x) { return (x + 255) & ~(size_t)255; }
constexpr size_t WS_BAR   = 0;
constexpr size_t WS_CNT   = WS_BAR + 16384;
constexpr size_t WS_ZERO_BYTES = 16384 + 256;
constexpr size_t WS_WIN   = AL(WS_CNT + 256);
constexpr size_t WS_WUK   = AL(WS_WIN + (size_t)INP * DM * 2);
constexpr size_t WS_WUV   = AL(WS_WUK + 8 * 128 * 64 * 2);
constexpr size_t WS_WF    = AL(WS_WUV + 8 * 64 * 128 * 2);
constexpr size_t WS_WA    = AL(WS_WF + 1024 * 512 * 2);
constexpr size_t WS_WO    = AL(WS_WA + 1024 * 512 * 2);
constexpr size_t WS_W1    = AL(WS_WO + 1024 * 1024 * 2);
constexpr size_t WS_W2    = AL(WS_W1 + (size_t)32 * 512 * 1024 * 2);
constexpr size_t WS_WRH   = AL(WS_W2 + (size_t)32 * 1024 * 256 * 2);
constexpr size_t WS_WRL   = AL(WS_WRH + 48 * 1024 * 2);
constexpr size_t WS_U     = AL(WS_WRL + 48 * 1024 * 2);
constexpr size_t WS_LIST  = AL(WS_U + (size_t)MPAD * DM * 2);
constexpr size_t WS_WTS   = AL(WS_LIST + (size_t)32 * LISTCAP * 4);
constexpr size_t WS_TOKROW= AL(WS_WTS + (size_t)32 * LISTCAP * 4);
constexpr size_t WS_UNION = AL(WS_TOKROW + (size_t)NTOK * 2 * 4);
constexpr size_t WS_Q     = WS_UNION;
constexpr size_t WS_C     = AL(WS_Q + (size_t)MPAD * 512 * 2);
constexpr size_t WS_IQ    = AL(WS_C + (size_t)MPAD * 128 * 2);
constexpr size_t WS_IK    = AL(WS_IQ + (size_t)MPAD * 256 * 2);
constexpr size_t WS_IW    = AL(WS_IK + (size_t)MPAD * 32 * 2);
constexpr size_t WS_PV    = AL(WS_IW + (size_t)MPAD * 8 * 4);
constexpr size_t WS_GATES = AL(WS_PV + (size_t)MPAD * 512 * 2);
constexpr size_t WS_ATTN  = AL(WS_GATES + (size_t)MPAD * 2048 * 2);
constexpr size_t WS_DD    = AL(WS_ATTN + (size_t)NTOK * 512 * 2);
constexpr size_t WS_ENDA  = AL(WS_DD + (size_t)NTOK * 512 * 2);
constexpr size_t WS_HID   = WS_UNION;
constexpr size_t WS_Y     = AL(WS_HID + (size_t)YROWS * 256 * 2);
constexpr size_t WS_ENDB  = AL(WS_Y + (size_t)YROWS * 1024 * 2);
constexpr size_t WS_END   = WS_ENDA > WS_ENDB ? WS_ENDA : WS_ENDB;

constexpr int LDS_BYTES = 156 * 1024;
constexpr int LDS_BARW  = LDS_BYTES - 16;

struct Params {
    const float *x, *meta, *norm1_g, *w_in, *kv_norm_g, *w_uk, *w_uv, *w_pool, *pool_scale, *w_ba, *w_bp, *w_out, *norm2_g,
                *w_gr, *b_gr, *w_er, *b_er, *w_eg, *w_eu, *w_ed, *final_g;
    float* out; unsigned char* ws; int ph_lo, ph_hi;
};

typedef __bf16 bf16v2_t __attribute__((ext_vector_type(2)));
typedef float f32x2 __attribute__((ext_vector_type(2)));
__device__ __forceinline__ unsigned cvt_pk_bf16(float lo, float hi) { const f32x2 v = {lo, hi}; return __builtin_bit_cast(unsigned, __builtin_convertvector(v, bf16v2_t)); }
__device__ __forceinline__ float bf_lo(unsigned u) { return __uint_as_float(u << 16); }
__device__ __forceinline__ float bf_hi(unsigned u) { return __uint_as_float(u & 0xffff0000u); }
__device__ __forceinline__ float wave_sum(float v) {
#pragma unroll
    for (int o = 1; o < 64; o <<= 1) v += __shfl_xor(v, o);
    return v;
}
__device__ __forceinline__ void st4bf(bf16_t* p, f32x4 v) { u32x2 o; o.x = cvt_pk_bf16(v[0], v[1]); o.y = cvt_pk_bf16(v[2], v[3]); *(u32x2*)p = o; }
__device__ __forceinline__ f32x4 mfma16(bf16x8 a, bf16x8 b, f32x4 c) { return __builtin_amdgcn_mfma_f32_16x16x32_bf16(a, b, c, 0, 0, 0); }
__device__ __forceinline__ f32x16 mfma32(bf16x8 a, bf16x8 b, f32x16 c) { return __builtin_amdgcn_mfma_f32_32x32x16_bf16(a, b, c, 0, 0, 0); }

#define MEAS_T0(k) unsigned long long _mt##k = 0; if (MEAS_SEC == (k) || ((k) == 30 && MEAS_SEC >= 31 && MEAS_SEC <= 33)) { __builtin_amdgcn_sched_barrier(0); _mt##k = __builtin_amdgcn_s_memtime(); __builtin_amdgcn_sched_barrier(0); }
#define MEAS_T1(k, ws) if (MEAS_SEC == (k)) { __builtin_amdgcn_s_waitcnt(0); __builtin_amdgcn_sched_barrier(0); const unsigned long long _d = __builtin_amdgcn_s_memtime() - _mt##k; \
    if (blockIdx.x == MEAS_BLK && threadIdx.x == 0) { unsigned long long* _slot = (unsigned long long*)((ws) + WS_CNT + 128); if (*_slot == 0ull) *_slot = _d; } }

#define MEAS_T1X(k, k0, ws) if (MEAS_SEC == (k)) { __builtin_amdgcn_s_waitcnt(0); const unsigned long long _d = __builtin_amdgcn_s_memtime() - _mt##k0; \
    if (blockIdx.x == MEAS_BLK && threadIdx.x == 0) { unsigned long long* _slot = (unsigned long long*)((ws) + WS_CNT + 128); if (*_slot == 0ull) *_slot = _d; } }
#define XB_TMO      128
#define XB_XCNT(j)  (256  + 64 * (j))
#define XB_XSUB(j)  (1280 + 64 * (j))
#define XB_XGEN(j)  (2304 + 64 * (j))
#define XB_TOP      3328
#define XB_TOPGEN   3392
#define XCD_BAR_WORDS 3456
#define XB_SPIN_CAP (1u << 20)
__device__ __forceinline__ unsigned xb_ld(unsigned* p)              { return __hip_atomic_load(p, __ATOMIC_RELAXED, __HIP_MEMORY_SCOPE_AGENT); }
__device__ __forceinline__ unsigned xb_add(unsigned* p, unsigned v) { return __hip_atomic_fetch_add(p, v, __ATOMIC_RELAXED, __HIP_MEMORY_SCOPE_AGENT); }
__device__ __forceinline__ unsigned xb_xcc_id() { return (unsigned)__builtin_amdgcn_s_getreg((3 << 11) | 20) & 0xFu; }
#define XB_SPIN(cond, bar) do { unsigned _sp = 0; while (cond) { __builtin_amdgcn_s_sleep(1); \
    if ((++_sp & 255u) == 0u) { if (xb_ld(&(bar)[XB_TMO])) break; if (_sp > XB_SPIN_CAP) { atomicAdd(&(bar)[XB_TMO], 1u); break; } } } } while (0)
struct XcdBarrier { unsigned* bar; unsigned x; volatile LAS unsigned* st; };
__device__ __forceinline__ XcdBarrier xcd_barrier_post(unsigned* bar, volatile LAS unsigned* st) {
    XcdBarrier b; b.bar = bar; b.x = xb_xcc_id(); b.st = st;
    if (threadIdx.x == 0) (void)xb_add(&bar[XB_XCNT(b.x)], 1u);
    return b;
}
__device__ __forceinline__ void xcd_barrier_complete(unsigned* bar, unsigned x, unsigned& nloc, unsigned& nx) {
    const unsigned G = gridDim.x * gridDim.y * gridDim.z;
    unsigned sum, cnt, mine, sp = 0u;
    for (;;) {
        sum = 0u; cnt = 0u; mine = 0u;
#pragma unroll
        for (unsigned j = 0; j < 16; ++j) { const unsigned c = xb_ld(&bar[XB_XCNT(j)]); sum += c; cnt += (c > 0u) ? 1u : 0u; mine = (j == x) ? c : mine; }
        if (sum == G) break;
        __builtin_amdgcn_s_sleep(1);
        if ((++sp & 255u) == 0u) { if (xb_ld(&bar[XB_TMO])) break; if (sp > XB_SPIN_CAP) { atomicAdd(&bar[XB_TMO], 1u); break; } }
    }
    nloc = mine > 0u ? mine : 1u; nx = cnt > 0u ? cnt : 1u;
}
__device__ __forceinline__ void xcd_barrier(const XcdBarrier& b) {
    asm volatile("s_waitcnt vmcnt(0)" ::: "memory");
    __syncthreads();
    if (threadIdx.x == 0) {
        unsigned* bar = b.bar;
        __builtin_amdgcn_s_waitcnt(0);
        unsigned nloc = b.st[0], nx = b.st[1];
        if (nloc == 0u) { xcd_barrier_complete(bar, b.x, nloc, nx); b.st[0] = nloc; b.st[1] = nx; }
        const unsigned old = xb_add(&bar[XB_XSUB(b.x)], 1u);
        const unsigned gen = old / nloc;
        if (old + 1u == (gen + 1u) * nloc) {
            __builtin_amdgcn_fence(__ATOMIC_RELEASE, "agent");
            asm volatile("s_waitcnt vmcnt(0)" ::: "memory");
            const unsigned og = xb_add(&bar[XB_TOP], 1u);
            const unsigned tg = og / nx;
            if (og + 1u == (tg + 1u) * nx) xb_add(&bar[XB_TOPGEN], 1u);
            else XB_SPIN(xb_ld(&bar[XB_TOPGEN]) == tg, bar);
            __builtin_amdgcn_fence(__ATOMIC_ACQUIRE, "agent");
            xb_add(&bar[XB_XGEN(b.x)], 1u);
            asm volatile("s_waitcnt vmcnt(0)" ::: "memory");
        } else {
            XB_SPIN(xb_ld(&bar[XB_XGEN(b.x)]) == gen, bar);
            __builtin_amdgcn_fence(__ATOMIC_ACQUIRE, "agent");
            asm volatile("s_waitcnt vmcnt(0)" ::: "memory");
        }
    }
    __syncthreads();
}

struct TJob { const float* src; bf16_t* dst; int src_ld, dst_ld, N, ktiles, ntiles, nbatch, split; size_t sbs, dbs; };
__device__ __forceinline__ TJob tjob(const Params& p, int j) {
    bf16_t* win = (bf16_t*)(p.ws + WS_WIN); bf16_t* w1 = (bf16_t*)(p.ws + WS_W1);
    TJob J;
    switch (j) {
    case 0:  J = TJob{p.w_in,        win,                 INW, 1024, 936, 16, 4, 1, 0, 0, 0}; break;
    case 1:  J = TJob{p.w_in + 936,  win + 1024 * 1024,   INW, 1024, 512, 16, 2, 1, 0, 0, 0}; break;
    case 2:  J = TJob{p.w_in + 1448, win + 1536 * 1024,   INW, 1024, 2048, 16, 8, 1, 0, 0, 0}; break;
    case 3:  J = TJob{p.w_uv, (bf16_t*)(p.ws + WS_WUV),   512, 128, 64, 2, 1, 8, 0, 64, 64 * 128}; break;
    case 4:  J = TJob{p.w_ba, (bf16_t*)(p.ws + WS_WA),    1024, 512, 1024, 8, 4, 1, 0, 0, 0}; break;
    case 5:  J = TJob{p.w_out, (bf16_t*)(p.ws + WS_WO),   1024, 1024, 1024, 16, 4, 1, 0, 0, 0}; break;
    case 6:  J = TJob{p.w_eg, w1,                         256, 1024, 256, 16, 1, 32, 1, 262144, 524288}; break;
    case 7:  J = TJob{p.w_eu, w1 + 128 * 1024,            256, 1024, 256, 16, 1, 32, 1, 262144, 524288}; break;
    default: J = TJob{p.w_ed, (bf16_t*)(p.ws + WS_W2),    1024, 256, 1024, 4, 4, 32, 0, 262144, 262144}; break;
    }
    return J;
}
constexpr int NTJOBS = 9;
__device__ __forceinline__ int tjob_tiles(int j) {
    constexpr int t[NTJOBS] = {64, 32, 128, 16, 32, 64, 512, 512, 512};
    return t[j];
}
constexpr int P0_TILES = 64 + 32 + 128 + 16 + 32 + 64 + 512 + 512 + 512;
constexpr int P0_WUK = 128, P0_WF = 512, P0_PAD = 88, P0_WR = 48, P0_NORM = MPAD / 4;
constexpr int P0_WITEMS = P0_WF + P0_WUK + P0_PAD + P0_WR + P0_NORM;
constexpr int T_LD = 257;

struct TItem { const float* src; bf16_t* dst; int src_ld, dst_ld, N, k0, n0, split; };
__device__ __forceinline__ bool p0_titem(const Params& p, int it, TItem& T) {
    if (it >= P0_TILES) return false;
    int r = it, j = 0;
#pragma unroll 1
    for (; j < NTJOBS - 1; ++j) { const int n = tjob_tiles(j); if (r < n) break; r -= n; }
    const TJob J = tjob(p, j);
    const int per = J.ktiles * J.ntiles, bi = r / per, rr = r % per, kt = rr / J.ntiles, nt = rr % J.ntiles;
    T.src = J.src + (size_t)bi * J.sbs; T.dst = J.dst + (size_t)bi * J.dbs; T.src_ld = J.src_ld; T.dst_ld = J.dst_ld; T.N = J.N; T.k0 = kt * 64; T.n0 = nt * 256; T.split = J.split;
    return true;
}
__device__ __forceinline__ void p0_tload(const TItem& T, f32x4 (&v)[8], int tid) {
#pragma unroll
    for (int i = 0; i < 8; ++i) {
        const int kk = (tid >> 6) + 8 * i, n4 = (tid & 63) * 4;
        v[i] = (f32x4){0.f, 0.f, 0.f, 0.f};
        if (T.n0 + n4 < T.N) v[i] = *(const f32x4*)(T.src + (size_t)(T.k0 + kk) * T.src_ld + T.n0 + n4);
    }
}

__device__ __forceinline__ void p0_phase(const Params& p, LAS char* lds) {
    const int tid = threadIdx.x, wid = __builtin_amdgcn_readfirstlane(tid >> 6), lane = tid & 63, fr = lane & 15, fq = lane >> 4;
    MEAS_T0(34)
    {
        LAS float* tile = (LAS float*)lds;
        TItem T, Tn; f32x4 v[8];
        int it = blockIdx.x;
        bool have = p0_titem(p, it, T);
        if (have) p0_tload(T, v, tid);
        while (have) {
#pragma unroll
            for (int i = 0; i < 8; ++i) {
                const int kk = (tid >> 6) + 8 * i, n4 = (tid & 63) * 4;
                tile[kk * T_LD + n4 + 0] = v[i][0]; tile[kk * T_LD + n4 + 1] = v[i][1]; tile[kk * T_LD + n4 + 2] = v[i][2]; tile[kk * T_LD + n4 + 3] = v[i][3];
            }
            it += gridDim.x;
            const bool hn = p0_titem(p, it, Tn);
            if (hn) p0_tload(Tn, v, tid);
            __syncthreads();
#pragma unroll
            for (int c = 0; c < 4; ++c) {
                const int idx = tid + 512 * c, n = idx >> 3, kc = idx & 7;
                if (T.n0 + n < T.N) {
                    const LAS float* sp = tile + (kc * 8) * T_LD + n;
                    u32x4 o; o.x = cvt_pk_bf16(sp[0], sp[T_LD]); o.y = cvt_pk_bf16(sp[2 * T_LD], sp[3 * T_LD]); o.z = cvt_pk_bf16(sp[4 * T_LD], sp[5 * T_LD]); o.w = cvt_pk_bf16(sp[6 * T_LD], sp[7 * T_LD]);
                    const int nn = T.n0 + n, drow = T.split ? ((nn & 127) + (nn >> 7) * 256) : nn;
                    *(u32x4*)(T.dst + (size_t)drow * T.dst_ld + T.k0 + kc * 8) = o;
                }
            }
            __syncthreads();
            T = Tn; have = hn;
        }
    }
    MEAS_T1(34, p.ws)
    MEAS_T0(35)
    for (int it = blockIdx.x * 8 + wid; it < P0_WITEMS; it += gridDim.x * 8) {
        int r = it;
        if (r < P0_WF) {
            const int kt = r >> 4, nq = r & 15, k0 = kt * 16, g = k0 >> 7, n0 = nq * 64;
            f32x4 acc[4];
#pragma unroll
            for (int i = 0; i < 4; ++i) acc[i] = (f32x4){0.f, 0.f, 0.f, 0.f};
            const float* wp = p.w_pool + (size_t)(k0 + fr) * 128 + fq; const float* ps = p.pool_scale + g * 128 + fq;
            const float* wb = p.w_bp + (size_t)(g * 128 + fq) * 1024 + n0 + fr;
#pragma unroll 8
            for (int st = 0; st < 32; ++st) {
                const float a = wp[4 * st] * ps[4 * st];
#pragma unroll
                for (int i = 0; i < 4; ++i) acc[i] = __builtin_amdgcn_mfma_f32_16x16x4f32(a, wb[(size_t)(4 * st) * 1024 + i * 16], acc[i], 0, 0, 0);
            }
            bf16_t* wf = (bf16_t*)(p.ws + WS_WF);
#pragma unroll
            for (int i = 0; i < 4; ++i) st4bf(wf + (size_t)(n0 + 16 * i + fr) * 512 + k0 + 4 * fq, acc[i]);
            continue;
        }
        r -= P0_WF;
        if (r < P0_WUK) {
            const int o = r * 512 + lane * 8, h = o >> 13, c = (o >> 6) & 127, d = o & 63;
            const float* sp = p.w_uk + c * 512 + h * 64 + d;
            const f32x4 a = *(const f32x4*)sp, b = *(const f32x4*)(sp + 4);
            u32x4 w; w.x = cvt_pk_bf16(a[0], a[1]); w.y = cvt_pk_bf16(a[2], a[3]); w.z = cvt_pk_bf16(b[0], b[1]); w.w = cvt_pk_bf16(b[2], b[3]);
            *(u32x4*)((bf16_t*)(p.ws + WS_WUK) + o) = w;
            continue;
        }
        r -= P0_WUK;
        if (r < P0_PAD) {
            bf16_t* win = (bf16_t*)(p.ws + WS_WIN) + (size_t)(936 + r) * 1024;
            const u32x4 z = {0u, 0u, 0u, 0u};
            *(u32x4*)(win + lane * 8) = z; *(u32x4*)(win + 512 + lane * 8) = z;
            continue;
        }
        r -= P0_PAD;
        if (r < P0_WR) {
            bf16_t* wh = (bf16_t*)(p.ws + WS_WRH) + (size_t)r * 1024; bf16_t* wl = (bf16_t*)(p.ws + WS_WRL) + (size_t)r * 1024;
#pragma unroll 16
            for (int i = 0; i < 16; ++i) {
                const int k = lane + 64 * i;
                const float w = r < 4 ? p.w_gr[(size_t)k * 4 + r] : (r < 36 ? p.w_er[(size_t)k * 32 + (r - 4)] : 0.f);
                const unsigned h = cvt_pk_bf16(w, 0.f) & 0xffffu;
                wh[k] = (bf16_t)h; wl[k] = (bf16_t)(cvt_pk_bf16(w - bf_lo(h), 0.f) & 0xffffu);
            }
            continue;
        }
        r -= P0_WR;
        {
            const int R0 = r * 4;
            f32x4 v[4][4];
#pragma unroll
            for (int q = 0; q < 4; ++q) {
                const int R = R0 + q;
                if (R < MALL) {
                    const int b = R / TT, t = R - b * TT;
                    const float* src = (t < 16) ? (p.meta + (size_t)t * 1024) : (p.x + ((size_t)b * SEQ + (t - 16)) * 1024);
#pragma unroll
                    for (int j = 0; j < 4; ++j) v[q][j] = *(const f32x4*)(src + j * 256 + lane * 4);
                } else {
#pragma unroll
                    for (int j = 0; j < 4; ++j) v[q][j] = (f32x4){0.f, 0.f, 0.f, 0.f};
                }
            }
            f32x4 g[4];
#pragma unroll
            for (int j = 0; j < 4; ++j) g[j] = *(const f32x4*)(p.norm1_g + j * 256 + lane * 4);
#pragma unroll
            for (int q = 0; q < 4; ++q) {
                float ss = 0.f;
#pragma unroll
                for (int j = 0; j < 4; ++j) ss += v[q][j][0] * v[q][j][0] + v[q][j][1] * v[q][j][1] + v[q][j][2] * v[q][j][2] + v[q][j][3] * v[q][j][3];
                ss = wave_sum(ss);
                const float rstd = rsqrtf(ss * (1.f / 1024.f) + EPS);
                bf16_t* urow = (bf16_t*)(p.ws + WS_U) + (size_t)(R0 + q) * 1024;
#pragma unroll
                for (int j = 0; j < 4; ++j) st4bf(urow + j * 256 + lane * 4, v[q][j] * rstd * g[j]);
            }
        }
    }
    MEAS_T1(35, p.ws)
    __syncthreads();
}

namespace g8 {
constexpr int BM = 256, BK = 64, HALF = 128, HTB = HALF * BK * 2, STAGE_BYTES = 8 * HTB, NXCD = 8, WGM = 8;
__device__ __forceinline__ int lds_byte(int r, int c) { const int st = (r >> 4) * 2 + (c >> 5), rr = r & 15, cc = c & 31, ob = rr * 64 + cc * 2; return st * 1024 + (ob ^ (((ob >> 9) & 1) << 5)); }
__device__ __forceinline__ void stage_rc(int b, int& R, int& C) { const int st = b / 1024, sb = b % 1024, swz = sb ^ (((sb >> 9) & 1) << 5); R = (st >> 1) * 16 + swz / 64; C = (st & 1) * 32 + (swz % 64) / 2; }

struct Unit { const char* A; const char* B; int i0, i1, i2, i3; unsigned va[2][2]; };

struct TileOrder {
    int nM, nN, nwg, G, c;
    __device__ __forceinline__ void init(int nM_, int nN_, int G_, int c_) { nM = nM_; nN = nN_; nwg = nM * nN; G = G_; c = c_; }
    __device__ __forceinline__ bool tile(int i, int& pm, int& pn) const {
        const long L = (long)i * G + c; if (L >= nwg) return false;
        int wgid = (int)L; { const int q = nwg / NXCD, r = nwg % NXCD, xcd = wgid % NXCD, off = wgid / NXCD; wgid = (xcd < r ? xcd * (q + 1) : r * (q + 1) + (xcd - r) * q) + off; }
        const int nig = WGM * nN, gid = wgid / nig, fm = gid * WGM, gsz = (nM - fm) < WGM ? (nM - fm) : WGM;
        pm = fm + ((wgid % nig) % gsz); pn = (wgid % nig) / gsz; return true;
    }
};

template <class Epi, class Sched, bool GATHER>
__device__ __forceinline__ void gemm_phase(LAS char* lds, const int K, const Sched& S, const Epi& E) {
    const int tid = threadIdx.x, wid = __builtin_amdgcn_readfirstlane(tid >> 6), lane = tid & 63, wr = wid >> 2, wc = wid & 3, fr = lane & 15, fq = lane >> 4;
    const int nt = K / BK;
    unsigned voff[2];
#pragma unroll
    for (int i = 0; i < 2; ++i) { int R_, C_; stage_rc(tid * 16 + i * 8192, R_, C_); voff[i] = (unsigned)(R_ * K + C_) * 2u; }
    const size_t kstep = (size_t)(BK * 2);
    const size_t hstep = (size_t)HALF * K * 2;
    const unsigned ldsw = (unsigned)wid * 1024u;
    const int aoff = lds_byte(wr * 64 + fr, fq * 8), boff = lds_byte(wc * 32 + fr, fq * 8);
#define G8_SA(b, h) (((b) * 2 + (h)) * HTB)
#define G8_SB(b, h) ((4 + (b) * 2 + (h)) * HTB)
#define G8_GLDS(bufoff, ptr, i_) __builtin_amdgcn_global_load_lds((const unsigned*)(ptr), (LAS unsigned*)(lds + (bufoff) + ldsw + (i_) * 8192), 16, 0, 0)
#define G8_STAGE_B(bufoff, gbase) do { _Pragma("unroll") for (int _i = 0; _i < 2; ++_i) G8_GLDS(bufoff, (const char*)(gbase) + voff[_i], _i); } while (0)
#define G8_STAGE_A(bufoff, abase, vA, h) do { _Pragma("unroll") for (int _i = 0; _i < 2; ++_i) \
        G8_GLDS(bufoff, GATHER ? ((const char*)(abase) + (vA)[h][_i]) : ((const char*)(abase) + (size_t)(h) * hstep + voff[_i]), _i); } while (0)
#define G8_LDA(dst, b, h) do { _Pragma("unroll") for (int m = 0; m < 4; ++m) _Pragma("unroll") for (int k = 0; k < 2; ++k) dst[m][k] = *(const LAS bf16x8*)(lds + G8_SA(b, h) + aoff + m * 2048 + k * 1024); } while (0)
#define G8_LDB(dst, b, h) do { _Pragma("unroll") for (int n = 0; n < 2; ++n) _Pragma("unroll") for (int k = 0; k < 2; ++k) dst[n][k] = *(const LAS bf16x8*)(lds + G8_SB(b, h) + boff + n * 2048 + k * 1024); } while (0)
#define G8_MMA(ai, bj, At, Bt) do { __builtin_amdgcn_s_setprio(1); _Pragma("unroll") for (int m = 0; m < 4; ++m) _Pragma("unroll") for (int n = 0; n < 2; ++n) _Pragma("unroll") for (int k = 0; k < 2; ++k) \
        acc[ai][bj][m][n] = __builtin_amdgcn_mfma_f32_16x16x32_bf16(Bt[n][k], At[m][k], acc[ai][bj][m][n], 0, 0, 0); __builtin_amdgcn_s_setprio(0); } while (0)
#define G8_WAIT_V(n) asm volatile("s_waitcnt vmcnt(" #n ")" ::: "memory")
#define G8_WAIT_L(n) asm volatile("s_waitcnt lgkmcnt(" #n ")" ::: "memory")
#define G8_BAR __builtin_amdgcn_s_barrier()
#define G8_SCHED __builtin_amdgcn_sched_barrier(0)
    Unit cur, nxt; int ui = 0;
    cur.A = nullptr; cur.B = nullptr; cur.i0 = cur.i1 = cur.i2 = cur.i3 = 0; cur.va[0][0] = cur.va[0][1] = cur.va[1][0] = cur.va[1][1] = 0u; nxt = cur;
    if (!S.next(0, cur, tid)) return;
    f32x4 acc[2][2][4][2];
#pragma unroll
    for (int a = 0; a < 2; ++a)
#pragma unroll
        for (int b = 0; b < 2; ++b)
#pragma unroll
            for (int m = 0; m < 4; ++m)
#pragma unroll
                for (int n = 0; n < 2; ++n) acc[a][b][m][n] = (f32x4){0.f, 0.f, 0.f, 0.f};
    bf16x8 At[4][2], B0[2][2], B1[2][2];
    G8_STAGE_B(G8_SB(0, 0), cur.B); G8_STAGE_B(G8_SB(0, 1), cur.B + hstep); G8_STAGE_A(G8_SA(0, 0), cur.A, cur.va, 0); G8_STAGE_A(G8_SA(0, 1), cur.A, cur.va, 1);
    if (wr == 1) G8_BAR;
    G8_WAIT_V(2); G8_BAR;
    G8_STAGE_B(G8_SB(1, 0), cur.B + kstep); G8_STAGE_A(G8_SA(1, 0), cur.A + kstep, cur.va, 0); G8_STAGE_B(G8_SB(1, 1), cur.B + hstep + kstep);
    G8_WAIT_V(6); G8_BAR;
    for (;;) {
        const bool has_next = S.next(ui + 1, nxt, tid);
        if (!has_next) nxt = cur;
#pragma unroll 1
        for (int t = 0; t < nt; t += 2) {
            const bool last = (t == nt - 2);
            const char* a1 = cur.A + (size_t)(t + 1) * kstep;
            const char* a2 = last ? nxt.A : cur.A + (size_t)(t + 2) * kstep; const char* b2 = last ? nxt.B : cur.B + (size_t)(t + 2) * kstep;
            const char* a3 = a2 + kstep; const char* b3 = b2 + kstep;
            G8_LDB(B0, 0, 0); G8_LDB(B1, 0, 1); G8_SCHED; G8_LDA(At, 0, 0); G8_STAGE_A(G8_SA(1, 1), a1, cur.va, 1);
            if (GATHER && last) {
#pragma unroll
                for (int h = 0; h < 2; ++h)
#pragma unroll
                    for (int i = 0; i < 2; ++i) cur.va[h][i] = nxt.va[h][i];
            }
            G8_WAIT_V(8); G8_WAIT_L(0); G8_BAR; G8_MMA(0, 0, At, B0); G8_MMA(0, 1, At, B1); G8_BAR; G8_SCHED;
            G8_LDA(At, 0, 1); G8_STAGE_B(G8_SB(0, 0), b2); G8_STAGE_B(G8_SB(0, 1), b2 + hstep); G8_STAGE_A(G8_SA(0, 0), a2, cur.va, 0);
            G8_WAIT_V(8); G8_WAIT_L(0); G8_BAR; G8_MMA(1, 0, At, B0); G8_MMA(1, 1, At, B1); G8_BAR; G8_SCHED;
            G8_LDB(B0, 1, 0); G8_LDB(B1, 1, 1); G8_SCHED; G8_LDA(At, 1, 0); G8_STAGE_A(G8_SA(0, 1), a2, cur.va, 1);
            G8_WAIT_V(8); G8_WAIT_L(0); G8_BAR; G8_MMA(0, 0, At, B0); G8_MMA(0, 1, At, B1); G8_BAR; G8_SCHED;
            G8_LDA(At, 1, 1); G8_STAGE_B(G8_SB(1, 0), b3); G8_STAGE_B(G8_SB(1, 1), b3 + hstep); G8_STAGE_A(G8_SA(1, 0), a3, cur.va, 0);
            G8_WAIT_V(8); G8_WAIT_L(0); G8_BAR; G8_MMA(1, 0, At, B0); G8_MMA(1, 1, At, B1); G8_BAR; G8_SCHED;
        }
        if (wr == 0) G8_BAR;
        { int efr = fr, efq = fq; asm volatile("" : "+v"(efr), "+v"(efq));
          E(acc, cur, wr, wc, efr, efq, lds + STAGE_BYTES); }
        if (!has_next) break;
#pragma unroll
        for (int a = 0; a < 2; ++a)
#pragma unroll
            for (int b = 0; b < 2; ++b)
#pragma unroll
                for (int m = 0; m < 4; ++m)
#pragma unroll
                    for (int n = 0; n < 2; ++n) acc[a][b][m][n] = (f32x4){0.f, 0.f, 0.f, 0.f};
        cur = nxt; ++ui;
        if (wr == 1) G8_BAR;
    }
    G8_WAIT_V(0);
    G8_BAR;
#undef G8_SA
#undef G8_SB
#undef G8_GLDS
#undef G8_STAGE_A
#undef G8_STAGE_B
#undef G8_LDA
#undef G8_LDB
#undef G8_MMA
#undef G8_WAIT_V
#undef G8_WAIT_L
#undef G8_BAR
#undef G8_SCHED
}
}
constexpr int GX_OFF = g8::STAGE_BYTES;

#define FOR_ACC(ai, bj, m, n) \
    _Pragma("unroll") for (int ai = 0; ai < 2; ++ai) _Pragma("unroll") for (int bj = 0; bj < 2; ++bj) \
    _Pragma("unroll") for (int m = 0; m < 4; ++m) _Pragma("unroll") for (int n = 0; n < 2; ++n)
__device__ __forceinline__ int vcu_id() { const int G = gridDim.x, bx = blockIdx.x; return (G % 8 == 0) ? (bx % 8) * (G / 8) + bx / 8 : bx; }

struct P1Sched {
    g8::TileOrder T; const char* U; const char* W;
    __device__ __forceinline__ bool next(int i, g8::Unit& u, int) const {
        int pm, pn; if (!T.tile(i, pm, pn)) return false;
        u.A = U + (size_t)pm * 256 * 1024 * 2; u.B = W + (size_t)pn * 256 * 1024 * 2; u.i0 = pm; u.i1 = pn; return true;
    }
};
struct P1Epi {
    const Params* pp;
    __device__ __forceinline__ void operator()(f32x4 (&acc)[2][2][4][2], const g8::Unit& u, int wr, int wc, int fr, int fq, LAS char* xl) const {
        const Params& p = *pp;
        bf16_t* Q = (bf16_t*)(p.ws + WS_Q); bf16_t* C = (bf16_t*)(p.ws + WS_C); bf16_t* IQ = (bf16_t*)(p.ws + WS_IQ); bf16_t* IK = (bf16_t*)(p.ws + WS_IK);
        float* IW = (float*)(p.ws + WS_IW); bf16_t* PV = (bf16_t*)(p.ws + WS_PV); bf16_t* GT = (bf16_t*)(p.ws + WS_GATES);
        const int pm = u.i0, pn = u.i1;
        const int rowb = pm * 256 + wr * 64 + fr, colb = wc * 32 + 4 * fq;
        if (pn < 2) {
            FOR_ACC(ai, bj, m, n) st4bf(Q + (size_t)(rowb + ai * 128 + m * 16) * 512 + pn * 256 + bj * 128 + colb + n * 16, acc[ai][bj][m][n]);
        } else if (pn == 2) {
            LAS float* part = (LAS float*)xl;
#pragma unroll
            for (int ai = 0; ai < 2; ++ai)
#pragma unroll
                for (int m = 0; m < 4; ++m) {
                    float s = 0.f;
#pragma unroll
                    for (int n = 0; n < 2; ++n) { const f32x4 v = acc[ai][0][m][n]; s += v[0] * v[0] + v[1] * v[1] + v[2] * v[2] + v[3] * v[3]; }
                    s += __shfl_xor(s, 16); s += __shfl_xor(s, 32);
                    if (fq == 0) part[(ai * 128 + wr * 64 + m * 16 + fr) * 4 + wc] = s;
                }
            __syncthreads();
#pragma unroll
            for (int ai = 0; ai < 2; ++ai)
#pragma unroll
                for (int m = 0; m < 4; ++m) {
                    const int lr = ai * 128 + wr * 64 + m * 16 + fr;
                    const f32x4 ps = *(LAS f32x4*)(part + lr * 4);
                    const float rstd = rsqrtf((ps[0] + ps[1] + ps[2] + ps[3]) * (1.f / 128.f) + EPS);
                    const size_t R = (size_t)(rowb + ai * 128 + m * 16);
#pragma unroll
                    for (int n = 0; n < 2; ++n) {
                        const f32x4 g = *(const f32x4*)(p.kv_norm_g + colb + n * 16);
                        st4bf(C + R * 128 + colb + n * 16, acc[ai][0][m][n] * rstd * g);
                        st4bf(IQ + R * 256 + colb + n * 16, acc[ai][1][m][n]);
                    }
                }
            __syncthreads();
        } else if (pn == 3) {
#pragma unroll
            for (int ai = 0; ai < 2; ++ai)
#pragma unroll
                for (int m = 0; m < 4; ++m) {
                    const size_t R = (size_t)(rowb + ai * 128 + m * 16);
#pragma unroll
                    for (int n = 0; n < 2; ++n) {
                        st4bf(IQ + R * 256 + 128 + colb + n * 16, acc[ai][0][m][n]);
                        if (wc == 0) st4bf(IK + R * 32 + n * 16 + 4 * fq, acc[ai][1][m][n]);
                        if (wc == 1 && n == 0 && fq < 2) *(f32x4*)(IW + R * 8 + 4 * fq) = acc[ai][1][m][n] * IDX_SCALE;
                    }
                }
        } else if (pn < 6) {
            FOR_ACC(ai, bj, m, n) st4bf(PV + (size_t)(rowb + ai * 128 + m * 16) * 512 + (pn - 4) * 256 + bj * 128 + colb + n * 16, acc[ai][bj][m][n]);
        } else {
            FOR_ACC(ai, bj, m, n) {
                f32x4 v = acc[ai][bj][m][n];
#pragma unroll
                for (int r = 0; r < 4; ++r) v[r] = __builtin_amdgcn_rcpf(1.f + __expf(-v[r]));
                st4bf(GT + (size_t)(rowb + ai * 128 + m * 16) * 2048 + (pn - 6) * 256 + bj * 128 + colb + n * 16, v);
            }
        }
    }
};
__device__ __forceinline__ void p1_phase(const Params& p, LAS char* lds) {
    P1Sched S; S.T.init(MPAD / 256, INP / 256, gridDim.x, blockIdx.x); S.U = (const char*)(p.ws + WS_U); S.W = (const char*)(p.ws + WS_WIN);
    P1Epi E{&p};
    g8::gemm_phase<P1Epi, P1Sched, false>(lds, 1024, S, E);
}
constexpr int SC_STRIDE = 2068;
constexpr int SC_BYTES = 16 * SC_STRIDE * 4;
constexpr int MASK_OFF = SC_BYTES;
constexpr int QS_STRIDE = 136;
constexpr float DEFER_THR = 6.0f;

__device__ __forceinline__ int kv_off(int row, int ch) { return 256 * row + 16 * (ch ^ (((row & 3) << 2) | ((row >> 2) & 3))); }
__device__ __forceinline__ unsigned f2ord(float f) { const unsigned u = __float_as_uint(f); return (u & 0x80000000u) ? ~u : (u | 0x80000000u); }
__device__ __forceinline__ int wave_sum_dpp(int v) {
    v += __builtin_amdgcn_update_dpp(0, v, 0x111, 0xf, 0xf, false);
    v += __builtin_amdgcn_update_dpp(0, v, 0x112, 0xf, 0xf, false);
    v += __builtin_amdgcn_update_dpp(0, v, 0x114, 0xf, 0xf, false);
    v += __builtin_amdgcn_update_dpp(0, v, 0x118, 0xf, 0xf, false);
    v += __builtin_amdgcn_update_dpp(0, v, 0x142, 0xa, 0xf, false);
    v += __builtin_amdgcn_update_dpp(0, v, 0x143, 0xc, 0xf, false);
    return __builtin_amdgcn_readlane(v, 63);
}

__device__ __forceinline__ void attn_item(const Params& p, int b, int j, int half, LAS char* lds) {
    int tid_ = threadIdx.x; asm volatile("" : "+v"(tid_));
    const int tid = tid_, wid = __builtin_amdgcn_readfirstlane(tid >> 6), lane = tid & 63, fr = lane & 15, fq = lane >> 4;
    const int nadm = 16 + 64 * j;
    const int t0 = 16 + 64 * (j - 1) + 32 * half;
    const size_t Rq0 = (size_t)b * TT + t0, Rk0 = (size_t)b * TT;
    const bf16_t* Q = (const bf16_t*)(p.ws + WS_Q); const bf16_t* C = (const bf16_t*)(p.ws + WS_C); const bf16_t* IQ = (const bf16_t*)(p.ws + WS_IQ);
    const bf16_t* IK = (const bf16_t*)(p.ws + WS_IK); const float* IW = (const float*)(p.ws + WS_IW);
    LAS unsigned* maskw = (LAS unsigned*)(lds + MASK_OFF);
    const int h = wid;

    MEAS_T0(21)
    {
        const bf16_t* Wuk = (const bf16_t*)(p.ws + WS_WUK) + (size_t)h * 128 * 64;
        bf16x8 bq[2][2];
#pragma unroll
        for (int qt = 0; qt < 2; ++qt)
#pragma unroll
            for (int ks = 0; ks < 2; ++ks) bq[qt][ks] = *(const bf16x8*)(Q + (Rq0 + qt * 16 + fr) * 512 + h * 64 + ks * 32 + fq * 8);
        LAS bf16_t* qs = (LAS bf16_t*)lds + (size_t)h * 32 * QS_STRIDE;
#pragma unroll
        for (int ct = 0; ct < 8; ++ct) {
            const bf16x8 a0 = *(const bf16x8*)(Wuk + (ct * 16 + fr) * 64 + fq * 8), a1 = *(const bf16x8*)(Wuk + (ct * 16 + fr) * 64 + 32 + fq * 8);
#pragma unroll
            for (int qt = 0; qt < 2; ++qt) {
                f32x4 d = {0.f, 0.f, 0.f, 0.f};
                d = mfma16(a0, bq[qt][0], d); d = mfma16(a1, bq[qt][1], d);
                d = d * (ATTN_SCALE * LOG2E);
                u32x2 o; o.x = cvt_pk_bf16(d[0], d[1]); o.y = cvt_pk_bf16(d[2], d[3]);
                *(LAS u32x2*)(qs + (qt * 16 + fr) * QS_STRIDE + ct * 16 + 4 * fq) = o;
            }
        }
    }
    __syncthreads();
    bf16x8 qf[8];
    {
        const LAS bf16_t* qs = (const LAS bf16_t*)lds + (size_t)h * 32 * QS_STRIDE + (lane & 31) * QS_STRIDE + (lane >> 5) * 8;
#pragma unroll
        for (int ks = 0; ks < 8; ++ks) qf[ks] = *(const LAS bf16x8*)(qs + ks * 16);
    }
    __syncthreads();

    MEAS_T1(21, p.ws)
    MEAS_T0(22)
    if (nadm <= 256) {
        for (int idx = tid; idx < 32 * 66; idx += 512) {
            const int w = idx % 66; const int lo = w * 32;
            unsigned v = 0u;
            if (lo + 32 <= nadm) v = 0xffffffffu; else if (lo < nadm) v = (1u << (nadm - lo)) - 1u;
            maskw[idx] = v;
        }
    } else {
        LAS float* sc = (LAS float*)lds;
        const int nkt = nadm >> 4;
        const int ni = (nadm + 63) >> 6;
#pragma unroll 1
        for (int sub = 0; sub < 2; ++sub) {
            {
                bf16x8 bq[8]; float wq[8];
                const size_t Rq = Rq0 + sub * 16 + fr;
#pragma unroll
                for (int hh = 0; hh < 8; ++hh) { bq[hh] = *(const bf16x8*)(IQ + Rq * 256 + hh * 32 + fq * 8); }
                { const f32x4 w0 = *(const f32x4*)(IW + Rq * 8), w1 = *(const f32x4*)(IW + Rq * 8 + 4);
                  wq[0] = w0[0]; wq[1] = w0[1]; wq[2] = w0[2]; wq[3] = w0[3]; wq[4] = w1[0]; wq[5] = w1[1]; wq[6] = w1[2]; wq[7] = w1[3]; }
                const bf16_t* ikp = IK + (Rk0 + fr) * 32 + fq * 8;
                bf16x8 a = *(const bf16x8*)(ikp + (size_t)wid * 16 * 32);
#pragma unroll 1
                for (int kt = wid; kt < nkt; kt += 8) {
                    const int ktn = (kt + 8 < nkt) ? kt + 8 : kt;
                    const bf16x8 an = *(const bf16x8*)(ikp + (size_t)ktn * 16 * 32);
                    f32x4 s = {0.f, 0.f, 0.f, 0.f};
#pragma unroll
                    for (int hh = 0; hh < 8; ++hh) {
                        f32x4 d = {0.f, 0.f, 0.f, 0.f};
                        d = mfma16(a, bq[hh], d);
#pragma unroll
                        for (int r = 0; r < 4; ++r) { const int di = __float_as_int(d[r]); s[r] += __int_as_float(di > 0 ? di : 0) * wq[hh]; }
                    }
                    *(LAS f32x4*)(sc + fr * SC_STRIDE + kt * 16 + 4 * fq) = s;
                    a = an;
                }
            }
            __syncthreads();
#pragma unroll 1
            for (int qq = 0; qq < 2; ++qq) {
                const int ql = 2 * wid + qq;
                unsigned key[33];
                int nadm_q = nadm; asm volatile("" : "+s"(nadm_q));
#pragma unroll
                for (int i = 0; i < 33; ++i) { const int k = lane + 64 * i; const unsigned o = f2ord(sc[ql * SC_STRIDE + k]); key[i] = (k < nadm_q) ? o : 0u; }
                unsigned prefix = 0u; bool exact = false;
#pragma unroll 1
                for (int bit = 31; bit >= 0; --bit) {
                    const unsigned cand = prefix | (1u << bit);
                    int c = 0;
#pragma unroll
                    for (int g = 0; g < 33; g += 8)
                        if (g < ni) {
#pragma unroll
                            for (int i = g; i < g + 8 && i < 33; ++i) c += (key[i] >= cand) ? 1 : 0;
                        }
                    c = wave_sum_dpp(c);
                    if (c >= 256) prefix = cand;
                    if (c == 256) { exact = true; break; }
                }
                int need = 0;
                if (!exact) {
                    int cg = 0;
#pragma unroll
                    for (int i = 0; i < 33; ++i) cg += (key[i] > prefix) ? 1 : 0;
                    need = 256 - wave_sum_dpp(cg);
                }
                int running = 0;
                const unsigned long long lt = (1ull << lane) - 1ull;
#pragma unroll
                for (int i = 0; i < 33; ++i) {
                    bool sel;
                    if (exact) sel = key[i] >= prefix;
                    else {
                        const bool eq = key[i] == prefix;
                        const unsigned long long be = __ballot(eq);
                        const int rank = running + __popcll(be & lt);
                        sel = (key[i] > prefix) || (eq && rank < need);
                        running += __popcll(be);
                    }
                    const unsigned long long bs = __ballot(sel);
                    if (lane == 0) { maskw[(sub * 16 + ql) * 66 + 2 * i] = (unsigned)bs; maskw[(sub * 16 + ql) * 66 + 2 * i + 1] = (unsigned)(bs >> 32); }
                    __builtin_amdgcn_sched_barrier(0);
                }
            }
            __syncthreads();
        }
    }
    __syncthreads();

    MEAS_T1(22, p.ws)
    MEAS_T0(23)
    const int ntile = (nadm + 63) >> 6;
    f32x16 O[4];
#pragma unroll
    for (int mt = 0; mt < 4; ++mt)
#pragma unroll
        for (int r = 0; r < 16; ++r) O[mt][r] = 0.f;
    float mrun = 0.f, lrun = 0.f;
    {
        const bf16_t* kvsrc = C + (Rk0 + (tid >> 4)) * 128 + (tid & 15) * 8;
        const int kvdst0 = kv_off(tid >> 4, tid & 15), kvdst1 = kv_off((tid >> 4) + 32, tid & 15);
        u32x4 rr0 = *(const u32x4*)kvsrc, rr1 = *(const u32x4*)(kvsrc + 32 * 128);
        *(LAS u32x4*)(lds + kvdst0) = rr0; *(LAS u32x4*)(lds + kvdst1) = rr1;
        __syncthreads();
        const int hq = lane >> 5, ql = lane & 31;
        const int tg = lane >> 4, ti = lane & 15, tq = ti >> 2, tp = ti & 3;
#pragma unroll 1
        for (int T = 0; T < ntile; ++T) {
            const bool more = T + 1 < ntile;
            if (more) { rr0 = *(const u32x4*)(kvsrc + (size_t)(T + 1) * 64 * 128); rr1 = *(const u32x4*)(kvsrc + (size_t)(T + 1) * 64 * 128 + 32 * 128); }
            LAS char* kb = lds + (T & 1) * 16384;
            const u32x2 mw2 = *(LAS u32x2*)(maskw + ql * 66 + 2 * T);
            const float nm = -mrun;
            f32x16 S[2];
#pragma unroll
            for (int kh = 0; kh < 2; ++kh) {
                const int mw = (int)((kh ? mw2.y : mw2.x) >> (4 * hq));
#pragma unroll
                for (int r = 0; r < 16; ++r) {
                    const unsigned m = (unsigned)__builtin_amdgcn_sbfe(mw, (r & 3) + 8 * (r >> 2), 1);
                    S[kh][r] = __uint_as_float((__float_as_uint(nm) & m) | (0xf149f2cau & ~m));
                }
#pragma unroll
                for (int ks = 0; ks < 8; ++ks) {
                    const bf16x8 a = *(LAS bf16x8*)(kb + kv_off(32 * kh + ql, 2 * ks + hq));
                    S[kh] = mfma32(a, qf[ks], S[kh]);
                }
            }
            float mx = -3e38f;
#pragma unroll
            for (int kh = 0; kh < 2; ++kh)
#pragma unroll
                for (int r = 0; r < 16; r += 2) mx = fmaxf(fmaxf(mx, S[kh][r]), S[kh][r + 1]);
            mx = fmaxf(mx, __shfl_xor(mx, 32));
            if (__any(mx > DEFER_THR)) {
                const float dm = fmaxf(mx, 0.f);
                const float alpha = __builtin_amdgcn_exp2f(-dm);
                lrun *= alpha; mrun += dm;
#pragma unroll
                for (int mt = 0; mt < 4; ++mt)
#pragma unroll
                    for (int r = 0; r < 16; ++r) O[mt][r] *= alpha;
#pragma unroll
                for (int kh = 0; kh < 2; ++kh)
#pragma unroll
                    for (int r = 0; r < 16; ++r) S[kh][r] -= dm;
            }
            float rs0 = 0.f, rs1 = 0.f;
#pragma unroll
            for (int kh = 0; kh < 2; ++kh)
#pragma unroll
                for (int r = 0; r < 16; r += 2) { S[kh][r] = __builtin_amdgcn_exp2f(S[kh][r]); S[kh][r + 1] = __builtin_amdgcn_exp2f(S[kh][r + 1]); rs0 += S[kh][r]; rs1 += S[kh][r + 1]; }
            float rs = rs0 + rs1;
            rs += __shfl_xor(rs, 32);
            lrun += rs;
            bf16x8 pf[4];
#pragma unroll
            for (int s2 = 0; s2 < 4; ++s2) {
                const int kh = s2 >> 1, o = 8 * (s2 & 1);
                u32x4 w;
                w.x = cvt_pk_bf16(S[kh][o + 0], S[kh][o + 1]); w.y = cvt_pk_bf16(S[kh][o + 2], S[kh][o + 3]);
                w.z = cvt_pk_bf16(S[kh][o + 4], S[kh][o + 5]); w.w = cvt_pk_bf16(S[kh][o + 6], S[kh][o + 7]);
                pf[s2] = __builtin_bit_cast(bf16x8, w);
            }
#pragma unroll
            for (int mt = 0; mt < 4; ++mt)
#pragma unroll
                for (int s2 = 0; s2 < 4; ++s2) {
                    const int colb = 32 * mt + 16 * (tg & 1) + 4 * tp;
                    const int row1 = 16 * s2 + 4 * (tg >> 1) + tq;
                    const s16x4 v0 = __builtin_amdgcn_ds_read_tr16_b64_v4i16((LAS s16x4*)(kb + kv_off(row1, colb >> 3) + (colb & 7) * 2));
                    const s16x4 v1 = __builtin_amdgcn_ds_read_tr16_b64_v4i16((LAS s16x4*)(kb + kv_off(row1 + 8, colb >> 3) + (colb & 7) * 2));
                    bf16x8 a; a[0] = v0[0]; a[1] = v0[1]; a[2] = v0[2]; a[3] = v0[3]; a[4] = v1[0]; a[5] = v1[1]; a[6] = v1[2]; a[7] = v1[3];
                    O[mt] = mfma32(a, pf[s2], O[mt]);
                }
            if (more) { LAS char* nb = lds + ((T + 1) & 1) * 16384; *(LAS u32x4*)(nb + kvdst0) = rr0; *(LAS u32x4*)(nb + kvdst1) = rr1; }
            __syncthreads();
        }
    }
    MEAS_T1(23, p.ws)
    MEAS_T0(24)
    {
        const float inv = 1.f / lrun;
        const int hq = lane >> 5, ql = lane & 31;
        LAS bf16_t* os = (LAS bf16_t*)(lds + 32768) + (size_t)h * 32 * QS_STRIDE;
#pragma unroll
        for (int mt = 0; mt < 4; ++mt)
#pragma unroll
            for (int rg = 0; rg < 4; ++rg) {
                u32x2 o; o.x = cvt_pk_bf16(O[mt][4 * rg] * inv, O[mt][4 * rg + 1] * inv); o.y = cvt_pk_bf16(O[mt][4 * rg + 2] * inv, O[mt][4 * rg + 3] * inv);
                *(LAS u32x2*)(os + ql * QS_STRIDE + 32 * mt + 8 * rg + 4 * hq) = o;
            }
        __syncthreads();
        const bf16_t* Wuv = (const bf16_t*)(p.ws + WS_WUV) + (size_t)h * 64 * 128;
        bf16_t* AT = (bf16_t*)(p.ws + WS_ATTN);
        const size_t n0 = (size_t)b * SEQ + (t0 - 16);
        bf16x8 bo[2][4];
#pragma unroll
        for (int qt = 0; qt < 2; ++qt)
#pragma unroll
            for (int ks = 0; ks < 4; ++ks) bo[qt][ks] = *(LAS bf16x8*)(os + (qt * 16 + fr) * QS_STRIDE + ks * 32 + fq * 8);
#pragma unroll
        for (int dt = 0; dt < 4; ++dt) {
            bf16x8 a[4];
#pragma unroll
            for (int ks = 0; ks < 4; ++ks) a[ks] = *(const bf16x8*)(Wuv + (dt * 16 + fr) * 128 + ks * 32 + fq * 8);
#pragma unroll
            for (int qt = 0; qt < 2; ++qt) {
                f32x4 d = {0.f, 0.f, 0.f, 0.f};
#pragma unroll
                for (int ks = 0; ks < 4; ++ks) d = mfma16(a[ks], bo[qt][ks], d);
                st4bf(AT + (n0 + qt * 16 + fr) * 512 + h * 64 + dt * 16 + 4 * fq, d);
            }
        }
    }
    __syncthreads();
    MEAS_T1(24, p.ws)
}

__device__ __forceinline__ void p2_phase(const Params& p, LAS char* lds) {
    const int tid = threadIdx.x;
    {
        const bf16_t* PV = (const bf16_t*)(p.ws + WS_PV); bf16_t* DD = (bf16_t*)(p.ws + WS_DD);
        for (int rc = blockIdx.x; rc < NTOK / 64; rc += gridDim.x) {
            const int n0 = rc * 64, b = n0 >> 11, s0 = n0 & 2047;
            const size_t R0 = (size_t)b * TT + 16 + s0 - 15;
            for (int idx = tid; idx < 79 * 64; idx += 512) *(LAS u32x4*)(lds + idx * 16) = *(const u32x4*)(PV + R0 * 512 + (size_t)idx * 8);
            __syncthreads();
#pragma unroll 1
            for (int it = 0; it < 8; ++it) {
                const int idx = tid + 512 * it, r = idx >> 6, ch8 = idx & 63;
                const int g = ch8 >> 4, w = 2 << g;
                float a[8];
#pragma unroll
                for (int e = 0; e < 8; ++e) a[e] = 0.f;
                const LAS char* src = lds + ((r + 15) * 64 + ch8) * 16;
                const u32x4 self = *(const LAS u32x4*)src;
                for (int i = 0; i < w; ++i) {
                    const u32x4 v = *(const LAS u32x4*)(src - i * 1024);
                    a[0] += bf_lo(v.x); a[1] += bf_hi(v.x); a[2] += bf_lo(v.y); a[3] += bf_hi(v.y); a[4] += bf_lo(v.z); a[5] += bf_hi(v.z); a[6] += bf_lo(v.w); a[7] += bf_hi(v.w);
                }
                const float iw = 1.f / (float)w;
                u32x4 o;
                o.x = cvt_pk_bf16(a[0] * iw - bf_lo(self.x), a[1] * iw - bf_hi(self.x)); o.y = cvt_pk_bf16(a[2] * iw - bf_lo(self.y), a[3] * iw - bf_hi(self.y));
                o.z = cvt_pk_bf16(a[4] * iw - bf_lo(self.z), a[5] * iw - bf_hi(self.z)); o.w = cvt_pk_bf16(a[6] * iw - bf_lo(self.w), a[7] * iw - bf_hi(self.w));
                *(u32x4*)(DD + (size_t)(n0 + r) * 512 + ch8 * 8) = o;
            }
            __syncthreads();
        }
    }
    for (int x = blockIdx.x; x < 256; x += gridDim.x) {
        const int b = x & 7, r = x >> 3;
#pragma unroll 1
        for (int rep = 0; rep < 2; ++rep) attn_item(p, b, rep == 0 ? 32 - (r >> 1) : 1 + (r >> 1), r & 1, lds);
    }
}

struct P3Sched {
    g8::TileOrder T; const char *AT, *DD, *WA, *WF;
    __device__ __forceinline__ bool next(int i, g8::Unit& u, int) const {
        int pm, pn; if (!T.tile(i >> 1, pm, pn)) return false;
        const int br = i & 1;
        u.A = (br ? DD : AT) + (size_t)pm * 256 * 512 * 2; u.B = (br ? WF : WA) + (size_t)pn * 256 * 512 * 2; u.i0 = pm; u.i1 = pn; u.i2 = br; return true;
    }
};
struct P3Epi {
    const Params* pp;
    __device__ __forceinline__ void operator()(f32x4 (&acc)[2][2][4][2], const g8::Unit& u, int wr, int wc, int fr, int fq, LAS char*) const {
        const Params& p = *pp;
        const bf16_t* GT = (const bf16_t*)(p.ws + WS_GATES); bf16_t* MG = (bf16_t*)(p.ws + WS_U);
        const int rowb = u.i0 * 256 + wr * 64 + fr, colb = u.i1 * 256 + wc * 32 + 4 * fq, br = u.i2;
        FOR_ACC(ai, bj, m, n) {
            const int nrow = rowb + ai * 128 + m * 16, col = colb + bj * 128 + n * 16;
            const size_t R = (size_t)nrow + 16 + 16 * (nrow >> 11);
            const u32x2 g = *(const u32x2*)(GT + R * 2048 + br * 1024 + col);
            f32x4 v = acc[ai][bj][m][n];
            v[0] *= bf_lo(g.x); v[1] *= bf_hi(g.x); v[2] *= bf_lo(g.y); v[3] *= bf_hi(g.y);
            if (br) { const u32x2 pr = *(const u32x2*)(MG + (size_t)nrow * 1024 + col); v[0] += bf_lo(pr.x); v[1] += bf_hi(pr.x); v[2] += bf_lo(pr.y); v[3] += bf_hi(pr.y); }
            st4bf(MG + (size_t)nrow * 1024 + col, v);
        }
    }
};
__device__ __forceinline__ void p3_phase(const Params& p, LAS char* lds) {
    P3Sched S; S.T.init(NTOK / 256, 4, gridDim.x, blockIdx.x);
    S.AT = (const char*)(p.ws + WS_ATTN); S.DD = (const char*)(p.ws + WS_DD); S.WA = (const char*)(p.ws + WS_WA); S.WF = (const char*)(p.ws + WS_WF);
    P3Epi E{&p};
    g8::gemm_phase<P3Epi, P3Sched, false>(lds, 512, S, E);
}

struct P4Sched {
    g8::TileOrder T; const char *MG, *WO;
    __device__ __forceinline__ bool next(int i, g8::Unit& u, int) const {
        int pm, pn; if (!T.tile(i, pm, pn)) return false;
        u.A = MG + (size_t)pm * 256 * 1024 * 2; u.B = WO + (size_t)pn * 256 * 1024 * 2; u.i0 = pm; u.i1 = pn; return true;
    }
};
struct P4Epi {
    const Params* pp;
    __device__ __forceinline__ void operator()(f32x4 (&acc)[2][2][4][2], const g8::Unit& u, int wr, int wc, int fr, int fq, LAS char*) const {
        const Params& p = *pp;
        const int rowb = u.i0 * 256 + wr * 64 + fr, colb = u.i1 * 256 + wc * 32 + 4 * fq;
        FOR_ACC(ai, bj, m, n) {
            const size_t off = (size_t)(rowb + ai * 128 + m * 16) * 1024 + colb + bj * 128 + n * 16;
            *(f32x4*)(p.out + off) = *(const f32x4*)(p.x + off) + acc[ai][bj][m][n];
        }
    }
};
__device__ __forceinline__ void p4_phase(const Params& p, LAS char* lds) {
    P4Sched S; S.T.init(NTOK / 256, 4, gridDim.x, blockIdx.x); S.MG = (const char*)(p.ws + WS_U); S.WO = (const char*)(p.ws + WS_WO);
    P4Epi E{&p};
    g8::gemm_phase<P4Epi, P4Sched, false>(lds, 1024, S, E);
}

constexpr int P5_USTR = 1032;
constexpr int P5_ULO = 32 * P5_USTR * 2;
constexpr int P5_PART = 2 * P5_ULO;
constexpr int P5_MISC = P5_PART + 4 * 48 * 32 * 4;
__device__ __forceinline__ void p5_phase(const Params& p, LAS char* lds) {
    const int tid = threadIdx.x, wid = __builtin_amdgcn_readfirstlane(tid >> 6), lane = tid & 63, fr0 = lane & 15, fq0 = lane >> 4;
    LAS bf16_t* Uhi = (LAS bf16_t*)lds; LAS bf16_t* Ulo = (LAS bf16_t*)(lds + P5_ULO);
    LAS float* part = (LAS float*)(lds + P5_PART);
    LAS int* lcnt = (LAS int*)(lds + P5_MISC);
    LAS int* lbase = lcnt + 32;
    LAS int* tk_e = lbase + 32;
    LAS int* tk_r = tk_e + 128;
    LAS float* tk_w = (LAS float*)(tk_r + 128);
    bf16_t* U2 = (bf16_t*)(p.ws + WS_U);
    const bf16_t* WRH = (const bf16_t*)(p.ws + WS_WRH); const bf16_t* WRL = (const bf16_t*)(p.ws + WS_WRL);
    int* cnt = (int*)(p.ws + WS_CNT); int* list = (int*)(p.ws + WS_LIST); float* wts = (float*)(p.ws + WS_WTS); int* tokrow = (int*)(p.ws + WS_TOKROW);
    for (int chunk = blockIdx.x; chunk < NTOK / 64; chunk += gridDim.x) {
        if (tid < 32) lcnt[tid] = 0;
        f32x4 gg[4];
#pragma unroll
        for (int j = 0; j < 4; ++j) gg[j] = *(const f32x4*)(p.norm2_g + j * 256 + lane * 4);
#pragma unroll 1
        for (int pass = 0; pass < 2; ++pass) {
            const int tb0 = chunk * 64 + pass * 32;
            f32x4 v[4][4];
#pragma unroll
            for (int t = 0; t < 4; ++t)
#pragma unroll
                for (int j = 0; j < 4; ++j) v[t][j] = *(const f32x4*)(p.out + (size_t)(tb0 + wid * 4 + t) * 1024 + j * 256 + lane * 4);
#pragma unroll
            for (int t = 0; t < 4; ++t) {
                float ss = 0.f;
#pragma unroll
                for (int j = 0; j < 4; ++j) ss += v[t][j][0] * v[t][j][0] + v[t][j][1] * v[t][j][1] + v[t][j][2] * v[t][j][2] + v[t][j][3] * v[t][j][3];
                ss = wave_sum(ss);
                const float rstd = rsqrtf(ss * (1.f / 1024.f) + EPS);
                const int tl = wid * 4 + t;
#pragma unroll
                for (int j = 0; j < 4; ++j) {
                    const f32x4 u = v[t][j] * rstd * gg[j];
                    u32x2 hi; hi.x = cvt_pk_bf16(u[0], u[1]); hi.y = cvt_pk_bf16(u[2], u[3]);
                    u32x2 lo; lo.x = cvt_pk_bf16(u[0] - bf_lo(hi.x), u[1] - bf_hi(hi.x)); lo.y = cvt_pk_bf16(u[2] - bf_lo(hi.y), u[3] - bf_hi(hi.y));
                    *(u32x2*)(U2 + (size_t)(tb0 + tl) * 1024 + j * 256 + lane * 4) = hi;
                    *(LAS u32x2*)(Uhi + tl * P5_USTR + j * 256 + lane * 4) = hi;
                    *(LAS u32x2*)(Ulo + tl * P5_USTR + j * 256 + lane * 4) = lo;
                }
            }
            __syncthreads();
            {
                const int tw = wid & 1, kq = wid >> 1;
                int fr = fr0, fq = fq0; asm volatile("" : "+v"(fr), "+v"(fq));
                f32x4 acc[3];
#pragma unroll
                for (int ot = 0; ot < 3; ++ot) acc[ot] = (f32x4){0.f, 0.f, 0.f, 0.f};
                const LAS bf16_t* bh = Uhi + (tw * 16 + fr) * P5_USTR + kq * 256 + fq * 8;
                const LAS bf16_t* bl = Ulo + (tw * 16 + fr) * P5_USTR + kq * 256 + fq * 8;
                const bf16_t* ah = WRH + (size_t)fr * 1024 + kq * 256 + fq * 8;
                const bf16_t* al = WRL + (size_t)fr * 1024 + kq * 256 + fq * 8;
#pragma unroll 2
                for (int ks = 0; ks < 8; ++ks) {
                    const bf16x8 bhi = *(const LAS bf16x8*)(bh + ks * 32), blo = *(const LAS bf16x8*)(bl + ks * 32);
#pragma unroll
                    for (int ot = 0; ot < 3; ++ot) {
                        const bf16x8 ahi = *(const bf16x8*)(ah + (size_t)ot * 16 * 1024 + ks * 32), alo = *(const bf16x8*)(al + (size_t)ot * 16 * 1024 + ks * 32);
                        acc[ot] = mfma16(ahi, bhi, acc[ot]); acc[ot] = mfma16(alo, bhi, acc[ot]); acc[ot] = mfma16(ahi, blo, acc[ot]);
                    }
                }
#pragma unroll
                for (int ot = 0; ot < 3; ++ot)
#pragma unroll
                    for (int r = 0; r < 4; ++r) part[(kq * 48 + ot * 16 + 4 * fq + r) * 32 + tw * 16 + fr] = acc[ot][r];
            }
            __syncthreads();
            if (tid < 32) {
                float L[36];
                int tq = tid; asm volatile("" : "+v"(tq));
                const LAS float* pt = part + tq;
#pragma unroll
                for (int o = 0; o < 36; ++o) L[o] = (pt[o * 32] + pt[(48 + o) * 32]) + (pt[(96 + o) * 32] + pt[(144 + o) * 32]);
                float gl[4];
#pragma unroll
                for (int g = 0; g < 4; ++g) gl[g] = L[g] + p.b_gr[g];
                int gs = 0; float gm = gl[0];
#pragma unroll
                for (int g = 1; g < 4; ++g) if (gl[g] > gm) { gm = gl[g]; gs = g; }
                float gsum = 0.f;
#pragma unroll
                for (int g = 0; g < 4; ++g) gsum += __expf(gl[g] - gm);
                const float pg = 1.f / gsum;
                float el[8];
#pragma unroll
                for (int e = 0; e < 8; ++e) {
                    const float l0 = L[4 + e] + p.b_er[e], l1 = L[12 + e] + p.b_er[8 + e], l2 = L[20 + e] + p.b_er[16 + e], l3 = L[28 + e] + p.b_er[24 + e];
                    el[e] = gs == 0 ? l0 : (gs == 1 ? l1 : (gs == 2 ? l2 : l3));
                }
                int i1 = 0; float v1 = el[0];
#pragma unroll
                for (int e = 1; e < 8; ++e) if (el[e] > v1) { v1 = el[e]; i1 = e; }
                int i2 = (i1 == 0) ? 1 : 0; float v2 = -INFINITY;
#pragma unroll
                for (int e = 0; e < 8; ++e) if (e != i1 && el[e] > v2) { v2 = el[e]; i2 = e; }
                const float e2 = __expf(v2 - v1), p1 = 1.f / (1.f + e2), p2 = e2 * p1;
                const int tl = pass * 32 + tid, ea = gs * 8 + i1, eb = gs * 8 + i2;
                tk_e[tl * 2] = ea; tk_e[tl * 2 + 1] = eb;
                tk_r[tl * 2] = __hip_atomic_fetch_add(&lcnt[ea], 1, __ATOMIC_RELAXED, __HIP_MEMORY_SCOPE_WORKGROUP); tk_r[tl * 2 + 1] = __hip_atomic_fetch_add(&lcnt[eb], 1, __ATOMIC_RELAXED, __HIP_MEMORY_SCOPE_WORKGROUP);
                tk_w[tl * 2] = pg * p1; tk_w[tl * 2 + 1] = pg * p2;
            }
            __syncthreads();
        }
        if (tid < 32) lbase[tid] = atomicAdd(&cnt[tid], lcnt[tid]);
        __syncthreads();
        if (tid < 128) {
            const int e = tk_e[tid], slot = lbase[e] + tk_r[tid], n = chunk * 64 + (tid >> 1);
            list[e * LISTCAP + slot] = n; wts[e * LISTCAP + slot] = tk_w[tid]; tokrow[n * 2 + (tid & 1)] = e * LISTCAP + slot;
        }
        __syncthreads();
    }
}

__device__ __forceinline__ void moe_tables(const Params& p, LAS int* tb) {
    if (threadIdx.x == 0) {
        const int* cnt = (const int*)(p.ws + WS_CNT);
        int acc = 0;
        for (int e = 0; e < 32; ++e) { const int c = __hip_atomic_load(cnt + e, __ATOMIC_RELAXED, __HIP_MEMORY_SCOPE_AGENT); tb[e] = c; tb[32 + e] = acc; acc += (c + 255) >> 8; }
        tb[64] = acc;
    }
    __syncthreads();
}

struct P6Sched {
    const LAS int* tb; const char *U2, *W1; const int* list; int G, c, nunits;
    __device__ __forceinline__ bool next(int i, g8::Unit& u, int tid) const {
        const int g = i * G + c; if (g >= nunits) return false;
        int e = 0;
#pragma unroll 1
        for (int q = 1; q < 32; ++q) if (2 * tb[32 + q] <= g) e = q;
        const int nte = tb[33 + e] - tb[32 + e], l = g - 2 * tb[32 + e], pn = l / nte, rt = l - pn * nte, ce = tb[e];
        u.A = U2; u.B = W1 + ((size_t)e * 512 + pn * 256) * 1024 * 2; u.i0 = e; u.i1 = rt; u.i2 = pn; u.i3 = tb[32 + e] + rt;
#pragma unroll
        for (int h = 0; h < 2; ++h)
#pragma unroll
            for (int k = 0; k < 2; ++k) { int sR, sC; g8::stage_rc(tid * 16 + k * 8192, sR, sC); const int slot = rt * 256 + h * 128 + sR; const int tok = slot < ce ? list[e * LISTCAP + slot] : 0; u.va[h][k] = (unsigned)(tok * 1024 + sC) * 2u; }
        return true;
    }
};
struct P6Epi {
    const Params* pp; const LAS int* tb;
    __device__ __forceinline__ void operator()(f32x4 (&acc)[2][2][4][2], const g8::Unit& u, int wr, int wc, int fr, int fq, LAS char*) const {
        const Params& p = *pp;
        const float* wts = (const float*)(p.ws + WS_WTS); bf16_t* HID = (bf16_t*)(p.ws + WS_HID);
        const int e = u.i0, rt = u.i1, pn = u.i2, ce = tb[e];
        const size_t rowbase = (size_t)u.i3 * 256;
#pragma unroll
        for (int ai = 0; ai < 2; ++ai)
#pragma unroll
            for (int m = 0; m < 4; ++m) {
                const int lr = ai * 128 + wr * 64 + m * 16 + fr, slot = rt * 256 + lr;
                const float w = slot < ce ? wts[e * LISTCAP + slot] : 0.f;
#pragma unroll
                for (int n = 0; n < 2; ++n) {
                    const f32x4 g = acc[ai][0][m][n], uu = acc[ai][1][m][n]; f32x4 hv;
#pragma unroll
                    for (int r = 0; r < 4; ++r) hv[r] = g[r] * __builtin_amdgcn_rcpf(1.f + __expf(-g[r])) * uu[r] * w;
                    st4bf(HID + (rowbase + lr) * 256 + pn * 128 + wc * 32 + n * 16 + 4 * fq, hv);
                }
            }
    }
};
__device__ __forceinline__ void p6_phase(const Params& p, LAS char* lds) {
    LAS int* tb = (LAS int*)(lds + GX_OFF);
    moe_tables(p, tb);
    P6Sched S; S.tb = tb; S.U2 = (const char*)(p.ws + WS_U); S.W1 = (const char*)(p.ws + WS_W1); S.list = (const int*)(p.ws + WS_LIST); S.G = gridDim.x; S.c = vcu_id(); S.nunits = tb[64] * 2;
    P6Epi E{&p, tb};
    g8::gemm_phase<P6Epi, P6Sched, true>(lds, 1024, S, E);
}

struct P7Sched {
    const LAS int* tb; const char *HID, *W2; int G, c, nunits;
    __device__ __forceinline__ bool next(int i, g8::Unit& u, int) const {
        const int g = i * G + c; if (g >= nunits) return false;
        int e = 0;
#pragma unroll 1
        for (int q = 1; q < 32; ++q) if (4 * tb[32 + q] <= g) e = q;
        const int nte = tb[33 + e] - tb[32 + e], l = g - 4 * tb[32 + e], pn = l / nte, rt = l - pn * nte, ti = tb[32 + e] + rt;
        u.A = HID + (size_t)ti * 256 * 256 * 2; u.B = W2 + ((size_t)e * 1024 + pn * 256) * 256 * 2; u.i0 = ti; u.i1 = pn; return true;
    }
};
struct P7Epi {
    const Params* pp;
    __device__ __forceinline__ void operator()(f32x4 (&acc)[2][2][4][2], const g8::Unit& u, int wr, int wc, int fr, int fq, LAS char*) const {
        bf16_t* Y = (bf16_t*)(pp->ws + WS_Y);
        FOR_ACC(ai, bj, m, n) st4bf(Y + ((size_t)u.i0 * 256 + ai * 128 + wr * 64 + m * 16 + fr) * 1024 + u.i1 * 256 + bj * 128 + wc * 32 + n * 16 + 4 * fq, acc[ai][bj][m][n]);
    }
};
__device__ __forceinline__ void p7_phase(const Params& p, LAS char* lds) {
    LAS int* tb = (LAS int*)(lds + GX_OFF);
    moe_tables(p, tb);
    P7Sched S; S.tb = tb; S.HID = (const char*)(p.ws + WS_HID); S.W2 = (const char*)(p.ws + WS_W2); S.G = gridDim.x; S.c = vcu_id(); S.nunits = tb[64] * 4;
    P7Epi E{&p};
    g8::gemm_phase<P7Epi, P7Sched, false>(lds, 256, S, E);
}

__device__ __forceinline__ void p8_phase(const Params& p, LAS char* lds) {
    const int tid = threadIdx.x, wid = tid >> 6, lane = tid & 63;
    LAS int* tb = (LAS int*)lds;
    moe_tables(p, tb);
    const bf16_t* Y = (const bf16_t*)(p.ws + WS_Y); const int* tokrow = (const int*)(p.ws + WS_TOKROW);
    for (int n = blockIdx.x * 8 + wid; n < NTOK; n += gridDim.x * 8) {
        const int r1 = tokrow[n * 2], r2 = tokrow[n * 2 + 1];
        const size_t y1 = (size_t)tb[32 + (r1 >> 14)] * 256 + (r1 & 16383), y2 = (size_t)tb[32 + (r2 >> 14)] * 256 + (r2 & 16383);
        f32x4 v[4]; float ss = 0.f;
#pragma unroll
        for (int j = 0; j < 4; ++j) {
            v[j] = *(const f32x4*)(p.out + (size_t)n * 1024 + j * 256 + lane * 4);
            const u32x2 a = *(const u32x2*)(Y + y1 * 1024 + j * 256 + lane * 4), c = *(const u32x2*)(Y + y2 * 1024 + j * 256 + lane * 4);
            v[j][0] += bf_lo(a.x) + bf_lo(c.x); v[j][1] += bf_hi(a.x) + bf_hi(c.x); v[j][2] += bf_lo(a.y) + bf_lo(c.y); v[j][3] += bf_hi(a.y) + bf_hi(c.y);
            ss += v[j][0] * v[j][0] + v[j][1] * v[j][1] + v[j][2] * v[j][2] + v[j][3] * v[j][3];
        }
        ss = wave_sum(ss);
        const float rstd = rsqrtf(ss * (1.f / 1024.f) + EPS);
#pragma unroll
        for (int j = 0; j < 4; ++j) { const f32x4 g = *(const f32x4*)(p.final_g + j * 256 + lane * 4); *(f32x4*)(p.out + (size_t)n * 1024 + j * 256 + lane * 4) = v[j] * rstd * g; }
    }
}

__global__ void __launch_bounds__(512, 2) fwd_kernel(Params p) {
    extern __shared__ __attribute__((aligned(16))) unsigned char smem[];
    LAS char* lds = (LAS char*)smem;
    volatile LAS unsigned* barw = (volatile LAS unsigned*)(lds + LDS_BARW);
    if (threadIdx.x < 2) barw[threadIdx.x] = 0u;
    __syncthreads();
    XcdBarrier bar; bar.bar = (unsigned*)(p.ws + WS_BAR); bar.x = 0; bar.st = nullptr;
    if (N_LAUNCHES == 1) bar = xcd_barrier_post((unsigned*)(p.ws + WS_BAR), barw);
    const int lo = p.ph_lo, hi = p.ph_hi;
#define IN(k) (lo <= (k) && (k) < hi)
#define SEAM(k) do { if (IN(k) && IN((k) + 1)) xcd_barrier(bar); } while (0)
#ifndef PH_MASK
#define PH_MASK 0x7ff
#endif
#define HAS(k) ((PH_MASK >> (k)) & 1)
    if (HAS(0) && IN(0)) { MEAS_T0(10) p0_phase(p, lds); MEAS_T1(10, p.ws) if (DUP_PHASE == 0) { xcd_barrier(bar); p0_phase(p, lds); } } SEAM(0);
    if (HAS(1) && IN(1)) { MEAS_T0(11) p1_phase(p, lds); MEAS_T1(11, p.ws) if (DUP_PHASE == 1) { xcd_barrier(bar); p1_phase(p, lds); } } SEAM(1);
    if (HAS(2) && IN(2)) { MEAS_T0(12) p2_phase(p, lds); MEAS_T1(12, p.ws) if (DUP_PHASE == 2) { xcd_barrier(bar); p2_phase(p, lds); } } SEAM(2);
    if (HAS(3) && IN(3)) { MEAS_T0(13) p3_phase(p, lds); MEAS_T1(13, p.ws) if (DUP_PHASE == 3) { xcd_barrier(bar); p3_phase(p, lds); } } SEAM(3);
    if (HAS(4) && IN(4)) { MEAS_T0(14) p4_phase(p, lds); MEAS_T1(14, p.ws) if (DUP_PHASE == 4) { xcd_barrier(bar); p4_phase(p, lds); } } SEAM(4);
    if (HAS(5) && IN(5)) { MEAS_T0(15) p5_phase(p, lds); MEAS_T1(15, p.ws) if (DUP_PHASE == 5) { xcd_barrier(bar); if (blockIdx.x == 0 && threadIdx.x < 32) ((int*)(p.ws + WS_CNT))[threadIdx.x] = 0; xcd_barrier(bar); p5_phase(p, lds); } } SEAM(5);
    if (HAS(6) && IN(6)) { MEAS_T0(16) p6_phase(p, lds); MEAS_T1(16, p.ws) if (DUP_PHASE == 6) { xcd_barrier(bar); p6_phase(p, lds); } } SEAM(6);
    if (HAS(7) && IN(7)) { MEAS_T0(17) p7_phase(p, lds); MEAS_T1(17, p.ws) if (DUP_PHASE == 7) { xcd_barrier(bar); p7_phase(p, lds); } } SEAM(7);
    if (HAS(8) && IN(8)) { MEAS_T0(18) p8_phase(p, lds); MEAS_T1(18, p.ws) }
    if (MEAS_SEC != 0 && blockIdx.x == 0 && threadIdx.x == 0) {
        const unsigned long long d = *(volatile unsigned long long*)(p.ws + WS_CNT + 128);
        const unsigned long long t0 = __builtin_amdgcn_s_memtime();
        while (__builtin_amdgcn_s_memtime() - t0 < d * MEAS_MULT) __builtin_amdgcn_s_sleep(8);
    }
}

extern "C" void kernel_launch(void* const* d_in, const int* in_sizes, int n_in, void* d_out, int out_size, void* d_ws, size_t ws_size, hipStream_t stream) {
    static int grid = 0;
    if (grid == 0) {
        if (n_in != 21 || ws_size < WS_END) { fprintf(stderr, "kernel_launch: unexpected n_in %d or ws_size %zu (< %zu)\n", n_in, ws_size, (size_t)WS_END); grid = -1; return; }
        int dev = 0, cus = 0;
        if (hipGetDevice(&dev) != hipSuccess || hipDeviceGetAttribute(&cus, hipDeviceAttributeMultiprocessorCount, dev) != hipSuccess) { grid = -1; return; }
        if (hipFuncSetAttribute((const void*)fwd_kernel, hipFuncAttributeMaxDynamicSharedMemorySize, LDS_BYTES) != hipSuccess) { fprintf(stderr, "kernel_launch: hipFuncSetAttribute failed\n"); grid = -1; return; }
        grid = cus;
    }
    if (grid < 0) return;
    (void)hipMemsetAsync((char*)d_ws + WS_BAR, 0, WS_ZERO_BYTES, stream);
    Params p{};
    const float** f = (const float**)&p;
    for (int i = 0; i < 21; ++i) f[i] = (const float*)d_in[i];
    p.out = (float*)d_out; p.ws = (unsigned char*)d_ws;
    if (N_LAUNCHES == 1) { p.ph_lo = 0; p.ph_hi = NPH; hipLaunchKernelGGL(fwd_kernel, dim3(grid), dim3(512), LDS_BYTES, stream, p); }
    else for (int k = 0; k < NPH; ++k) { p.ph_lo = k; p.ph_hi = k + 1; hipLaunchKernelGGL(fwd_kernel, dim3(grid), dim3(512), LDS_BYTES, stream, p); }
}
```

```cpp
#include <hip/hip_runtime.h>
#include <stdint.h>
#include <stdio.h>

#ifndef DUP_PHASE
#define DUP_PHASE -1
#endif
#ifndef MEAS_SEC
#define MEAS_SEC 0
#endif
#ifndef MEAS_BLK
#define MEAS_BLK 0
#endif
#ifndef MEAS_MULT
#define MEAS_MULT 100
#endif
#ifndef EXTRA_MEMSET
#define EXTRA_MEMSET 0
#endif
#ifndef N_LAUNCHES
#define N_LAUNCHES 1
#endif

#define LAS __attribute__((address_space(3)))
typedef unsigned short bf16_t;
typedef short bf16x8 __attribute__((ext_vector_type(8)));
typedef short s16x4 __attribute__((ext_vector_type(4)));
typedef float f32x4 __attribute__((ext_vector_type(4)));
typedef float f32x16 __attribute__((ext_vector_type(16)));
typedef unsigned u32x4 __attribute__((ext_vector_type(4)));
typedef unsigned u32x2 __attribute__((ext_vector_type(2)));

constexpr int NB = 8, SEQ = 2048, TT = 2064, DM = 1024;
constexpr int MALL = NB * TT;
constexpr int MPAD = 16640;
constexpr int NTOK = NB * SEQ;
constexpr int INW = 3496, INP = 3584;
constexpr float EPS = 1e-6f;
constexpr float ATTN_SCALE = 0.125f;
constexpr float IDX_SCALE = 0.0625f;
constexpr float LOG2E = 1.4426950408889634f;
constexpr int NPH = 9;
constexpr int LISTCAP = 16384;
constexpr int YROWS = 40960;

constexpr size_t AL(size_t x) { return (x + 255) & ~(size_t)255; }
constexpr size_t WS_BAR   = 0;
constexpr size_t WS_CNT   = WS_BAR + 16384;
constexpr size_t WS_READY = WS_CNT + 256;
constexpr size_t WS_ZERO_BYTES = 16384 + 4096;
constexpr size_t WS_WIN   = AL(WS_CNT + 4096);
constexpr size_t WS_WUK   = AL(WS_WIN + (size_t)INP * DM * 2);
constexpr size_t WS_WUV   = AL(WS_WUK + 8 * 128 * 64 * 2);
constexpr size_t WS_WF    = AL(WS_WUV + 8 * 64 * 128 * 2);
constexpr size_t WS_WA    = AL(WS_WF + 1024 * 512 * 2);
constexpr size_t WS_WO    = AL(WS_WA + 1024 * 512 * 2);
constexpr size_t WS_W1    = AL(WS_WO + 1024 * 1024 * 2);
constexpr size_t WS_W2    = AL(WS_W1 + (size_t)32 * 512 * 1024 * 2);
constexpr size_t WS_WRH   = AL(WS_W2 + (size_t)32 * 1024 * 256 * 2);
constexpr size_t WS_WRL   = AL(WS_WRH + 48 * 1024 * 2);
constexpr size_t WS_U     = AL(WS_WRL + 48 * 1024 * 2);
constexpr size_t WS_LIST  = AL(WS_U + (size_t)MPAD * DM * 2);
constexpr size_t WS_WTS   = AL(WS_LIST + (size_t)32 * LISTCAP * 4);
constexpr size_t WS_TOKROW= AL(WS_WTS + (size_t)32 * LISTCAP * 4);
constexpr size_t WS_UNION = AL(WS_TOKROW + (size_t)NTOK * 2 * 4);
constexpr size_t WS_Q     = WS_UNION;
constexpr size_t WS_C     = AL(WS_Q + (size_t)MPAD * 512 * 2);
constexpr size_t WS_IQ    = AL(WS_C + (size_t)MPAD * 128 * 2);
constexpr size_t WS_IK    = AL(WS_IQ + (size_t)MPAD * 256 * 2);
constexpr size_t WS_IW    = AL(WS_IK + (size_t)MPAD * 32 * 2);
constexpr size_t WS_PV    = AL(WS_IW + (size_t)MPAD * 8 * 4);
constexpr size_t WS_GATES = AL(WS_PV + (size_t)MPAD * 512 * 2);
constexpr size_t WS_ATTN  = AL(WS_GATES + (size_t)MPAD * 2048 * 2);
constexpr size_t WS_DD    = AL(WS_ATTN + (size_t)NTOK * 512 * 2);
constexpr size_t WS_ENDA  = AL(WS_DD + (size_t)NTOK * 512 * 2);
constexpr size_t WS_HID   = WS_UNION;
constexpr size_t WS_Y     = AL(WS_HID + (size_t)YROWS * 256 * 2);
constexpr size_t WS_H2    = AL(WS_Y + (size_t)YROWS * 1024 * 2);
constexpr size_t WS_ENDB  = AL(WS_H2 + (size_t)NTOK * 1024 * 2);
constexpr size_t WS_END   = WS_ENDA > WS_ENDB ? WS_ENDA : WS_ENDB;

constexpr int LDS_BYTES = 156 * 1024;
constexpr int LDS_BARW  = LDS_BYTES - 16;

struct Params {
    const float *x, *meta, *norm1_g, *w_in, *kv_norm_g, *w_uk, *w_uv, *w_pool, *pool_scale, *w_ba, *w_bp, *w_out, *norm2_g,
                *w_gr, *b_gr, *w_er, *b_er, *w_eg, *w_eu, *w_ed, *final_g;
    float* out; unsigned char* ws; int ph_lo, ph_hi;
};

typedef __bf16 bf16v2_t __attribute__((ext_vector_type(2)));
typedef float f32x2 __attribute__((ext_vector_type(2)));
__device__ __forceinline__ unsigned cvt_pk_bf16(float lo, float hi) { const f32x2 v = {lo, hi}; return __builtin_bit_cast(unsigned, __builtin_convertvector(v, bf16v2_t)); }
__device__ __forceinline__ float bf_lo(unsigned u) { return __uint_as_float(u << 16); }
__device__ __forceinline__ float bf_hi(unsigned u) { return __uint_as_float(u & 0xffff0000u); }
__device__ __forceinline__ float wave_sum(float v) {
#pragma unroll
    for (int o = 1; o < 64; o <<= 1) v += __shfl_xor(v, o);
    return v;
}
__device__ __forceinline__ void st4bf(bf16_t* p, f32x4 v) { u32x2 o; o.x = cvt_pk_bf16(v[0], v[1]); o.y = cvt_pk_bf16(v[2], v[3]); *(u32x2*)p = o; }
__device__ __forceinline__ f32x4 mfma16(bf16x8 a, bf16x8 b, f32x4 c) { return __builtin_amdgcn_mfma_f32_16x16x32_bf16(a, b, c, 0, 0, 0); }
__device__ __forceinline__ f32x16 mfma32(bf16x8 a, bf16x8 b, f32x16 c) { return __builtin_amdgcn_mfma_f32_32x32x16_bf16(a, b, c, 0, 0, 0); }

#define MEAS_T0(k) unsigned long long _mt##k = 0; if (MEAS_SEC == (k) || ((k) == 30 && MEAS_SEC >= 31 && MEAS_SEC <= 33)) { __builtin_amdgcn_sched_barrier(0); _mt##k = __builtin_amdgcn_s_memtime(); __builtin_amdgcn_sched_barrier(0); }
#define MEAS_T1(k, ws) if (MEAS_SEC == (k)) { __builtin_amdgcn_s_waitcnt(0); __builtin_amdgcn_sched_barrier(0); const unsigned long long _d = __builtin_amdgcn_s_memtime() - _mt##k; \
    if (blockIdx.x == MEAS_BLK && threadIdx.x == 0) { unsigned long long* _slot = (unsigned long long*)((ws) + WS_CNT + 128); if (*_slot == 0ull) *_slot = _d; } }

#define MEAS_T1X(k, k0, ws) if (MEAS_SEC == (k)) { __builtin_amdgcn_s_waitcnt(0); const unsigned long long _d = __builtin_amdgcn_s_memtime() - _mt##k0; \
    if (blockIdx.x == MEAS_BLK && threadIdx.x == 0) { unsigned long long* _slot = (unsigned long long*)((ws) + WS_CNT + 128); if (*_slot == 0ull) *_slot = _d; } }
#define XB_TMO      128
#define XB_XCNT(j)  (256  + 64 * (j))
#define XB_XSUB(j)  (1280 + 64 * (j))
#define XB_XGEN(j)  (2304 + 64 * (j))
#define XB_TOP      3328
#define XB_TOPGEN   3392
#define XCD_BAR_WORDS 3456
#define XB_SPIN_CAP (1u << 20)
__device__ __forceinline__ unsigned xb_ld(unsigned* p)              { return __hip_atomic_load(p, __ATOMIC_RELAXED, __HIP_MEMORY_SCOPE_AGENT); }
__device__ __forceinline__ unsigned xb_add(unsigned* p, unsigned v) { return __hip_atomic_fetch_add(p, v, __ATOMIC_RELAXED, __HIP_MEMORY_SCOPE_AGENT); }
__device__ __forceinline__ unsigned xb_xcc_id() { return (unsigned)__builtin_amdgcn_s_getreg((3 << 11) | 20) & 0xFu; }
#define XB_SPIN(cond, bar) do { unsigned _sp = 0; while (cond) { __builtin_amdgcn_s_sleep(1); \
    if ((++_sp & 255u) == 0u) { if (xb_ld(&(bar)[XB_TMO])) break; if (_sp > XB_SPIN_CAP) { atomicAdd(&(bar)[XB_TMO], 1u); break; } } } } while (0)
struct XcdBarrier { unsigned* bar; unsigned x; volatile LAS unsigned* st; };
__device__ __forceinline__ XcdBarrier xcd_barrier_post(unsigned* bar, volatile LAS unsigned* st) {
    XcdBarrier b; b.bar = bar; b.x = xb_xcc_id(); b.st = st;
    if (threadIdx.x == 0) (void)xb_add(&bar[XB_XCNT(b.x)], 1u);
    return b;
}
__device__ __forceinline__ void xcd_barrier_complete(unsigned* bar, unsigned x, unsigned& nloc, unsigned& nx) {
    const unsigned G = gridDim.x * gridDim.y * gridDim.z;
    unsigned sum, cnt, mine, sp = 0u;
    for (;;) {
        sum = 0u; cnt = 0u; mine = 0u;
#pragma unroll
        for (unsigned j = 0; j < 16; ++j) { const unsigned c = xb_ld(&bar[XB_XCNT(j)]); sum += c; cnt += (c > 0u) ? 1u : 0u; mine = (j == x) ? c : mine; }
        if (sum == G) break;
        __builtin_amdgcn_s_sleep(1);
        if ((++sp & 255u) == 0u) { if (xb_ld(&bar[XB_TMO])) break; if (sp > XB_SPIN_CAP) { atomicAdd(&bar[XB_TMO], 1u); break; } }
    }
    nloc = mine > 0u ? mine : 1u; nx = cnt > 0u ? cnt : 1u;
}
__device__ __forceinline__ void xcd_barrier(const XcdBarrier& b) {
    asm volatile("s_waitcnt vmcnt(0)" ::: "memory");
    __syncthreads();
    if (threadIdx.x == 0) {
        unsigned* bar = b.bar;
        __builtin_amdgcn_s_waitcnt(0);
        unsigned nloc = b.st[0], nx = b.st[1];
        if (nloc == 0u) { xcd_barrier_complete(bar, b.x, nloc, nx); b.st[0] = nloc; b.st[1] = nx; }
        const unsigned old = xb_add(&bar[XB_XSUB(b.x)], 1u);
        const unsigned gen = old / nloc;
        if (old + 1u == (gen + 1u) * nloc) {
            __builtin_amdgcn_fence(__ATOMIC_RELEASE, "agent");
            asm volatile("s_waitcnt vmcnt(0)" ::: "memory");
            const unsigned og = xb_add(&bar[XB_TOP], 1u);
            const unsigned tg = og / nx;
            if (og + 1u == (tg + 1u) * nx) xb_add(&bar[XB_TOPGEN], 1u);
            else XB_SPIN(xb_ld(&bar[XB_TOPGEN]) == tg, bar);
            __builtin_amdgcn_fence(__ATOMIC_ACQUIRE, "agent");
            xb_add(&bar[XB_XGEN(b.x)], 1u);
            asm volatile("s_waitcnt vmcnt(0)" ::: "memory");
        } else {
            XB_SPIN(xb_ld(&bar[XB_XGEN(b.x)]) == gen, bar);
            __builtin_amdgcn_fence(__ATOMIC_ACQUIRE, "agent");
            asm volatile("s_waitcnt vmcnt(0)" ::: "memory");
        }
    }
    __syncthreads();
}

struct TJob { const float* src; bf16_t* dst; int src_ld, dst_ld, N, ktiles, ntiles, nbatch, split; size_t sbs, dbs; };
__device__ __forceinline__ TJob tjob(const Params& p, int j) {
    bf16_t* win = (bf16_t*)(p.ws + WS_WIN); bf16_t* w1 = (bf16_t*)(p.ws + WS_W1);
    TJob J;
    switch (j) {
    case 0:  J = TJob{p.w_in,        win,                 INW, 1024, 936, 16, 4, 1, 0, 0, 0}; break;
    case 1:  J = TJob{p.w_in + 936,  win + 1024 * 1024,   INW, 1024, 512, 16, 2, 1, 0, 0, 0}; break;
    case 2:  J = TJob{p.w_in + 1448, win + 1536 * 1024,   INW, 1024, 2048, 16, 8, 1, 0, 0, 0}; break;
    case 3:  J = TJob{p.w_uv, (bf16_t*)(p.ws + WS_WUV),   512, 128, 64, 2, 1, 8, 0, 64, 64 * 128}; break;
    case 4:  J = TJob{p.w_ba, (bf16_t*)(p.ws + WS_WA),    1024, 512, 1024, 8, 4, 1, 0, 0, 0}; break;
    case 5:  J = TJob{p.w_out, (bf16_t*)(p.ws + WS_WO),   1024, 1024, 1024, 16, 4, 1, 0, 0, 0}; break;
    case 6:  J = TJob{p.w_eg, w1,                         256, 1024, 256, 16, 1, 32, 1, 262144, 524288}; break;
    case 7:  J = TJob{p.w_eu, w1 + 128 * 1024,            256, 1024, 256, 16, 1, 32, 1, 262144, 524288}; break;
    default: J = TJob{p.w_ed, (bf16_t*)(p.ws + WS_W2),    1024, 256, 1024, 4, 4, 32, 0, 262144, 262144}; break;
    }
    return J;
}
constexpr int NTJOBS = 9;
__device__ __forceinline__ int tjob_tiles(int j) {
    constexpr int t[NTJOBS] = {64, 32, 128, 16, 32, 64, 512, 512, 512};
    return t[j];
}
constexpr int P0_TILES = 64 + 32 + 128 + 16 + 32 + 64 + 512 + 512 + 512;
constexpr int P0_WUK = 128, P0_WF = 512, P0_PAD = 88, P0_WR = 48, P0_NORM = MPAD / 4;
constexpr int P0_WITEMS = P0_WF + P0_WUK + P0_PAD + P0_WR + P0_NORM;
constexpr int T_LD = 257;

struct TItem { const float* src; bf16_t* dst; int src_ld, dst_ld, N, k0, n0, split; };
__device__ __forceinline__ bool p0_titem(const Params& p, int it, TItem& T) {
    if (it >= P0_TILES) return false;
    int r = it, j = 0;
#pragma unroll 1
    for (; j < NTJOBS - 1; ++j) { const int n = tjob_tiles(j); if (r < n) break; r -= n; }
    const TJob J = tjob(p, j);
    const int per = J.ktiles * J.ntiles, bi = r / per, rr = r % per, kt = rr / J.ntiles, nt = rr % J.ntiles;
    T.src = J.src + (size_t)bi * J.sbs; T.dst = J.dst + (size_t)bi * J.dbs; T.src_ld = J.src_ld; T.dst_ld = J.dst_ld; T.N = J.N; T.k0 = kt * 64; T.n0 = nt * 256; T.split = J.split;
    return true;
}
__device__ __forceinline__ void p0_tload(const TItem& T, f32x4 (&v)[8], int tid) {
#pragma unroll
    for (int i = 0; i < 8; ++i) {
        const int kk = (tid >> 6) + 8 * i, n4 = (tid & 63) * 4;
        v[i] = (f32x4){0.f, 0.f, 0.f, 0.f};
        if (T.n0 + n4 < T.N) v[i] = *(const f32x4*)(T.src + (size_t)(T.k0 + kk) * T.src_ld + T.n0 + n4);
    }
}

__device__ __forceinline__ void p0_phase(const Params& p, LAS char* lds) {
    const int tid = threadIdx.x, wid = __builtin_amdgcn_readfirstlane(tid >> 6), lane = tid & 63, fr = lane & 15, fq = lane >> 4;
    MEAS_T0(34)
    {
        LAS float* tile = (LAS float*)lds;
        TItem T, Tn; f32x4 v[8];
        int it = blockIdx.x;
        bool have = p0_titem(p, it, T);
        if (have) p0_tload(T, v, tid);
        while (have) {
#pragma unroll
            for (int i = 0; i < 8; ++i) {
                const int kk = (tid >> 6) + 8 * i, n4 = (tid & 63) * 4;
                tile[kk * T_LD + n4 + 0] = v[i][0]; tile[kk * T_LD + n4 + 1] = v[i][1]; tile[kk * T_LD + n4 + 2] = v[i][2]; tile[kk * T_LD + n4 + 3] = v[i][3];
            }
            it += gridDim.x;
            const bool hn = p0_titem(p, it, Tn);
            if (hn) p0_tload(Tn, v, tid);
            __syncthreads();
#pragma unroll
            for (int c = 0; c < 4; ++c) {
                const int idx = tid + 512 * c, n = idx >> 3, kc = idx & 7;
                if (T.n0 + n < T.N) {
                    const LAS float* sp = tile + (kc * 8) * T_LD + n;
                    u32x4 o; o.x = cvt_pk_bf16(sp[0], sp[T_LD]); o.y = cvt_pk_bf16(sp[2 * T_LD], sp[3 * T_LD]); o.z = cvt_pk_bf16(sp[4 * T_LD], sp[5 * T_LD]); o.w = cvt_pk_bf16(sp[6 * T_LD], sp[7 * T_LD]);
                    const int nn = T.n0 + n, drow = T.split ? ((nn & 127) + (nn >> 7) * 256) : nn;
                    *(u32x4*)(T.dst + (size_t)drow * T.dst_ld + T.k0 + kc * 8) = o;
                }
            }
            __syncthreads();
            T = Tn; have = hn;
        }
    }
    MEAS_T1(34, p.ws)
    MEAS_T0(35)
    for (int it = blockIdx.x * 8 + wid; it < P0_WITEMS; it += gridDim.x * 8) {
        int r = it;
        if (r < P0_WF) {
            const int kt = r >> 4, nq = r & 15, k0 = kt * 16, g = k0 >> 7, n0 = nq * 64;
            f32x4 acc[4];
#pragma unroll
            for (int i = 0; i < 4; ++i) acc[i] = (f32x4){0.f, 0.f, 0.f, 0.f};
            const float* wp = p.w_pool + (size_t)(k0 + fr) * 128 + fq; const float* ps = p.pool_scale + g * 128 + fq;
            const float* wb = p.w_bp + (size_t)(g * 128 + fq) * 1024 + n0 + fr;
#pragma unroll 8
            for (int st = 0; st < 32; ++st) {
                const float a = wp[4 * st] * ps[4 * st];
#pragma unroll
                for (int i = 0; i < 4; ++i) acc[i] = __builtin_amdgcn_mfma_f32_16x16x4f32(a, wb[(size_t)(4 * st) * 1024 + i * 16], acc[i], 0, 0, 0);
            }
            bf16_t* wf = (bf16_t*)(p.ws + WS_WF);
#pragma unroll
            for (int i = 0; i < 4; ++i) st4bf(wf + (size_t)(n0 + 16 * i + fr) * 512 + k0 + 4 * fq, acc[i]);
            continue;
        }
        r -= P0_WF;
        if (r < P0_WUK) {
            const int o = r * 512 + lane * 8, h = o >> 13, c = (o >> 6) & 127, d = o & 63;
            const float* sp = p.w_uk + c * 512 + h * 64 + d;
            const f32x4 a = *(const f32x4*)sp, b = *(const f32x4*)(sp + 4);
            u32x4 w; w.x = cvt_pk_bf16(a[0], a[1]); w.y = cvt_pk_bf16(a[2], a[3]); w.z = cvt_pk_bf16(b[0], b[1]); w.w = cvt_pk_bf16(b[2], b[3]);
            *(u32x4*)((bf16_t*)(p.ws + WS_WUK) + o) = w;
            continue;
        }
        r -= P0_WUK;
        if (r < P0_PAD) {
            bf16_t* win = (bf16_t*)(p.ws + WS_WIN) + (size_t)(936 + r) * 1024;
            const u32x4 z = {0u, 0u, 0u, 0u};
            *(u32x4*)(win + lane * 8) = z; *(u32x4*)(win + 512 + lane * 8) = z;
            continue;
        }
        r -= P0_PAD;
        if (r < P0_WR) {
            bf16_t* wh = (bf16_t*)(p.ws + WS_WRH) + (size_t)r * 1024; bf16_t* wl = (bf16_t*)(p.ws + WS_WRL) + (size_t)r * 1024;
#pragma unroll 16
            for (int i = 0; i < 16; ++i) {
                const int k = lane + 64 * i;
                const float w = r < 4 ? p.w_gr[(size_t)k * 4 + r] : (r < 36 ? p.w_er[(size_t)k * 32 + (r - 4)] : 0.f);
                const unsigned h = cvt_pk_bf16(w, 0.f) & 0xffffu;
                wh[k] = (bf16_t)h; wl[k] = (bf16_t)(cvt_pk_bf16(w - bf_lo(h), 0.f) & 0xffffu);
            }
            continue;
        }
        r -= P0_WR;
        {
            const int R0 = r * 4;
            f32x4 v[4][4];
#pragma unroll
            for (int q = 0; q < 4; ++q) {
                const int R = R0 + q;
                if (R < MALL) {
                    const int b = R / TT, t = R - b * TT;
                    const float* src = (t < 16) ? (p.meta + (size_t)t * 1024) : (p.x + ((size_t)b * SEQ + (t - 16)) * 1024);
#pragma unroll
                    for (int j = 0; j < 4; ++j) v[q][j] = *(const f32x4*)(src + j * 256 + lane * 4);
                } else {
#pragma unroll
                    for (int j = 0; j < 4; ++j) v[q][j] = (f32x4){0.f, 0.f, 0.f, 0.f};
                }
            }
            f32x4 g[4];
#pragma unroll
            for (int j = 0; j < 4; ++j) g[j] = *(const f32x4*)(p.norm1_g + j * 256 + lane * 4);
#pragma unroll
            for (int q = 0; q < 4; ++q) {
                float ss = 0.f;
#pragma unroll
                for (int j = 0; j < 4; ++j) ss += v[q][j][0] * v[q][j][0] + v[q][j][1] * v[q][j][1] + v[q][j][2] * v[q][j][2] + v[q][j][3] * v[q][j][3];
                ss = wave_sum(ss);
                const float rstd = rsqrtf(ss * (1.f / 1024.f) + EPS);
                bf16_t* urow = (bf16_t*)(p.ws + WS_U) + (size_t)(R0 + q) * 1024;
#pragma unroll
                for (int j = 0; j < 4; ++j) st4bf(urow + j * 256 + lane * 4, v[q][j] * rstd * g[j]);
            }
        }
    }
    MEAS_T1(35, p.ws)
    __syncthreads();
}

namespace g8 {
constexpr int BM = 256, BK = 64, HALF = 128, HTB = HALF * BK * 2, STAGE_BYTES = 8 * HTB, NXCD = 8, WGM = 8;
__device__ __forceinline__ int lds_byte(int r, int c) { const int st = (r >> 4) * 2 + (c >> 5), rr = r & 15, cc = c & 31, ob = rr * 64 + cc * 2; return st * 1024 + (ob ^ (((ob >> 9) & 1) << 5)); }
__device__ __forceinline__ void stage_rc(int b, int& R, int& C) { const int st = b / 1024, sb = b % 1024, swz = sb ^ (((sb >> 9) & 1) << 5); R = (st >> 1) * 16 + swz / 64; C = (st & 1) * 32 + (swz % 64) / 2; }

struct Unit { const char* A; const char* B; int i0, i1, i2, i3; unsigned va[2][2]; };

struct TileOrder {
    int nM, nN, nwg, G, c;
    __device__ __forceinline__ void init(int nM_, int nN_, int G_, int c_) { nM = nM_; nN = nN_; nwg = nM * nN; G = G_; c = c_; }
    __device__ __forceinline__ bool tile(int i, int& pm, int& pn) const {
        const long L = (long)i * G + c; if (L >= nwg) return false;
        int wgid = (int)L; { const int q = nwg / NXCD, r = nwg % NXCD, xcd = wgid % NXCD, off = wgid / NXCD; wgid = (xcd < r ? xcd * (q + 1) : r * (q + 1) + (xcd - r) * q) + off; }
        const int nig = WGM * nN, gid = wgid / nig, fm = gid * WGM, gsz = (nM - fm) < WGM ? (nM - fm) : WGM;
        pm = fm + ((wgid % nig) % gsz); pn = (wgid % nig) / gsz; return true;
    }
};

template <class Epi, class Sched, bool GATHER, bool PERM = false>
__device__ __forceinline__ void gemm_phase(LAS char* lds, const int K, const Sched& S, const Epi& E) {
    const int tid = threadIdx.x, wid = __builtin_amdgcn_readfirstlane(tid >> 6), lane = tid & 63, wr = wid >> 2, wc = wid & 3, fr = lane & 15, fq = lane >> 4;
    const int nt = K / BK;
    unsigned voff[2], voffb[2];
#pragma unroll
    for (int i = 0; i < 2; ++i) { int R_, C_; stage_rc(tid * 16 + i * 8192, R_, C_); voff[i] = (unsigned)(R_ * K + C_) * 2u;
        const int rho = R_ & 31, Rb = PERM ? ((R_ & ~31) + 8 * ((rho & 15) >> 2) + 4 * (rho >> 4) + (rho & 3)) : R_; voffb[i] = (unsigned)(Rb * K + C_) * 2u; }
    const size_t kstep = (size_t)(BK * 2);
    const size_t hstep = (size_t)HALF * K * 2;
    const unsigned ldsw = (unsigned)wid * 1024u;
    const int aoff = lds_byte(wr * 64 + fr, fq * 8), boff = lds_byte(wc * 32 + fr, fq * 8);
#define G8_SA(b, h) (((b) * 2 + (h)) * HTB)
#define G8_SB(b, h) ((4 + (b) * 2 + (h)) * HTB)
#define G8_GLDS(bufoff, ptr, i_) __builtin_amdgcn_global_load_lds((const unsigned*)(ptr), (LAS unsigned*)(lds + (bufoff) + ldsw + (i_) * 8192), 16, 0, 0)
#define G8_STAGE_B(bufoff, gbase) do { _Pragma("unroll") for (int _i = 0; _i < 2; ++_i) G8_GLDS(bufoff, (const char*)(gbase) + voffb[_i], _i); } while (0)
#define G8_STAGE_A(bufoff, abase, vA, h) do { _Pragma("unroll") for (int _i = 0; _i < 2; ++_i) \
        G8_GLDS(bufoff, GATHER ? ((const char*)(abase) + (vA)[h][_i]) : ((const char*)(abase) + (size_t)(h) * hstep + voff[_i]), _i); } while (0)
#define G8_LDA(dst, b, h) do { _Pragma("unroll") for (int m = 0; m < 4; ++m) _Pragma("unroll") for (int k = 0; k < 2; ++k) dst[m][k] = *(const LAS bf16x8*)(lds + G8_SA(b, h) + aoff + m * 2048 + k * 1024); } while (0)
#define G8_LDB(dst, b, h) do { _Pragma("unroll") for (int n = 0; n < 2; ++n) _Pragma("unroll") for (int k = 0; k < 2; ++k) dst[n][k] = *(const LAS bf16x8*)(lds + G8_SB(b, h) + boff + n * 2048 + k * 1024); } while (0)
#define G8_MMA(ai, bj, At, Bt) do { __builtin_amdgcn_s_setprio(1); _Pragma("unroll") for (int m = 0; m < 4; ++m) _Pragma("unroll") for (int n = 0; n < 2; ++n) _Pragma("unroll") for (int k = 0; k < 2; ++k) \
        acc[ai][bj][m][n] = __builtin_amdgcn_mfma_f32_16x16x32_bf16(Bt[n][k], At[m][k], acc[ai][bj][m][n], 0, 0, 0); __builtin_amdgcn_s_setprio(0); } while (0)
#define G8_WAIT_V(n) asm volatile("s_waitcnt vmcnt(" #n ")" ::: "memory")
#define G8_WAIT_L(n) asm volatile("s_waitcnt lgkmcnt(" #n ")" ::: "memory")
#define G8_BAR __builtin_amdgcn_s_barrier()
#define G8_SCHED __builtin_amdgcn_sched_barrier(0)
    Unit cur, nxt; int ui = 0;
    cur.A = nullptr; cur.B = nullptr; cur.i0 = cur.i1 = cur.i2 = cur.i3 = 0; cur.va[0][0] = cur.va[0][1] = cur.va[1][0] = cur.va[1][1] = 0u; nxt = cur;
    if (!S.next(0, cur, tid)) return;
    S.a_ready(cur);
    f32x4 acc[2][2][4][2];
#pragma unroll
    for (int a = 0; a < 2; ++a)
#pragma unroll
        for (int b = 0; b < 2; ++b)
#pragma unroll
            for (int m = 0; m < 4; ++m)
#pragma unroll
                for (int n = 0; n < 2; ++n) acc[a][b][m][n] = (f32x4){0.f, 0.f, 0.f, 0.f};
    bf16x8 At[4][2], B0[2][2], B1[2][2];
    G8_STAGE_B(G8_SB(0, 0), cur.B); G8_STAGE_B(G8_SB(0, 1), cur.B + hstep); G8_STAGE_A(G8_SA(0, 0), cur.A, cur.va, 0); G8_STAGE_A(G8_SA(0, 1), cur.A, cur.va, 1);
    if (wr == 1) G8_BAR;
    G8_WAIT_V(2); G8_BAR;
    G8_STAGE_B(G8_SB(1, 0), cur.B + kstep); G8_STAGE_A(G8_SA(1, 0), cur.A + kstep, cur.va, 0); G8_STAGE_B(G8_SB(1, 1), cur.B + hstep + kstep);
    G8_WAIT_V(6); G8_BAR;
    for (;;) {
        const bool has_next = S.next(ui + 1, nxt, tid);
        if (!has_next) nxt = cur;
#pragma unroll 1
        for (int t = 0; t < nt; t += 2) {
            const bool last = (t == nt - 2);
            if (last && has_next) S.a_ready(nxt);
            const char* a1 = cur.A + (size_t)(t + 1) * kstep;
            const char* a2 = last ? nxt.A : cur.A + (size_t)(t + 2) * kstep; const char* b2 = last ? nxt.B : cur.B + (size_t)(t + 2) * kstep;
            const char* a3 = a2 + kstep; const char* b3 = b2 + kstep;
            G8_LDB(B0, 0, 0); G8_LDB(B1, 0, 1); G8_SCHED; G8_LDA(At, 0, 0); G8_STAGE_A(G8_SA(1, 1), a1, cur.va, 1);
            if (GATHER && last) {
#pragma unroll
                for (int h = 0; h < 2; ++h)
#pragma unroll
                    for (int i = 0; i < 2; ++i) cur.va[h][i] = nxt.va[h][i];
            }
            G8_WAIT_V(8); G8_WAIT_L(0); G8_BAR; G8_MMA(0, 0, At, B0); G8_MMA(0, 1, At, B1); G8_BAR; G8_SCHED;
            G8_LDA(At, 0, 1); G8_STAGE_B(G8_SB(0, 0), b2); G8_STAGE_B(G8_SB(0, 1), b2 + hstep); G8_STAGE_A(G8_SA(0, 0), a2, cur.va, 0);
            G8_WAIT_V(8); G8_WAIT_L(0); G8_BAR; G8_MMA(1, 0, At, B0); G8_MMA(1, 1, At, B1); G8_BAR; G8_SCHED;
            G8_LDB(B0, 1, 0); G8_LDB(B1, 1, 1); G8_SCHED; G8_LDA(At, 1, 0); G8_STAGE_A(G8_SA(0, 1), a2, cur.va, 1);
            G8_WAIT_V(8); G8_WAIT_L(0); G8_BAR; G8_MMA(0, 0, At, B0); G8_MMA(0, 1, At, B1); G8_BAR; G8_SCHED;
            G8_LDA(At, 1, 1); G8_STAGE_B(G8_SB(1, 0), b3); G8_STAGE_B(G8_SB(1, 1), b3 + hstep); G8_STAGE_A(G8_SA(1, 0), a3, cur.va, 0);
            G8_WAIT_V(8); G8_WAIT_L(0); G8_BAR; G8_MMA(1, 0, At, B0); G8_MMA(1, 1, At, B1); G8_BAR; G8_SCHED;
        }
        if (wr == 0) G8_BAR;
        bool keep = false;
        { int efr = fr, efq = fq; asm volatile("" : "+v"(efr), "+v"(efq));
          keep = E(acc, cur, wr, wc, efr, efq, lds + STAGE_BYTES); }
        if (!has_next) break;
        if (!keep) {
#pragma unroll
        for (int a = 0; a < 2; ++a)
#pragma unroll
            for (int b = 0; b < 2; ++b)
#pragma unroll
                for (int m = 0; m < 4; ++m)
#pragma unroll
                    for (int n = 0; n < 2; ++n) acc[a][b][m][n] = (f32x4){0.f, 0.f, 0.f, 0.f};
        }
        cur = nxt; ++ui;
        if (wr == 1) G8_BAR;
    }
    G8_WAIT_V(0);
    G8_BAR;
#undef G8_SA
#undef G8_SB
#undef G8_GLDS
#undef G8_STAGE_A
#undef G8_STAGE_B
#undef G8_LDA
#undef G8_LDB
#undef G8_MMA
#undef G8_WAIT_V
#undef G8_WAIT_L
#undef G8_BAR
#undef G8_SCHED
}
}
constexpr int GX_OFF = g8::STAGE_BYTES;

#define FOR_ACC(ai, bj, m, n) \
    _Pragma("unroll") for (int ai = 0; ai < 2; ++ai) _Pragma("unroll") for (int bj = 0; bj < 2; ++bj) \
    _Pragma("unroll") for (int m = 0; m < 4; ++m) _Pragma("unroll") for (int n = 0; n < 2; ++n)
__device__ __forceinline__ int vcu_id() { const int G = gridDim.x, bx = blockIdx.x; return (G % 8 == 0) ? (bx % 8) * (G / 8) + bx / 8 : bx; }

struct P1Sched {
    __device__ __forceinline__ void a_ready(const g8::Unit&) const {}
    g8::TileOrder T; const char* U; const char* W;
    __device__ __forceinline__ bool next(int i, g8::Unit& u, int) const {
        int pm, pn; if (!T.tile(i, pm, pn)) return false;
        u.A = U + (size_t)pm * 256 * 1024 * 2; u.B = W + (size_t)pn * 256 * 1024 * 2; u.i0 = pm; u.i1 = pn; return true;
    }
};
struct P1Epi {
    const Params* pp;
    __device__ __forceinline__ bool operator()(f32x4 (&acc)[2][2][4][2], const g8::Unit& u, int wr, int wc, int fr, int fq, LAS char* xl) const {
        const Params& p = *pp;
        bf16_t* Q = (bf16_t*)(p.ws + WS_Q); bf16_t* C = (bf16_t*)(p.ws + WS_C); bf16_t* IQ = (bf16_t*)(p.ws + WS_IQ); bf16_t* IK = (bf16_t*)(p.ws + WS_IK);
        float* IW = (float*)(p.ws + WS_IW); bf16_t* PV = (bf16_t*)(p.ws + WS_PV); bf16_t* GT = (bf16_t*)(p.ws + WS_GATES);
        const int pm = u.i0, pn = u.i1;
        const int rowb = pm * 256 + wr * 64 + fr, colb = wc * 32 + 4 * fq;
        if (pn < 2) {
            FOR_ACC(ai, bj, m, n) st4bf(Q + (size_t)(rowb + ai * 128 + m * 16) * 512 + pn * 256 + bj * 128 + colb + n * 16, acc[ai][bj][m][n]);
        } else if (pn == 2) {
            LAS float* part = (LAS float*)xl;
#pragma unroll
            for (int ai = 0; ai < 2; ++ai)
#pragma unroll
                for (int m = 0; m < 4; ++m) {
                    float s = 0.f;
#pragma unroll
                    for (int n = 0; n < 2; ++n) { const f32x4 v = acc[ai][0][m][n]; s += v[0] * v[0] + v[1] * v[1] + v[2] * v[2] + v[3] * v[3]; }
                    s += __shfl_xor(s, 16); s += __shfl_xor(s, 32);
                    if (fq == 0) part[(ai * 128 + wr * 64 + m * 16 + fr) * 4 + wc] = s;
                }
            __syncthreads();
#pragma unroll
            for (int ai = 0; ai < 2; ++ai)
#pragma unroll
                for (int m = 0; m < 4; ++m) {
                    const int lr = ai * 128 + wr * 64 + m * 16 + fr;
                    const f32x4 ps = *(LAS f32x4*)(part + lr * 4);
                    const float rstd = rsqrtf((ps[0] + ps[1] + ps[2] + ps[3]) * (1.f / 128.f) + EPS);
                    const size_t R = (size_t)(rowb + ai * 128 + m * 16);
#pragma unroll
                    for (int n = 0; n < 2; ++n) {
                        const f32x4 g = *(const f32x4*)(p.kv_norm_g + colb + n * 16);
                        st4bf(C + R * 128 + colb + n * 16, acc[ai][0][m][n] * rstd * g);
                        st4bf(IQ + R * 256 + colb + n * 16, acc[ai][1][m][n]);
                    }
                }
            __syncthreads();
        } else if (pn == 3) {
#pragma unroll
            for (int ai = 0; ai < 2; ++ai)
#pragma unroll
                for (int m = 0; m < 4; ++m) {
                    const size_t R = (size_t)(rowb + ai * 128 + m * 16);
#pragma unroll
                    for (int n = 0; n < 2; ++n) {
                        st4bf(IQ + R * 256 + 128 + colb + n * 16, acc[ai][0][m][n]);
                        if (wc == 0) st4bf(IK + R * 32 + n * 16 + 4 * fq, acc[ai][1][m][n]);
                        if (wc == 1 && n == 0 && fq < 2) *(f32x4*)(IW + R * 8 + 4 * fq) = acc[ai][1][m][n] * IDX_SCALE;
                    }
                }
        } else if (pn < 6) {
            FOR_ACC(ai, bj, m, n) st4bf(PV + (size_t)(rowb + ai * 128 + m * 16) * 512 + (pn - 4) * 256 + bj * 128 + colb + n * 16, acc[ai][bj][m][n]);
        } else {
            FOR_ACC(ai, bj, m, n) {
                f32x4 v = acc[ai][bj][m][n];
#pragma unroll
                for (int r = 0; r < 4; ++r) v[r] = __builtin_amdgcn_rcpf(1.f + __expf(-v[r]));
                st4bf(GT + (size_t)(rowb + ai * 128 + m * 16) * 2048 + (pn - 6) * 256 + bj * 128 + colb + n * 16, v);
            }
        }
            return false;
    }
};
__device__ __forceinline__ void p1_phase(const Params& p, LAS char* lds) {
    P1Sched S; S.T.init(MPAD / 256, INP / 256, gridDim.x, blockIdx.x); S.U = (const char*)(p.ws + WS_U); S.W = (const char*)(p.ws + WS_WIN);
    P1Epi E{&p};
    g8::gemm_phase<P1Epi, P1Sched, false>(lds, 1024, S, E);
}
constexpr int SC_STRIDE = 2068;
constexpr int SC_BYTES = 16 * SC_STRIDE * 4;
constexpr int MASK_OFF = SC_BYTES;
constexpr int QS_STRIDE = 136;
constexpr float DEFER_THR = 6.0f;

__device__ __forceinline__ int kv_off(int row, int ch) { return 256 * row + 16 * (ch ^ (((row & 3) << 2) | ((row >> 2) & 3))); }
__device__ __forceinline__ unsigned f2ord(float f) { const unsigned u = __float_as_uint(f); return (u & 0x80000000u) ? ~u : (u | 0x80000000u); }
__device__ __forceinline__ int wave_sum_dpp(int v) {
    v += __builtin_amdgcn_update_dpp(0, v, 0x111, 0xf, 0xf, false);
    v += __builtin_amdgcn_update_dpp(0, v, 0x112, 0xf, 0xf, false);
    v += __builtin_amdgcn_update_dpp(0, v, 0x114, 0xf, 0xf, false);
    v += __builtin_amdgcn_update_dpp(0, v, 0x118, 0xf, 0xf, false);
    v += __builtin_amdgcn_update_dpp(0, v, 0x142, 0xa, 0xf, false);
    v += __builtin_amdgcn_update_dpp(0, v, 0x143, 0xc, 0xf, false);
    return __builtin_amdgcn_readlane(v, 63);
}

__device__ __forceinline__ void attn_item(const Params& p, int b, int j, int half, LAS char* lds) {
    int tid_ = threadIdx.x; asm volatile("" : "+v"(tid_));
    const int tid = tid_, wid = __builtin_amdgcn_readfirstlane(tid >> 6), lane = tid & 63, fr = lane & 15, fq = lane >> 4;
    const int nadm = 16 + 64 * j;
    const int t0 = 16 + 64 * (j - 1) + 32 * half;
    const size_t Rq0 = (size_t)b * TT + t0, Rk0 = (size_t)b * TT;
    const bf16_t* Q = (const bf16_t*)(p.ws + WS_Q); const bf16_t* C = (const bf16_t*)(p.ws + WS_C); const bf16_t* IQ = (const bf16_t*)(p.ws + WS_IQ);
    const bf16_t* IK = (const bf16_t*)(p.ws + WS_IK); const float* IW = (const float*)(p.ws + WS_IW);
    LAS unsigned* maskw = (LAS unsigned*)(lds + MASK_OFF);
    const int h = wid;

    MEAS_T0(21)
    {
        const bf16_t* Wuk = (const bf16_t*)(p.ws + WS_WUK) + (size_t)h * 128 * 64;
        bf16x8 bq[2][2];
#pragma unroll
        for (int qt = 0; qt < 2; ++qt)
#pragma unroll
            for (int ks = 0; ks < 2; ++ks) bq[qt][ks] = *(const bf16x8*)(Q + (Rq0 + qt * 16 + fr) * 512 + h * 64 + ks * 32 + fq * 8);
        LAS bf16_t* qs = (LAS bf16_t*)lds + (size_t)h * 32 * QS_STRIDE;
#pragma unroll
        for (int ct = 0; ct < 8; ++ct) {
            const bf16x8 a0 = *(const bf16x8*)(Wuk + (ct * 16 + fr) * 64 + fq * 8), a1 = *(const bf16x8*)(Wuk + (ct * 16 + fr) * 64 + 32 + fq * 8);
#pragma unroll
            for (int qt = 0; qt < 2; ++qt) {
                f32x4 d = {0.f, 0.f, 0.f, 0.f};
                d = mfma16(a0, bq[qt][0], d); d = mfma16(a1, bq[qt][1], d);
                d = d * (ATTN_SCALE * LOG2E);
                u32x2 o; o.x = cvt_pk_bf16(d[0], d[1]); o.y = cvt_pk_bf16(d[2], d[3]);
                *(LAS u32x2*)(qs + (qt * 16 + fr) * QS_STRIDE + ct * 16 + 4 * fq) = o;
            }
        }
    }
    __syncthreads();
    bf16x8 qf[8];
    {
        const LAS bf16_t* qs = (const LAS bf16_t*)lds + (size_t)h * 32 * QS_STRIDE + (lane & 31) * QS_STRIDE + (lane >> 5) * 8;
#pragma unroll
        for (int ks = 0; ks < 8; ++ks) qf[ks] = *(const LAS bf16x8*)(qs + ks * 16);
    }
    __syncthreads();

    MEAS_T1(21, p.ws)
    MEAS_T0(22)
    if (nadm <= 256) {
        for (int idx = tid; idx < 32 * 66; idx += 512) {
            const int w = idx % 66; const int lo = w * 32;
            unsigned v = 0u;
            if (lo + 32 <= nadm) v = 0xffffffffu; else if (lo < nadm) v = (1u << (nadm - lo)) - 1u;
            maskw[idx] = v;
        }
    } else {
        LAS float* sc = (LAS float*)lds;
        const int nkt = nadm >> 4;
        const int ni = (nadm + 63) >> 6;
#pragma unroll 1
        for (int sub = 0; sub < 2; ++sub) {
            MEAS_T0(25)
            {
                bf16x8 bq[8]; float wq[8];
                const size_t Rq = Rq0 + sub * 16 + fr;
#pragma unroll
                for (int hh = 0; hh < 8; ++hh) { bq[hh] = *(const bf16x8*)(IQ + Rq * 256 + hh * 32 + fq * 8); }
                { const f32x4 w0 = *(const f32x4*)(IW + Rq * 8), w1 = *(const f32x4*)(IW + Rq * 8 + 4);
                  wq[0] = w0[0]; wq[1] = w0[1]; wq[2] = w0[2]; wq[3] = w0[3]; wq[4] = w1[0]; wq[5] = w1[1]; wq[6] = w1[2]; wq[7] = w1[3]; }
                const bf16_t* ikp = IK + (Rk0 + fr) * 32 + fq * 8;
#pragma unroll 1
                for (int kb = wid; kb < nkt; kb += 64) {
                    bf16x8 a[8];
#pragma unroll
                    for (int i = 0; i < 8; ++i) { const int kt = kb + 8 * i; a[i] = *(const bf16x8*)(ikp + (size_t)(kt < nkt ? kt : kb) * 16 * 32); }
#pragma unroll
                    for (int i = 0; i < 8; ++i) {
                        const int kt = kb + 8 * i;
                        if (kt < nkt) {
                            f32x4 s = {0.f, 0.f, 0.f, 0.f};
#pragma unroll
                            for (int hh = 0; hh < 8; ++hh) {
                                f32x4 d = {0.f, 0.f, 0.f, 0.f};
                                d = mfma16(a[i], bq[hh], d);
#pragma unroll
                                for (int r = 0; r < 4; ++r) { const int di = __float_as_int(d[r]); s[r] += __int_as_float(di > 0 ? di : 0) * wq[hh]; }
                            }
                            *(LAS f32x4*)(sc + fr * SC_STRIDE + kt * 16 + 4 * fq) = s;
                        }
                    }
                }
            }
            __syncthreads();
            MEAS_T1(25, p.ws)
            MEAS_T0(26)
#pragma unroll 1
            for (int qq = 0; qq < 2; ++qq) {
                const int ql = 2 * wid + qq;
                unsigned key[33];
                int nadm_q = nadm; asm volatile("" : "+s"(nadm_q));
#pragma unroll
                for (int i = 0; i < 33; ++i) { const int k = lane + 64 * i; const unsigned o = f2ord(sc[ql * SC_STRIDE + k]); key[i] = (k < nadm_q) ? o : 0u; }
                unsigned prefix = 0u; bool exact = false;
#pragma unroll 1
                for (int bit = 31; bit >= 0; --bit) {
                    const unsigned cand = prefix | (1u << bit);
                    int c = 0;
#pragma unroll
                    for (int g = 0; g < 33; g += 8)
                        if (g < ni) {
#pragma unroll
                            for (int i = g; i < g + 8 && i < 33; ++i) c += (key[i] >= cand) ? 1 : 0;
                        }
                    c = wave_sum_dpp(c);
                    if (c >= 256) prefix = cand;
                    if (c == 256) { exact = true; break; }
                }
                int need = 0;
                if (!exact) {
                    int cg = 0;
#pragma unroll
                    for (int i = 0; i < 33; ++i) cg += (key[i] > prefix) ? 1 : 0;
                    need = 256 - wave_sum_dpp(cg);
                }
                int running = 0;
                const unsigned long long lt = (1ull << lane) - 1ull;
#pragma unroll
                for (int i = 0; i < 33; ++i) {
                    bool sel;
                    if (exact) sel = key[i] >= prefix;
                    else {
                        const bool eq = key[i] == prefix;
                        const unsigned long long be = __ballot(eq);
                        const int rank = running + __popcll(be & lt);
                        sel = (key[i] > prefix) || (eq && rank < need);
                        running += __popcll(be);
                    }
                    const unsigned long long bs = __ballot(sel);
                    if (lane == 0) { maskw[(sub * 16 + ql) * 66 + 2 * i] = (unsigned)bs; maskw[(sub * 16 + ql) * 66 + 2 * i + 1] = (unsigned)(bs >> 32); }
                    __builtin_amdgcn_sched_barrier(0);
                }
            }
            MEAS_T1(26, p.ws)
            __syncthreads();
        }
    }
    __syncthreads();

    MEAS_T1(22, p.ws)
    MEAS_T0(23)
    const int ntile = (nadm + 63) >> 6;
    f32x16 O[4];
#pragma unroll
    for (int mt = 0; mt < 4; ++mt)
#pragma unroll
        for (int r = 0; r < 16; ++r) O[mt][r] = 0.f;
    float mrun = 0.f, lrun = 0.f;
    {
        const bf16_t* kvsrc = C + (Rk0 + (tid >> 4)) * 128 + (tid & 15) * 8;
        const int kvdst0 = kv_off(tid >> 4, tid & 15), kvdst1 = kv_off((tid >> 4) + 32, tid & 15);
        u32x4 rr0 = *(const u32x4*)kvsrc, rr1 = *(const u32x4*)(kvsrc + 32 * 128);
        *(LAS u32x4*)(lds + kvdst0) = rr0; *(LAS u32x4*)(lds + kvdst1) = rr1;
        __syncthreads();
        const int hq = lane >> 5, ql = lane & 31;
        const int tg = lane >> 4, ti = lane & 15, tq = ti >> 2, tp = ti & 3;
#pragma unroll 1
        for (int T = 0; T < ntile; ++T) {
            const bool more = T + 1 < ntile;
            if (more) { rr0 = *(const u32x4*)(kvsrc + (size_t)(T + 1) * 64 * 128); rr1 = *(const u32x4*)(kvsrc + (size_t)(T + 1) * 64 * 128 + 32 * 128); }
            LAS char* kb = lds + (T & 1) * 16384;
            const u32x2 mw2 = *(LAS u32x2*)(maskw + ql * 66 + 2 * T);
            const float nm = -mrun;
            f32x16 S[2];
#pragma unroll
            for (int kh = 0; kh < 2; ++kh) {
                const int mw = (int)((kh ? mw2.y : mw2.x) >> (4 * hq));
#pragma unroll
                for (int r = 0; r < 16; ++r) {
                    const unsigned m = (unsigned)__builtin_amdgcn_sbfe(mw, (r & 3) + 8 * (r >> 2), 1);
                    S[kh][r] = __uint_as_float((__float_as_uint(nm) & m) | (0xf149f2cau & ~m));
                }
#pragma unroll
                for (int ks = 0; ks < 8; ++ks) {
                    const bf16x8 a = *(LAS bf16x8*)(kb + kv_off(32 * kh + ql, 2 * ks + hq));
                    S[kh] = mfma32(a, qf[ks], S[kh]);
                }
            }
            float mx = -3e38f;
#pragma unroll
            for (int kh = 0; kh < 2; ++kh)
#pragma unroll
                for (int r = 0; r < 16; r += 2) mx = fmaxf(fmaxf(mx, S[kh][r]), S[kh][r + 1]);
            mx = fmaxf(mx, __shfl_xor(mx, 32));
            if (__any(mx > DEFER_THR)) {
                const float dm = fmaxf(mx, 0.f);
                const float alpha = __builtin_amdgcn_exp2f(-dm);
                lrun *= alpha; mrun += dm;
#pragma unroll
                for (int mt = 0; mt < 4; ++mt)
#pragma unroll
                    for (int r = 0; r < 16; ++r) O[mt][r] *= alpha;
#pragma unroll
                for (int kh = 0; kh < 2; ++kh)
#pragma unroll
                    for (int r = 0; r < 16; ++r) S[kh][r] -= dm;
            }
            float rs0 = 0.f, rs1 = 0.f;
#pragma unroll
            for (int kh = 0; kh < 2; ++kh)
#pragma unroll
                for (int r = 0; r < 16; r += 2) { S[kh][r] = __builtin_amdgcn_exp2f(S[kh][r]); S[kh][r + 1] = __builtin_amdgcn_exp2f(S[kh][r + 1]); rs0 += S[kh][r]; rs1 += S[kh][r + 1]; }
            float rs = rs0 + rs1;
            rs += __shfl_xor(rs, 32);
            lrun += rs;
            bf16x8 pf[4];
#pragma unroll
            for (int s2 = 0; s2 < 4; ++s2) {
                const int kh = s2 >> 1, o = 8 * (s2 & 1);
                u32x4 w;
                w.x = cvt_pk_bf16(S[kh][o + 0], S[kh][o + 1]); w.y = cvt_pk_bf16(S[kh][o + 2], S[kh][o + 3]);
                w.z = cvt_pk_bf16(S[kh][o + 4], S[kh][o + 5]); w.w = cvt_pk_bf16(S[kh][o + 6], S[kh][o + 7]);
                pf[s2] = __builtin_bit_cast(bf16x8, w);
            }
#pragma unroll
            for (int mt = 0; mt < 4; ++mt)
#pragma unroll
                for (int s2 = 0; s2 < 4; ++s2) {
                    const int colb = 32 * mt + 16 * (tg & 1) + 4 * tp;
                    const int row1 = 16 * s2 + 4 * (tg >> 1) + tq;
                    const s16x4 v0 = __builtin_amdgcn_ds_read_tr16_b64_v4i16((LAS s16x4*)(kb + kv_off(row1, colb >> 3) + (colb & 7) * 2));
                    const s16x4 v1 = __builtin_amdgcn_ds_read_tr16_b64_v4i16((LAS s16x4*)(kb + kv_off(row1 + 8, colb >> 3) + (colb & 7) * 2));
                    bf16x8 a; a[0] = v0[0]; a[1] = v0[1]; a[2] = v0[2]; a[3] = v0[3]; a[4] = v1[0]; a[5] = v1[1]; a[6] = v1[2]; a[7] = v1[3];
                    O[mt] = mfma32(a, pf[s2], O[mt]);
                }
            if (more) { LAS char* nb = lds + ((T + 1) & 1) * 16384; *(LAS u32x4*)(nb + kvdst0) = rr0; *(LAS u32x4*)(nb + kvdst1) = rr1; }
            __syncthreads();
        }
    }
    MEAS_T1(23, p.ws)
    MEAS_T0(24)
    {
        const float inv = 1.f / lrun;
        const int hq = lane >> 5, ql = lane & 31;
        LAS bf16_t* os = (LAS bf16_t*)(lds + 32768) + (size_t)h * 32 * QS_STRIDE;
#pragma unroll
        for (int mt = 0; mt < 4; ++mt)
#pragma unroll
            for (int rg = 0; rg < 4; ++rg) {
                u32x2 o; o.x = cvt_pk_bf16(O[mt][4 * rg] * inv, O[mt][4 * rg + 1] * inv); o.y = cvt_pk_bf16(O[mt][4 * rg + 2] * inv, O[mt][4 * rg + 3] * inv);
                *(LAS u32x2*)(os + ql * QS_STRIDE + 32 * mt + 8 * rg + 4 * hq) = o;
            }
        __syncthreads();
        const bf16_t* Wuv = (const bf16_t*)(p.ws + WS_WUV) + (size_t)h * 64 * 128;
        bf16_t* AT = (bf16_t*)(p.ws + WS_ATTN);
        const size_t n0 = (size_t)b * SEQ + (t0 - 16);
        bf16x8 bo[2][4];
#pragma unroll
        for (int qt = 0; qt < 2; ++qt)
#pragma unroll
            for (int ks = 0; ks < 4; ++ks) bo[qt][ks] = *(LAS bf16x8*)(os + (qt * 16 + fr) * QS_STRIDE + ks * 32 + fq * 8);
#pragma unroll
        for (int dt = 0; dt < 4; ++dt) {
            bf16x8 a[4];
#pragma unroll
            for (int ks = 0; ks < 4; ++ks) a[ks] = *(const bf16x8*)(Wuv + (dt * 16 + fr) * 128 + ks * 32 + fq * 8);
#pragma unroll
            for (int qt = 0; qt < 2; ++qt) {
                f32x4 d = {0.f, 0.f, 0.f, 0.f};
#pragma unroll
                for (int ks = 0; ks < 4; ++ks) d = mfma16(a[ks], bo[qt][ks], d);
                st4bf(AT + (n0 + qt * 16 + fr) * 512 + h * 64 + dt * 16 + 4 * fq, d);
            }
        }
    }
    __syncthreads();
    MEAS_T1(24, p.ws)
}

__device__ __forceinline__ void p2_phase(const Params& p, LAS char* lds) {
    const int tid = threadIdx.x;
    {
        const bf16_t* PV = (const bf16_t*)(p.ws + WS_PV); bf16_t* DD = (bf16_t*)(p.ws + WS_DD);
        for (int rc = blockIdx.x; rc < NTOK / 64; rc += gridDim.x) {
            const int n0 = rc * 64, b = n0 >> 11, s0 = n0 & 2047;
            const size_t R0 = (size_t)b * TT + 16 + s0 - 15;
            for (int idx = tid; idx < 79 * 64; idx += 512) *(LAS u32x4*)(lds + idx * 16) = *(const u32x4*)(PV + R0 * 512 + (size_t)idx * 8);
            __syncthreads();
#pragma unroll 1
            for (int it = 0; it < 8; ++it) {
                const int idx = tid + 512 * it, r = idx >> 6, ch8 = idx & 63;
                const int g = ch8 >> 4, w = 2 << g;
                float a[8];
#pragma unroll
                for (int e = 0; e < 8; ++e) a[e] = 0.f;
                const LAS char* src = lds + ((r + 15) * 64 + ch8) * 16;
                const u32x4 self = *(const LAS u32x4*)src;
                for (int i = 0; i < w; ++i) {
                    const u32x4 v = *(const LAS u32x4*)(src - i * 1024);
                    a[0] += bf_lo(v.x); a[1] += bf_hi(v.x); a[2] += bf_lo(v.y); a[3] += bf_hi(v.y); a[4] += bf_lo(v.z); a[5] += bf_hi(v.z); a[6] += bf_lo(v.w); a[7] += bf_hi(v.w);
                }
                const float iw = 1.f / (float)w;
                u32x4 o;
                o.x = cvt_pk_bf16(a[0] * iw - bf_lo(self.x), a[1] * iw - bf_hi(self.x)); o.y = cvt_pk_bf16(a[2] * iw - bf_lo(self.y), a[3] * iw - bf_hi(self.y));
                o.z = cvt_pk_bf16(a[4] * iw - bf_lo(self.z), a[5] * iw - bf_hi(self.z)); o.w = cvt_pk_bf16(a[6] * iw - bf_lo(self.w), a[7] * iw - bf_hi(self.w));
                *(u32x4*)(DD + (size_t)(n0 + r) * 512 + ch8 * 8) = o;
            }
            __syncthreads();
        }
    }
    for (int x = blockIdx.x; x < 256; x += gridDim.x) {
        const int b = x & 7, r = x >> 3;
#pragma unroll 1
        for (int rep = 0; rep < 2; ++rep) attn_item(p, b, rep == 0 ? 32 - (r >> 1) : 1 + (r >> 1), r & 1, lds);
    }
}

struct P3Sched {
    __device__ __forceinline__ void a_ready(const g8::Unit&) const {}
    g8::TileOrder T; const char *AT, *DD, *WA, *WF;
    __device__ __forceinline__ bool next(int i, g8::Unit& u, int) const {
        int pm, pn; if (!T.tile(i >> 1, pm, pn)) return false;
        const int br = i & 1;
        u.A = (br ? DD : AT) + (size_t)pm * 256 * 512 * 2; u.B = (br ? WF : WA) + (size_t)pn * 256 * 512 * 2; u.i0 = pm; u.i1 = pn; u.i2 = br; return true;
    }
};
struct P3Epi {
    const Params* pp;
    __device__ __forceinline__ bool operator()(f32x4 (&acc)[2][2][4][2], const g8::Unit& u, int wr, int wc, int fr, int fq, LAS char*) const {
        const Params& p = *pp;
        const bf16_t* GT = (const bf16_t*)(p.ws + WS_GATES); bf16_t* MG = (bf16_t*)(p.ws + WS_U);
        const int rowb = u.i0 * 256 + wr * 64 + fr, colb = u.i1 * 256 + wc * 32 + 4 * fq, br = u.i2;
        FOR_ACC(ai, bj, m, n) {
            const int nrow = rowb + ai * 128 + m * 16, col = colb + bj * 128 + n * 16;
            const size_t R = (size_t)nrow + 16 + 16 * (nrow >> 11);
            const u32x2 gp = *(const u32x2*)(GT + R * 2048 + 1024 + col);
            f32x4 v = acc[ai][bj][m][n];
            if (br == 0) {
                const u32x2 ga = *(const u32x2*)(GT + R * 2048 + col);
                v[0] *= bf_lo(ga.x) * __builtin_amdgcn_rcpf(bf_lo(gp.x)); v[1] *= bf_hi(ga.x) * __builtin_amdgcn_rcpf(bf_hi(gp.x));
                v[2] *= bf_lo(ga.y) * __builtin_amdgcn_rcpf(bf_lo(gp.y)); v[3] *= bf_hi(ga.y) * __builtin_amdgcn_rcpf(bf_hi(gp.y));
                acc[ai][bj][m][n] = v;
            } else {
                v[0] *= bf_lo(gp.x); v[1] *= bf_hi(gp.x); v[2] *= bf_lo(gp.y); v[3] *= bf_hi(gp.y);
                st4bf(MG + (size_t)nrow * 1024 + col, v);
            }
        }
        return br == 0;
    }
};
__device__ __forceinline__ void p3_phase(const Params& p, LAS char* lds) {
    P3Sched S; S.T.init(NTOK / 256, 4, gridDim.x, blockIdx.x);
    S.AT = (const char*)(p.ws + WS_ATTN); S.DD = (const char*)(p.ws + WS_DD); S.WA = (const char*)(p.ws + WS_WA); S.WF = (const char*)(p.ws + WS_WF);
    P3Epi E{&p};
    g8::gemm_phase<P3Epi, P3Sched, false>(lds, 512, S, E);
}

struct P4Sched {
    __device__ __forceinline__ void a_ready(const g8::Unit&) const {}
    g8::TileOrder T; const char *MG, *WO;
    __device__ __forceinline__ bool next(int i, g8::Unit& u, int) const {
        int pm, pn; if (!T.tile(i, pm, pn)) return false;
        u.A = MG + (size_t)pm * 256 * 1024 * 2; u.B = WO + (size_t)pn * 256 * 1024 * 2; u.i0 = pm; u.i1 = pn; return true;
    }
};
struct P4Epi {
    const Params* pp;
    __device__ __forceinline__ bool operator()(f32x4 (&acc)[2][2][4][2], const g8::Unit& u, int wr, int wc, int fr, int fq, LAS char*) const {
        const Params& p = *pp;
        const int rowb = u.i0 * 256 + wr * 64 + fr, colb = u.i1 * 256 + wc * 32 + 4 * fq;
        FOR_ACC(ai, bj, m, n) {
            const size_t off = (size_t)(rowb + ai * 128 + m * 16) * 1024 + colb + bj * 128 + n * 16;
            st4bf((bf16_t*)(p.ws + WS_H2) + off, *(const f32x4*)(p.x + off) + acc[ai][bj][m][n]);
        }
            return false;
    }
};
__device__ __forceinline__ void p4_phase(const Params& p, LAS char* lds) {
    P4Sched S; S.T.init(NTOK / 256, 4, gridDim.x, blockIdx.x); S.MG = (const char*)(p.ws + WS_U); S.WO = (const char*)(p.ws + WS_WO);
    P4Epi E{&p};
    g8::gemm_phase<P4Epi, P4Sched, false>(lds, 1024, S, E);
}

constexpr int P5_USTR = 1032;
constexpr int P5_ULO = 32 * P5_USTR * 2;
constexpr int P5_PART = 2 * P5_ULO;
constexpr int P5_MISC = P5_PART + 4 * 48 * 32 * 4;
__device__ __forceinline__ void p5_phase(const Params& p, LAS char* lds) {
    const int tid = threadIdx.x, wid = __builtin_amdgcn_readfirstlane(tid >> 6), lane = tid & 63, fr0 = lane & 15, fq0 = lane >> 4;
    LAS bf16_t* Uhi = (LAS bf16_t*)lds; LAS bf16_t* Ulo = (LAS bf16_t*)(lds + P5_ULO);
    LAS float* part = (LAS float*)(lds + P5_PART);
    LAS int* lcnt = (LAS int*)(lds + P5_MISC);
    LAS int* lbase = lcnt + 32;
    LAS int* tk_e = lbase + 32;
    LAS int* tk_r = tk_e + 128;
    LAS float* tk_w = (LAS float*)(tk_r + 128);
    bf16_t* U2 = (bf16_t*)(p.ws + WS_U);
    const bf16_t* WRH = (const bf16_t*)(p.ws + WS_WRH); const bf16_t* WRL = (const bf16_t*)(p.ws + WS_WRL);
    int* cnt = (int*)(p.ws + WS_CNT); int* list = (int*)(p.ws + WS_LIST); float* wts = (float*)(p.ws + WS_WTS); int* tokrow = (int*)(p.ws + WS_TOKROW);
    for (int chunk = blockIdx.x; chunk < NTOK / 64; chunk += gridDim.x) {
        if (tid < 32) lcnt[tid] = 0;
        f32x4 gg[4];
#pragma unroll
        for (int j = 0; j < 4; ++j) gg[j] = *(const f32x4*)(p.norm2_g + j * 256 + lane * 4);
#pragma unroll 1
        for (int pass = 0; pass < 2; ++pass) {
            const int tb0 = chunk * 64 + pass * 32;
            f32x4 v[4][4];
#pragma unroll
            for (int t = 0; t < 4; ++t)
#pragma unroll
                for (int j = 0; j < 4; ++j) { const u32x2 hb = *(const u32x2*)((const bf16_t*)(p.ws + WS_H2) + (size_t)(tb0 + wid * 4 + t) * 1024 + j * 256 + lane * 4);
                    v[t][j] = (f32x4){bf_lo(hb.x), bf_hi(hb.x), bf_lo(hb.y), bf_hi(hb.y)}; }
#pragma unroll
            for (int t = 0; t < 4; ++t) {
                float ss = 0.f;
#pragma unroll
                for (int j = 0; j < 4; ++j) ss += v[t][j][0] * v[t][j][0] + v[t][j][1] * v[t][j][1] + v[t][j][2] * v[t][j][2] + v[t][j][3] * v[t][j][3];
                ss = wave_sum(ss);
                const float rstd = rsqrtf(ss * (1.f / 1024.f) + EPS);
                const int tl = wid * 4 + t;
#pragma unroll
                for (int j = 0; j < 4; ++j) {
                    const f32x4 u = v[t][j] * rstd * gg[j];
                    u32x2 hi; hi.x = cvt_pk_bf16(u[0], u[1]); hi.y = cvt_pk_bf16(u[2], u[3]);
                    u32x2 lo; lo.x = cvt_pk_bf16(u[0] - bf_lo(hi.x), u[1] - bf_hi(hi.x)); lo.y = cvt_pk_bf16(u[2] - bf_lo(hi.y), u[3] - bf_hi(hi.y));
                    *(u32x2*)(U2 + (size_t)(tb0 + tl) * 1024 + j * 256 + lane * 4) = hi;
                    *(LAS u32x2*)(Uhi + tl * P5_USTR + j * 256 + lane * 4) = hi;
                    *(LAS u32x2*)(Ulo + tl * P5_USTR + j * 256 + lane * 4) = lo;
                }
            }
            __syncthreads();
            {
                const int tw = wid & 1, kq = wid >> 1;
                int fr = fr0, fq = fq0; asm volatile("" : "+v"(fr), "+v"(fq));
                f32x4 acc[3];
#pragma unroll
                for (int ot = 0; ot < 3; ++ot) acc[ot] = (f32x4){0.f, 0.f, 0.f, 0.f};
                const LAS bf16_t* bh = Uhi + (tw * 16 + fr) * P5_USTR + kq * 256 + fq * 8;
                const LAS bf16_t* bl = Ulo + (tw * 16 + fr) * P5_USTR + kq * 256 + fq * 8;
                const bf16_t* ah = WRH + (size_t)fr * 1024 + kq * 256 + fq * 8;
                const bf16_t* al = WRL + (size_t)fr * 1024 + kq * 256 + fq * 8;
#pragma unroll 2
                for (int ks = 0; ks < 8; ++ks) {
                    const bf16x8 bhi = *(const LAS bf16x8*)(bh + ks * 32), blo = *(const LAS bf16x8*)(bl + ks * 32);
#pragma unroll
                    for (int ot = 0; ot < 3; ++ot) {
                        const bf16x8 ahi = *(const bf16x8*)(ah + (size_t)ot * 16 * 1024 + ks * 32), alo = *(const bf16x8*)(al + (size_t)ot * 16 * 1024 + ks * 32);
                        acc[ot] = mfma16(ahi, bhi, acc[ot]); acc[ot] = mfma16(alo, bhi, acc[ot]); acc[ot] = mfma16(ahi, blo, acc[ot]);
                    }
                }
#pragma unroll
                for (int ot = 0; ot < 3; ++ot)
#pragma unroll
                    for (int r = 0; r < 4; ++r) part[(kq * 48 + ot * 16 + 4 * fq + r) * 32 + tw * 16 + fr] = acc[ot][r];
            }
            __syncthreads();
            if (tid < 32) {
                float L[36];
                int tq = tid; asm volatile("" : "+v"(tq));
                const LAS float* pt = part + tq;
#pragma unroll
                for (int o = 0; o < 36; ++o) L[o] = (pt[o * 32] + pt[(48 + o) * 32]) + (pt[(96 + o) * 32] + pt[(144 + o) * 32]);
                float gl[4];
#pragma unroll
                for (int g = 0; g < 4; ++g) gl[g] = L[g] + p.b_gr[g];
                int gs = 0; float gm = gl[0];
#pragma unroll
                for (int g = 1; g < 4; ++g) if (gl[g] > gm) { gm = gl[g]; gs = g; }
                float gsum = 0.f;
#pragma unroll
                for (int g = 0; g < 4; ++g) gsum += __expf(gl[g] - gm);
                const float pg = 1.f / gsum;
                float el[8];
#pragma unroll
                for (int e = 0; e < 8; ++e) {
                    const float l0 = L[4 + e] + p.b_er[e], l1 = L[12 + e] + p.b_er[8 + e], l2 = L[20 + e] + p.b_er[16 + e], l3 = L[28 + e] + p.b_er[24 + e];
                    el[e] = gs == 0 ? l0 : (gs == 1 ? l1 : (gs == 2 ? l2 : l3));
                }
                int i1 = 0; float v1 = el[0];
#pragma unroll
                for (int e = 1; e < 8; ++e) if (el[e] > v1) { v1 = el[e]; i1 = e; }
                int i2 = (i1 == 0) ? 1 : 0; float v2 = -INFINITY;
#pragma unroll
                for (int e = 0; e < 8; ++e) if (e != i1 && el[e] > v2) { v2 = el[e]; i2 = e; }
                const float e2 = __expf(v2 - v1), p1 = 1.f / (1.f + e2), p2 = e2 * p1;
                const int tl = pass * 32 + tid, ea = gs * 8 + i1, eb = gs * 8 + i2;
                tk_e[tl * 2] = ea; tk_e[tl * 2 + 1] = eb;
                tk_r[tl * 2] = __hip_atomic_fetch_add(&lcnt[ea], 1, __ATOMIC_RELAXED, __HIP_MEMORY_SCOPE_WORKGROUP); tk_r[tl * 2 + 1] = __hip_atomic_fetch_add(&lcnt[eb], 1, __ATOMIC_RELAXED, __HIP_MEMORY_SCOPE_WORKGROUP);
                tk_w[tl * 2] = pg * p1; tk_w[tl * 2 + 1] = pg * p2;
            }
            __syncthreads();
        }
        if (tid < 32) lbase[tid] = atomicAdd(&cnt[tid], lcnt[tid]);
        __syncthreads();
        if (tid < 128) {
            const int e = tk_e[tid], slot = lbase[e] + tk_r[tid], n = chunk * 64 + (tid >> 1);
            list[e * LISTCAP + slot] = n; wts[e * LISTCAP + slot] = tk_w[tid]; tokrow[n * 2 + (tid & 1)] = e * LISTCAP + slot;
        }
        __syncthreads();
    }
}

__device__ __forceinline__ void moe_tables(const Params& p, LAS int* tb) {
    if (threadIdx.x == 0) {
        const int* cnt = (const int*)(p.ws + WS_CNT);
        int acc = 0;
        for (int e = 0; e < 32; ++e) { const int c = __hip_atomic_load(cnt + e, __ATOMIC_RELAXED, __HIP_MEMORY_SCOPE_AGENT); tb[e] = c; tb[32 + e] = acc; acc += (c + 255) >> 8; }
        tb[64] = acc;
    }
    __syncthreads();
}

struct P6Sched {
    __device__ __forceinline__ void a_ready(const g8::Unit&) const {}
    const LAS int* tb; const char *U2, *W1; const int* list; int G, c, nunits;
    __device__ __forceinline__ bool next(int i, g8::Unit& u, int tid) const {
        const int g = i * G + c; if (g >= nunits) return false;
        int e = 0;
#pragma unroll 1
        for (int q = 1; q < 32; ++q) if (2 * tb[32 + q] <= g) e = q;
        const int nte = tb[33 + e] - tb[32 + e], l = g - 2 * tb[32 + e], pn = l / nte, rt = l - pn * nte, ce = tb[e];
        u.A = U2; u.B = W1 + ((size_t)e * 512 + pn * 256) * 1024 * 2; u.i0 = e; u.i1 = rt; u.i2 = pn; u.i3 = tb[32 + e] + rt;
#pragma unroll
        for (int h = 0; h < 2; ++h)
#pragma unroll
            for (int k = 0; k < 2; ++k) { int sR, sC; g8::stage_rc(tid * 16 + k * 8192, sR, sC); const int slot = rt * 256 + h * 128 + sR; const int tok = slot < ce ? list[e * LISTCAP + slot] : 0; u.va[h][k] = (unsigned)(tok * 1024 + sC) * 2u; }
        return true;
    }
};
struct P6Epi {
    const Params* pp; const LAS int* tb;
    __device__ __forceinline__ bool operator()(f32x4 (&acc)[2][2][4][2], const g8::Unit& u, int wr, int wc, int fr, int fq, LAS char*) const {
        const Params& p = *pp;
        const float* wts = (const float*)(p.ws + WS_WTS);
        const int e = u.i0, rt = u.i1, pn = u.i2, ce = tb[e];
        const size_t rowbase = (size_t)u.i3 * 256;
        const __amdgpu_buffer_rsrc_t rsrc = __builtin_amdgcn_make_buffer_rsrc((void*)(p.ws + WS_HID), 0, (int)((size_t)YROWS * 256 * 2), 0x00020000);
#pragma unroll
        for (int ai = 0; ai < 2; ++ai)
#pragma unroll
            for (int m = 0; m < 4; ++m) {
                const int lr = ai * 128 + wr * 64 + m * 16 + fr, slot = rt * 256 + lr;
                const float w = slot < ce ? wts[e * LISTCAP + slot] : 0.f;
                u32x4 o;
#pragma unroll
                for (int n = 0; n < 2; ++n) {
                    const f32x4 g = acc[ai][0][m][n], uu = acc[ai][1][m][n]; f32x4 hv;
#pragma unroll
                    for (int r = 0; r < 4; ++r) hv[r] = g[r] * __builtin_amdgcn_rcpf(1.f + __expf(-g[r])) * uu[r] * w;
                    o[2 * n] = cvt_pk_bf16(hv[0], hv[1]); o[2 * n + 1] = cvt_pk_bf16(hv[2], hv[3]);
                }
                __builtin_amdgcn_raw_buffer_store_b128(o, rsrc, (int)(((rowbase + lr) * 256 + pn * 128 + wc * 32 + 8 * fq) * 2), 0, 16);
            }
        asm volatile("s_waitcnt vmcnt(0)" ::: "memory");
        if (fr == 0 && fq == 0) __hip_atomic_fetch_add((int*)(p.ws + WS_READY) + u.i3, 1, __ATOMIC_RELAXED, __HIP_MEMORY_SCOPE_AGENT);
            return false;
    }
};
__device__ __forceinline__ void p6_phase(const Params& p, LAS char* lds) {
    LAS int* tb = (LAS int*)(lds + GX_OFF);
    moe_tables(p, tb);
    P6Sched S; S.tb = tb; S.U2 = (const char*)(p.ws + WS_U); S.W1 = (const char*)(p.ws + WS_W1); S.list = (const int*)(p.ws + WS_LIST); S.G = gridDim.x; S.c = vcu_id(); S.nunits = tb[64] * 2;
    P6Epi E{&p, tb};
    g8::gemm_phase<P6Epi, P6Sched, true, true>(lds, 1024, S, E);
}

struct P7Sched {
    const LAS int* tb; const char *HID, *W2; int* ready; int G, c, nunits, nheavy;
    __device__ __forceinline__ void a_ready(const g8::Unit& u) const {
        if (__builtin_amdgcn_readfirstlane(threadIdx.x >> 6) == 0) {
            int* w = ready + u.i0; unsigned sp = 0;
            while (__hip_atomic_load(w, __ATOMIC_RELAXED, __HIP_MEMORY_SCOPE_AGENT) < 16) { __builtin_amdgcn_s_sleep(8); if (++sp > (1u << 21)) break; }
            __builtin_amdgcn_fence(__ATOMIC_ACQUIRE, "agent");
            asm volatile("s_waitcnt vmcnt(0)" ::: "memory");
        }
        __builtin_amdgcn_s_barrier();
    }
    __device__ __forceinline__ bool next(int i, g8::Unit& u, int) const {
        if (c < nheavy) return false;
        const int g = i * (G - nheavy) + (c - nheavy); if (g >= nunits) return false;
        int e = 0;
#pragma unroll 1
        for (int q = 1; q < 32; ++q) if (4 * tb[32 + q] <= g) e = q;
        const int nte = tb[33 + e] - tb[32 + e], l = g - 4 * tb[32 + e], pn = l / nte, rt = l - pn * nte, ti = tb[32 + e] + rt;
        u.A = HID + (size_t)ti * 256 * 256 * 2; u.B = W2 + ((size_t)e * 1024 + pn * 256) * 256 * 2; u.i0 = ti; u.i1 = pn; return true;
    }
};
struct P7Epi {
    const Params* pp;
    __device__ __forceinline__ bool operator()(f32x4 (&acc)[2][2][4][2], const g8::Unit& u, int wr, int wc, int fr, int fq, LAS char*) const {
        bf16_t* Y = (bf16_t*)(pp->ws + WS_Y);
        FOR_ACC(ai, bj, m, n) st4bf(Y + ((size_t)u.i0 * 256 + ai * 128 + wr * 64 + m * 16 + fr) * 1024 + u.i1 * 256 + bj * 128 + wc * 32 + n * 16 + 4 * fq, acc[ai][bj][m][n]);
            return false;
    }
};
__device__ __forceinline__ void p7_phase(const Params& p, LAS char* lds) {
    LAS int* tb = (LAS int*)(lds + GX_OFF);
    moe_tables(p, tb);
    P7Sched S; S.tb = tb; S.HID = (const char*)(p.ws + WS_HID); S.W2 = (const char*)(p.ws + WS_W2); S.ready = (int*)(p.ws + WS_READY); S.G = gridDim.x; S.c = vcu_id(); S.nunits = tb[64] * 4; { const int n6 = tb[64] * 2 - (int)gridDim.x; S.nheavy = n6 < 0 ? 0 : (n6 > (int)gridDim.x / 2 ? (int)gridDim.x / 2 : n6); }
    P7Epi E{&p};
    g8::gemm_phase<P7Epi, P7Sched, false>(lds, 256, S, E);
}

__device__ __forceinline__ void p8_phase(const Params& p, LAS char* lds) {
    const int tid = threadIdx.x, wid = tid >> 6, lane = tid & 63;
    LAS int* tb = (LAS int*)lds;
    moe_tables(p, tb);
    const bf16_t* Y = (const bf16_t*)(p.ws + WS_Y); const bf16_t* H2 = (const bf16_t*)(p.ws + WS_H2); const int* tokrow = (const int*)(p.ws + WS_TOKROW);
    f32x4 g[4];
#pragma unroll
    for (int j = 0; j < 4; ++j) g[j] = *(const f32x4*)(p.final_g + j * 256 + lane * 4);
    const int stride = gridDim.x * 8;
    for (int n0 = blockIdx.x * 8 + wid; n0 < NTOK; n0 += 2 * stride) {
        u32x2 hb[2][4], ya[2][4], yc[2][4]; bool ok[2];
#pragma unroll
        for (int q = 0; q < 2; ++q) {
            const int n = n0 + q * stride; ok[q] = n < NTOK;
            const int nn = ok[q] ? n : n0;
            const int r1 = tokrow[nn * 2], r2 = tokrow[nn * 2 + 1];
            const size_t y1 = (size_t)tb[32 + (r1 >> 14)] * 256 + (r1 & 16383), y2 = (size_t)tb[32 + (r2 >> 14)] * 256 + (r2 & 16383);
#pragma unroll
            for (int j = 0; j < 4; ++j) {
                hb[q][j] = *(const u32x2*)(H2 + (size_t)nn * 1024 + j * 256 + lane * 4);
                ya[q][j] = *(const u32x2*)(Y + y1 * 1024 + j * 256 + lane * 4); yc[q][j] = *(const u32x2*)(Y + y2 * 1024 + j * 256 + lane * 4);
            }
        }
#pragma unroll
        for (int q = 0; q < 2; ++q) {
            f32x4 v[4]; float ss = 0.f;
#pragma unroll
            for (int j = 0; j < 4; ++j) {
                v[j][0] = bf_lo(hb[q][j].x) + bf_lo(ya[q][j].x) + bf_lo(yc[q][j].x); v[j][1] = bf_hi(hb[q][j].x) + bf_hi(ya[q][j].x) + bf_hi(yc[q][j].x);
                v[j][2] = bf_lo(hb[q][j].y) + bf_lo(ya[q][j].y) + bf_lo(yc[q][j].y); v[j][3] = bf_hi(hb[q][j].y) + bf_hi(ya[q][j].y) + bf_hi(yc[q][j].y);
                ss += v[j][0] * v[j][0] + v[j][1] * v[j][1] + v[j][2] * v[j][2] + v[j][3] * v[j][3];
            }
            ss = wave_sum(ss);
            const float rstd = rsqrtf(ss * (1.f / 1024.f) + EPS);
            if (ok[q]) {
#pragma unroll
                for (int j = 0; j < 4; ++j) *(f32x4*)(p.out + (size_t)(n0 + q * stride) * 1024 + j * 256 + lane * 4) = v[j] * rstd * g[j];
            }
        }
    }
}

__global__ void __launch_bounds__(512, 2) fwd_kernel(Params p) {
    extern __shared__ __attribute__((aligned(16))) unsigned char smem[];
    LAS char* lds = (LAS char*)smem;
    volatile LAS unsigned* barw = (volatile LAS unsigned*)(lds + LDS_BARW);
    if (threadIdx.x < 2) barw[threadIdx.x] = 0u;
    __syncthreads();
    XcdBarrier bar; bar.bar = (unsigned*)(p.ws + WS_BAR); bar.x = 0; bar.st = nullptr;
    if (N_LAUNCHES == 1) bar = xcd_barrier_post((unsigned*)(p.ws + WS_BAR), barw);
    const int lo = p.ph_lo, hi = p.ph_hi;
    unsigned long long _kstart = 0; if (MEAS_SEC >= 50 && MEAS_SEC < 60) _kstart = __builtin_amdgcn_s_memtime();
#define MEAS_SEAM(k) if (MEAS_SEC == 50 + (k)) { __builtin_amdgcn_s_waitcnt(0); const unsigned long long _d = __builtin_amdgcn_s_memtime() - _kstart; \
    if (blockIdx.x == MEAS_BLK && threadIdx.x == 0) { unsigned long long* _slot = (unsigned long long*)(p.ws + WS_CNT + 128); if (*_slot == 0ull) *_slot = _d; } }
#define IN(k) (lo <= (k) && (k) < hi)
#define SEAM(k) do { if (IN(k) && IN((k) + 1)) xcd_barrier(bar); } while (0)
#ifndef PH_MASK
#define PH_MASK 0x7ff
#endif
#define HAS(k) ((PH_MASK >> (k)) & 1)
    if (HAS(0) && IN(0)) { MEAS_T0(10) p0_phase(p, lds); MEAS_T1(10, p.ws) if (DUP_PHASE == 0) { xcd_barrier(bar); p0_phase(p, lds); } } SEAM(0); MEAS_SEAM(0)
    if (HAS(1) && IN(1)) { MEAS_T0(11) p1_phase(p, lds); MEAS_T1(11, p.ws) if (DUP_PHASE == 1) { xcd_barrier(bar); p1_phase(p, lds); } } SEAM(1); MEAS_SEAM(1)
    if (HAS(2) && IN(2)) { MEAS_T0(12) p2_phase(p, lds); MEAS_T1(12, p.ws) if (DUP_PHASE == 2) { xcd_barrier(bar); p2_phase(p, lds); } } SEAM(2); MEAS_SEAM(2)
    if (HAS(3) && IN(3)) { MEAS_T0(13) p3_phase(p, lds); MEAS_T1(13, p.ws) if (DUP_PHASE == 3) { xcd_barrier(bar); p3_phase(p, lds); } } SEAM(3); MEAS_SEAM(3)
    if (HAS(4) && IN(4)) { MEAS_T0(14) p4_phase(p, lds); MEAS_T1(14, p.ws) if (DUP_PHASE == 4) { xcd_barrier(bar); p4_phase(p, lds); } } SEAM(4); MEAS_SEAM(4)
    if (HAS(5) && IN(5)) { MEAS_T0(15) p5_phase(p, lds); MEAS_T1(15, p.ws) if (DUP_PHASE == 5) { xcd_barrier(bar); if (blockIdx.x == 0 && threadIdx.x < 32) ((int*)(p.ws + WS_CNT))[threadIdx.x] = 0; xcd_barrier(bar); p5_phase(p, lds); } } SEAM(5); MEAS_SEAM(5)
    if (HAS(6) && IN(6)) { MEAS_T0(16) p6_phase(p, lds); MEAS_T1(16, p.ws) }   MEAS_SEAM(6)
    if (HAS(7) && IN(7)) { MEAS_T0(17) p7_phase(p, lds); MEAS_T1(17, p.ws) if (DUP_PHASE == 7) { xcd_barrier(bar); p7_phase(p, lds); } } SEAM(7); MEAS_SEAM(7)
    if (HAS(8) && IN(8)) { MEAS_T0(18) p8_phase(p, lds); MEAS_T1(18, p.ws) } MEAS_SEAM(8)
    if (MEAS_SEC != 0 && blockIdx.x == 0 && threadIdx.x == 0) {
        const unsigned long long d = *(volatile unsigned long long*)(p.ws + WS_CNT + 128);
        const unsigned long long t0 = __builtin_amdgcn_s_memtime();
        while (__builtin_amdgcn_s_memtime() - t0 < d * MEAS_MULT) __builtin_amdgcn_s_sleep(8);
    }
}

extern "C" void kernel_launch(void* const* d_in, const int* in_sizes, int n_in, void* d_out, int out_size, void* d_ws, size_t ws_size, hipStream_t stream) {
    static int grid = 0;
    if (grid == 0) {
        if (n_in != 21 || ws_size < WS_END) { fprintf(stderr, "kernel_launch: unexpected n_in %d or ws_size %zu (< %zu)\n", n_in, ws_size, (size_t)WS_END); grid = -1; return; }
        int dev = 0, cus = 0;
        if (hipGetDevice(&dev) != hipSuccess || hipDeviceGetAttribute(&cus, hipDeviceAttributeMultiprocessorCount, dev) != hipSuccess) { grid = -1; return; }
        if (hipFuncSetAttribute((const void*)fwd_kernel, hipFuncAttributeMaxDynamicSharedMemorySize, LDS_BYTES) != hipSuccess) { fprintf(stderr, "kernel_launch: hipFuncSetAttribute failed\n"); grid = -1; return; }
        grid = cus;
    }
    if (grid < 0) return;
    (void)hipMemsetAsync((char*)d_ws + WS_BAR, 0, WS_ZERO_BYTES, stream);
#if EXTRA_MEMSET
    (void)hipMemsetAsync((char*)d_ws + WS_BAR, 0, WS_ZERO_BYTES, stream);
#endif
    Params p{};
    const float** f = (const float**)&p;
    for (int i = 0; i < 21; ++i) f[i] = (const float*)d_in[i];
    p.out = (float*)d_out; p.ws = (unsigned char*)d_ws;
    if (N_LAUNCHES == 1) { p.ph_lo = 0; p.ph_hi = NPH; hipLaunchKernelGGL(fwd_kernel, dim3(grid), dim3(512), LDS_BYTES, stream, p); }
    else for (int k = 0; k < NPH; ++k) { p.ph_lo = k; p.ph_hi = k + 1; hipLaunchKernelGGL(fwd_kernel, dim3(grid), dim3(512), LDS_BYTES, stream, p); }
}
```

```cpp
#include <hip/hip_runtime.h>
#include <stdint.h>
#include <stdio.h>

#ifndef DUP_PHASE
#define DUP_PHASE -1
#endif
#ifndef MEAS_SEC
#define MEAS_SEC 0
#endif
#ifndef MEAS_BLK
#define MEAS_BLK 0
#endif
#ifndef MEAS_MULT
#define MEAS_MULT 100
#endif
#ifndef EXTRA_MEMSET
#define EXTRA_MEMSET 0
#endif
#ifndef N_LAUNCHES
#define N_LAUNCHES 1
#endif

#define LAS __attribute__((address_space(3)))
typedef unsigned short bf16_t;
typedef short bf16x8 __attribute__((ext_vector_type(8)));
typedef short s16x4 __attribute__((ext_vector_type(4)));
typedef float f32x4 __attribute__((ext_vector_type(4)));
typedef float f32x16 __attribute__((ext_vector_type(16)));
typedef unsigned u32x4 __attribute__((ext_vector_type(4)));
typedef unsigned u32x2 __attribute__((ext_vector_type(2)));

constexpr int NB = 8, SEQ = 2048, TT = 2064, DM = 1024;
constexpr int MALL = NB * TT;
constexpr int MPAD = 16640;
constexpr int NTOK = NB * SEQ;
constexpr int INW = 3496, INP = 3584;
constexpr float EPS = 1e-6f;
constexpr float ATTN_SCALE = 0.125f;
constexpr float IDX_SCALE = 0.0625f;
constexpr float LOG2E = 1.4426950408889634f;
constexpr int NPH = 9;
constexpr int LISTCAP = 16384;
constexpr int YROWS = 40960;

constexpr size_t AL(size_t x) { return (x + 255) & ~(size_t)255; }
constexpr size_t WS_BAR   = 0;
constexpr size_t WS_CNT   = WS_BAR + 16384;
constexpr size_t WS_READY = WS_CNT + 256;
constexpr size_t WS_READY3 = WS_CNT + 2048;
constexpr size_t WS_READY4 = WS_CNT + 3072;
constexpr size_t WS_ZERO_BYTES = 16384 + 4096;
constexpr size_t WS_WIN   = AL(WS_CNT + 4096);
constexpr size_t WS_WUK   = AL(WS_WIN + (size_t)INP * DM * 2);
constexpr size_t WS_WUV   = AL(WS_WUK + 8 * 128 * 64 * 2);
constexpr size_t WS_WF    = AL(WS_WUV + 8 * 64 * 128 * 2);
constexpr size_t WS_WA    = AL(WS_WF + 1024 * 512 * 2);
constexpr size_t WS_WO    = AL(WS_WA + 1024 * 512 * 2);
constexpr size_t WS_W1    = AL(WS_WO + 1024 * 1024 * 2);
constexpr size_t WS_W2    = AL(WS_W1 + (size_t)32 * 512 * 1024 * 2);
constexpr size_t WS_WRH   = AL(WS_W2 + (size_t)32 * 1024 * 256 * 2);
constexpr size_t WS_WRL   = AL(WS_WRH + 48 * 1024 * 2);
constexpr size_t WS_U     = AL(WS_WRL + 48 * 1024 * 2);
constexpr size_t WS_LIST  = AL(WS_U + (size_t)MPAD * DM * 2);
constexpr size_t WS_WTS   = AL(WS_LIST + (size_t)32 * LISTCAP * 4);
constexpr size_t WS_TOKROW= AL(WS_WTS + (size_t)32 * LISTCAP * 4);
constexpr size_t WS_UNION = AL(WS_TOKROW + (size_t)NTOK * 2 * 4);
constexpr size_t WS_Q     = WS_UNION;
constexpr size_t WS_C     = AL(WS_Q + (size_t)MPAD * 512 * 2);
constexpr size_t WS_IQ    = AL(WS_C + (size_t)MPAD * 128 * 2);
constexpr size_t WS_IK    = AL(WS_IQ + (size_t)MPAD * 256 * 2);
constexpr size_t WS_IW    = AL(WS_IK + (size_t)MPAD * 32 * 2);
constexpr size_t WS_PV    = AL(WS_IW + (size_t)MPAD * 8 * 4);
constexpr size_t WS_GATES = AL(WS_PV + (size_t)MPAD * 512 * 2);
constexpr size_t WS_ATTN  = AL(WS_GATES + (size_t)MPAD * 2048 * 2);
constexpr size_t WS_DD    = AL(WS_ATTN + (size_t)NTOK * 512 * 2);
constexpr size_t WS_ENDA  = AL(WS_DD + (size_t)NTOK * 512 * 2);
constexpr size_t WS_HID   = WS_UNION;
constexpr size_t WS_Y     = AL(WS_HID + (size_t)YROWS * 256 * 2);
constexpr size_t WS_H2    = AL(WS_Y + (size_t)YROWS * 1024 * 2);
constexpr size_t WS_ENDB  = AL(WS_H2 + (size_t)NTOK * 1024 * 2);
constexpr size_t WS_END   = WS_ENDA > WS_ENDB ? WS_ENDA : WS_ENDB;

constexpr int LDS_BYTES = 156 * 1024;
constexpr int LDS_BARW  = LDS_BYTES - 16;

struct Params {
    const float *x, *meta, *norm1_g, *w_in, *kv_norm_g, *w_uk, *w_uv, *w_pool, *pool_scale, *w_ba, *w_bp, *w_out, *norm2_g,
                *w_gr, *b_gr, *w_er, *b_er, *w_eg, *w_eu, *w_ed, *final_g;
    float* out; unsigned char* ws; int ph_lo, ph_hi;
};

typedef __bf16 bf16v2_t __attribute__((ext_vector_type(2)));
typedef float f32x2 __attribute__((ext_vector_type(2)));
__device__ __forceinline__ unsigned cvt_pk_bf16(float lo, float hi) { const f32x2 v = {lo, hi}; return __builtin_bit_cast(unsigned, __builtin_convertvector(v, bf16v2_t)); }
__device__ __forceinline__ float bf_lo(unsigned u) { return __uint_as_float(u << 16); }
__device__ __forceinline__ float bf_hi(unsigned u) { return __uint_as_float(u & 0xffff0000u); }
__device__ __forceinline__ float wave_sum(float v) {
#pragma unroll
    for (int o = 1; o < 64; o <<= 1) v += __shfl_xor(v, o);
    return v;
}
__device__ __forceinline__ void st4bf(bf16_t* p, f32x4 v) { u32x2 o; o.x = cvt_pk_bf16(v[0], v[1]); o.y = cvt_pk_bf16(v[2], v[3]); *(u32x2*)p = o; }
__device__ __forceinline__ f32x4 mfma16(bf16x8 a, bf16x8 b, f32x4 c) { return __builtin_amdgcn_mfma_f32_16x16x32_bf16(a, b, c, 0, 0, 0); }
__device__ __forceinline__ f32x16 mfma32(bf16x8 a, bf16x8 b, f32x16 c) { return __builtin_amdgcn_mfma_f32_32x32x16_bf16(a, b, c, 0, 0, 0); }

#define MEAS_T0(k) unsigned long long _mt##k = 0; if (MEAS_SEC == (k) || ((k) == 30 && MEAS_SEC >= 31 && MEAS_SEC <= 33)) { __builtin_amdgcn_sched_barrier(0); _mt##k = __builtin_amdgcn_s_memtime(); __builtin_amdgcn_sched_barrier(0); }
#define MEAS_T1(k, ws) if (MEAS_SEC == (k)) { __builtin_amdgcn_s_waitcnt(0); __builtin_amdgcn_sched_barrier(0); const unsigned long long _d = __builtin_amdgcn_s_memtime() - _mt##k; \
    if (blockIdx.x == MEAS_BLK && threadIdx.x == 0) { unsigned long long* _slot = (unsigned long long*)((ws) + WS_CNT + 128); if (*_slot == 0ull) *_slot = _d; } }

#define MEAS_T1X(k, k0, ws) if (MEAS_SEC == (k)) { __builtin_amdgcn_s_waitcnt(0); const unsigned long long _d = __builtin_amdgcn_s_memtime() - _mt##k0; \
    if (blockIdx.x == MEAS_BLK && threadIdx.x == 0) { unsigned long long* _slot = (unsigned long long*)((ws) + WS_CNT + 128); if (*_slot == 0ull) *_slot = _d; } }
#define XB_TMO      128
#define XB_XCNT(j)  (256  + 64 * (j))
#define XB_XSUB(j)  (1280 + 64 * (j))
#define XB_XGEN(j)  (2304 + 64 * (j))
#define XB_TOP      3328
#define XB_TOPGEN   3392
#define XCD_BAR_WORDS 3456
#define XB_SPIN_CAP (1u << 20)
__device__ __forceinline__ unsigned xb_ld(unsigned* p)              { return __hip_atomic_load(p, __ATOMIC_RELAXED, __HIP_MEMORY_SCOPE_AGENT); }
__device__ __forceinline__ unsigned xb_add(unsigned* p, unsigned v) { return __hip_atomic_fetch_add(p, v, __ATOMIC_RELAXED, __HIP_MEMORY_SCOPE_AGENT); }
__device__ __forceinline__ unsigned xb_xcc_id() { return (unsigned)__builtin_amdgcn_s_getreg((3 << 11) | 20) & 0xFu; }
#define XB_SPIN(cond, bar) do { unsigned _sp = 0; while (cond) { __builtin_amdgcn_s_sleep(1); \
    if ((++_sp & 255u) == 0u) { if (xb_ld(&(bar)[XB_TMO])) break; if (_sp > XB_SPIN_CAP) { atomicAdd(&(bar)[XB_TMO], 1u); break; } } } } while (0)
struct XcdBarrier { unsigned* bar; unsigned x; volatile LAS unsigned* st; };
__device__ __forceinline__ XcdBarrier xcd_barrier_post(unsigned* bar, volatile LAS unsigned* st) {
    XcdBarrier b; b.bar = bar; b.x = xb_xcc_id(); b.st = st;
    if (threadIdx.x == 0) (void)xb_add(&bar[XB_XCNT(b.x)], 1u);
    return b;
}
__device__ __forceinline__ void xcd_barrier_complete(unsigned* bar, unsigned x, unsigned& nloc, unsigned& nx) {
    const unsigned G = gridDim.x * gridDim.y * gridDim.z;
    unsigned sum, cnt, mine, sp = 0u;
    for (;;) {
        sum = 0u; cnt = 0u; mine = 0u;
#pragma unroll
        for (unsigned j = 0; j < 16; ++j) { const unsigned c = xb_ld(&bar[XB_XCNT(j)]); sum += c; cnt += (c > 0u) ? 1u : 0u; mine = (j == x) ? c : mine; }
        if (sum == G) break;
        __builtin_amdgcn_s_sleep(1);
        if ((++sp & 255u) == 0u) { if (xb_ld(&bar[XB_TMO])) break; if (sp > XB_SPIN_CAP) { atomicAdd(&bar[XB_TMO], 1u); break; } }
    }
    nloc = mine > 0u ? mine : 1u; nx = cnt > 0u ? cnt : 1u;
}
__device__ __forceinline__ void xcd_barrier(const XcdBarrier& b) {
    asm volatile("s_waitcnt vmcnt(0)" ::: "memory");
    __syncthreads();
    if (threadIdx.x == 0) {
        unsigned* bar = b.bar;
        __builtin_amdgcn_s_waitcnt(0);
        unsigned nloc = b.st[0], nx = b.st[1];
        if (nloc == 0u) { xcd_barrier_complete(bar, b.x, nloc, nx); b.st[0] = nloc; b.st[1] = nx; }
        const unsigned old = xb_add(&bar[XB_XSUB(b.x)], 1u);
        const unsigned gen = old / nloc;
        if (old + 1u == (gen + 1u) * nloc) {
            __builtin_amdgcn_fence(__ATOMIC_RELEASE, "agent");
            asm volatile("s_waitcnt vmcnt(0)" ::: "memory");
            const unsigned og = xb_add(&bar[XB_TOP], 1u);
            const unsigned tg = og / nx;
            if (og + 1u == (tg + 1u) * nx) xb_add(&bar[XB_TOPGEN], 1u);
            else XB_SPIN(xb_ld(&bar[XB_TOPGEN]) == tg, bar);
            __builtin_amdgcn_fence(__ATOMIC_ACQUIRE, "agent");
            xb_add(&bar[XB_XGEN(b.x)], 1u);
            asm volatile("s_waitcnt vmcnt(0)" ::: "memory");
        } else {
            XB_SPIN(xb_ld(&bar[XB_XGEN(b.x)]) == gen, bar);
            __builtin_amdgcn_fence(__ATOMIC_ACQUIRE, "agent");
            asm volatile("s_waitcnt vmcnt(0)" ::: "memory");
        }
    }
    __syncthreads();
}

struct TJob { const float* src; bf16_t* dst; int src_ld, dst_ld, N, ktiles, ntiles, nbatch, split; size_t sbs, dbs; };
__device__ __forceinline__ TJob tjob(const Params& p, int j) {
    bf16_t* win = (bf16_t*)(p.ws + WS_WIN); bf16_t* w1 = (bf16_t*)(p.ws + WS_W1);
    TJob J;
    switch (j) {
    case 0:  J = TJob{p.w_in,        win,                 INW, 1024, 936, 16, 4, 1, 0, 0, 0}; break;
    case 1:  J = TJob{p.w_in + 936,  win + 1024 * 1024,   INW, 1024, 512, 16, 2, 1, 0, 0, 0}; break;
    case 2:  J = TJob{p.w_in + 1448, win + 1536 * 1024,   INW, 1024, 2048, 16, 8, 1, 0, 0, 0}; break;
    case 3:  J = TJob{p.w_uv, (bf16_t*)(p.ws + WS_WUV),   512, 128, 64, 2, 1, 8, 0, 64, 64 * 128}; break;
    case 4:  J = TJob{p.w_ba, (bf16_t*)(p.ws + WS_WA),    1024, 512, 1024, 8, 4, 1, 0, 0, 0}; break;
    case 5:  J = TJob{p.w_out, (bf16_t*)(p.ws + WS_WO),   1024, 1024, 1024, 16, 4, 1, 0, 0, 0}; break;
    case 6:  J = TJob{p.w_eg, w1,                         256, 1024, 256, 16, 1, 32, 1, 262144, 524288}; break;
    case 7:  J = TJob{p.w_eu, w1 + 128 * 1024,            256, 1024, 256, 16, 1, 32, 1, 262144, 524288}; break;
    default: J = TJob{p.w_ed, (bf16_t*)(p.ws + WS_W2),    1024, 256, 1024, 4, 4, 32, 0, 262144, 262144}; break;
    }
    return J;
}
constexpr int NTJOBS = 9;
__device__ __forceinline__ int tjob_tiles(int j) {
    constexpr int t[NTJOBS] = {64, 32, 128, 16, 32, 64, 512, 512, 512};
    return t[j];
}
constexpr int P0_TILES = 64 + 32 + 128 + 16 + 32 + 64 + 512 + 512 + 512;
constexpr int P0_WUK = 128, P0_WF = 512, P0_PAD = 88, P0_WR = 48, P0_NORM = MPAD / 4;
constexpr int P0_WITEMS = P0_WF + P0_WUK + P0_PAD + P0_WR + P0_NORM;
constexpr int T_LD = 257;

struct TItem { const float* src; bf16_t* dst; int src_ld, dst_ld, N, k0, n0, split; };
__device__ __forceinline__ bool p0_titem(const Params& p, int it, TItem& T) {
    if (it >= P0_TILES) return false;
    int r = it, j = 0;
#pragma unroll 1
    for (; j < NTJOBS - 1; ++j) { const int n = tjob_tiles(j); if (r < n) break; r -= n; }
    const TJob J = tjob(p, j);
    const int per = J.ktiles * J.ntiles, bi = r / per, rr = r % per, kt = rr / J.ntiles, nt = rr % J.ntiles;
    T.src = J.src + (size_t)bi * J.sbs; T.dst = J.dst + (size_t)bi * J.dbs; T.src_ld = J.src_ld; T.dst_ld = J.dst_ld; T.N = J.N; T.k0 = kt * 64; T.n0 = nt * 256; T.split = J.split;
    return true;
}
__device__ __forceinline__ void p0_tload(const TItem& T, f32x4 (&v)[8], int tid) {
#pragma unroll
    for (int i = 0; i < 8; ++i) {
        const int kk = (tid >> 6) + 8 * i, n4 = (tid & 63) * 4;
        v[i] = (f32x4){0.f, 0.f, 0.f, 0.f};
        if (T.n0 + n4 < T.N) v[i] = *(const f32x4*)(T.src + (size_t)(T.k0 + kk) * T.src_ld + T.n0 + n4);
    }
}

__device__ __forceinline__ void p0_phase(const Params& p, LAS char* lds) {
    const int tid = threadIdx.x, wid = __builtin_amdgcn_readfirstlane(tid >> 6), lane = tid & 63, fr = lane & 15, fq = lane >> 4;
    MEAS_T0(34)
    {
        LAS float* tile = (LAS float*)lds;
        TItem T, Tn; f32x4 v[8];
        int it = blockIdx.x;
        bool have = p0_titem(p, it, T);
        if (have) p0_tload(T, v, tid);
        while (have) {
#pragma unroll
            for (int i = 0; i < 8; ++i) {
                const int kk = (tid >> 6) + 8 * i, n4 = (tid & 63) * 4;
                tile[kk * T_LD + n4 + 0] = v[i][0]; tile[kk * T_LD + n4 + 1] = v[i][1]; tile[kk * T_LD + n4 + 2] = v[i][2]; tile[kk * T_LD + n4 + 3] = v[i][3];
            }
            it += gridDim.x;
            const bool hn = p0_titem(p, it, Tn);
            if (hn) p0_tload(Tn, v, tid);
            __syncthreads();
#pragma unroll
            for (int c = 0; c < 4; ++c) {
                const int idx = tid + 512 * c, n = idx >> 3, kc = idx & 7;
                if (T.n0 + n < T.N) {
                    const LAS float* sp = tile + (kc * 8) * T_LD + n;
                    u32x4 o; o.x = cvt_pk_bf16(sp[0], sp[T_LD]); o.y = cvt_pk_bf16(sp[2 * T_LD], sp[3 * T_LD]); o.z = cvt_pk_bf16(sp[4 * T_LD], sp[5 * T_LD]); o.w = cvt_pk_bf16(sp[6 * T_LD], sp[7 * T_LD]);
                    const int nn = T.n0 + n, drow = T.split ? ((nn & 127) + (nn >> 7) * 256) : nn;
                    *(u32x4*)(T.dst + (size_t)drow * T.dst_ld + T.k0 + kc * 8) = o;
                }
            }
            __syncthreads();
            T = Tn; have = hn;
        }
    }
    MEAS_T1(34, p.ws)
    MEAS_T0(35)
    for (int it = blockIdx.x * 8 + wid; it < P0_WITEMS; it += gridDim.x * 8) {
        int r = it;
        if (r < P0_WF) {
            const int kt = r >> 4, nq = r & 15, k0 = kt * 16, g = k0 >> 7, n0 = nq * 64;
            f32x4 acc[4];
#pragma unroll
            for (int i = 0; i < 4; ++i) acc[i] = (f32x4){0.f, 0.f, 0.f, 0.f};
            const float* wp = p.w_pool + (size_t)(k0 + fr) * 128 + fq; const float* ps = p.pool_scale + g * 128 + fq;
            const float* wb = p.w_bp + (size_t)(g * 128 + fq) * 1024 + n0 + fr;
#pragma unroll 8
            for (int st = 0; st < 32; ++st) {
                const float a = wp[4 * st] * ps[4 * st];
#pragma unroll
                for (int i = 0; i < 4; ++i) acc[i] = __builtin_amdgcn_mfma_f32_16x16x4f32(a, wb[(size_t)(4 * st) * 1024 + i * 16], acc[i], 0, 0, 0);
            }
            bf16_t* wf = (bf16_t*)(p.ws + WS_WF);
#pragma unroll
            for (int i = 0; i < 4; ++i) st4bf(wf + (size_t)(n0 + 16 * i + fr) * 512 + k0 + 4 * fq, acc[i]);
            continue;
        }
        r -= P0_WF;
        if (r < P0_WUK) {
            const int o = r * 512 + lane * 8, h = o >> 13, c = (o >> 6) & 127, d = o & 63;
            const float* sp = p.w_uk + c * 512 + h * 64 + d;
            const f32x4 a = *(const f32x4*)sp, b = *(const f32x4*)(sp + 4);
            u32x4 w; w.x = cvt_pk_bf16(a[0], a[1]); w.y = cvt_pk_bf16(a[2], a[3]); w.z = cvt_pk_bf16(b[0], b[1]); w.w = cvt_pk_bf16(b[2], b[3]);
            *(u32x4*)((bf16_t*)(p.ws + WS_WUK) + o) = w;
            continue;
        }
        r -= P0_WUK;
        if (r < P0_PAD) {
            bf16_t* win = (bf16_t*)(p.ws + WS_WIN) + (size_t)(936 + r) * 1024;
            const u32x4 z = {0u, 0u, 0u, 0u};
            *(u32x4*)(win + lane * 8) = z; *(u32x4*)(win + 512 + lane * 8) = z;
            continue;
        }
        r -= P0_PAD;
        if (r < P0_WR) {
            bf16_t* wh = (bf16_t*)(p.ws + WS_WRH) + (size_t)r * 1024; bf16_t* wl = (bf16_t*)(p.ws + WS_WRL) + (size_t)r * 1024;
#pragma unroll 16
            for (int i = 0; i < 16; ++i) {
                const int k = lane + 64 * i;
                const float w = r < 4 ? p.w_gr[(size_t)k * 4 + r] : (r < 36 ? p.w_er[(size_t)k * 32 + (r - 4)] : 0.f);
                const unsigned h = cvt_pk_bf16(w, 0.f) & 0xffffu;
                wh[k] = (bf16_t)h; wl[k] = (bf16_t)(cvt_pk_bf16(w - bf_lo(h), 0.f) & 0xffffu);
            }
            continue;
        }
        r -= P0_WR;
        {
            const int R0 = r * 4;
            f32x4 v[4][4];
#pragma unroll
            for (int q = 0; q < 4; ++q) {
                const int R = R0 + q;
                if (R < MALL) {
                    const int b = R / TT, t = R - b * TT;
                    const float* src = (t < 16) ? (p.meta + (size_t)t * 1024) : (p.x + ((size_t)b * SEQ + (t - 16)) * 1024);
#pragma unroll
                    for (int j = 0; j < 4; ++j) v[q][j] = *(const f32x4*)(src + j * 256 + lane * 4);
                } else {
#pragma unroll
                    for (int j = 0; j < 4; ++j) v[q][j] = (f32x4){0.f, 0.f, 0.f, 0.f};
                }
            }
            f32x4 g[4];
#pragma unroll
            for (int j = 0; j < 4; ++j) g[j] = *(const f32x4*)(p.norm1_g + j * 256 + lane * 4);
#pragma unroll
            for (int q = 0; q < 4; ++q) {
                float ss = 0.f;
#pragma unroll
                for (int j = 0; j < 4; ++j) ss += v[q][j][0] * v[q][j][0] + v[q][j][1] * v[q][j][1] + v[q][j][2] * v[q][j][2] + v[q][j][3] * v[q][j][3];
                ss = wave_sum(ss);
                const float rstd = rsqrtf(ss * (1.f / 1024.f) + EPS);
                bf16_t* urow = (bf16_t*)(p.ws + WS_U) + (size_t)(R0 + q) * 1024;
#pragma unroll
                for (int j = 0; j < 4; ++j) st4bf(urow + j * 256 + lane * 4, v[q][j] * rstd * g[j]);
            }
        }
    }
    MEAS_T1(35, p.ws)
    __syncthreads();
}

namespace g8 {
constexpr int BM = 256, BK = 64, HALF = 128, HTB = HALF * BK * 2, STAGE_BYTES = 8 * HTB, NXCD = 8, WGM = 8;
__device__ __forceinline__ int lds_byte(int r, int c) { const int st = (r >> 4) * 2 + (c >> 5), rr = r & 15, cc = c & 31, ob = rr * 64 + cc * 2; return st * 1024 + (ob ^ (((ob >> 9) & 1) << 5)); }
__device__ __forceinline__ void stage_rc(int b, int& R, int& C) { const int st = b / 1024, sb = b % 1024, swz = sb ^ (((sb >> 9) & 1) << 5); R = (st >> 1) * 16 + swz / 64; C = (st & 1) * 32 + (swz % 64) / 2; }

struct Unit { const char* A; const char* B; int i0, i1, i2, i3; unsigned va[2][2]; };

struct TileOrder {
    int nM, nN, nwg, G, c;
    __device__ __forceinline__ void init(int nM_, int nN_, int G_, int c_) { nM = nM_; nN = nN_; nwg = nM * nN; G = G_; c = c_; }
    __device__ __forceinline__ bool tile(int i, int& pm, int& pn) const {
        const long L = (long)i * G + c; if (L >= nwg) return false;
        int wgid = (int)L; { const int q = nwg / NXCD, r = nwg % NXCD, xcd = wgid % NXCD, off = wgid / NXCD; wgid = (xcd < r ? xcd * (q + 1) : r * (q + 1) + (xcd - r) * q) + off; }
        const int nig = WGM * nN, gid = wgid / nig, fm = gid * WGM, gsz = (nM - fm) < WGM ? (nM - fm) : WGM;
        pm = fm + ((wgid % nig) % gsz); pn = (wgid % nig) / gsz; return true;
    }
};

template <class Epi, class Sched, bool GATHER, bool PERM = false>
__device__ __forceinline__ void gemm_phase(LAS char* lds, const int K, const Sched& S, const Epi& E) {
    const int tid = threadIdx.x, wid = __builtin_amdgcn_readfirstlane(tid >> 6), lane = tid & 63, wr = wid >> 2, wc = wid & 3, fr = lane & 15, fq = lane >> 4;
    const int nt = K / BK;
    unsigned voff[2], voffb[2];
#pragma unroll
    for (int i = 0; i < 2; ++i) { int R_, C_; stage_rc(tid * 16 + i * 8192, R_, C_); voff[i] = (unsigned)(R_ * K + C_) * 2u;
        const int rho = R_ & 31, Rb = PERM ? ((R_ & ~31) + 8 * ((rho & 15) >> 2) + 4 * (rho >> 4) + (rho & 3)) : R_; voffb[i] = (unsigned)(Rb * K + C_) * 2u; }
    const size_t kstep = (size_t)(BK * 2);
    const size_t hstep = (size_t)HALF * K * 2;
    const unsigned ldsw = (unsigned)wid * 1024u;
    const int aoff = lds_byte(wr * 64 + fr, fq * 8), boff = lds_byte(wc * 32 + fr, fq * 8);
#define G8_SA(b, h) (((b) * 2 + (h)) * HTB)
#define G8_SB(b, h) ((4 + (b) * 2 + (h)) * HTB)
#define G8_GLDS(bufoff, ptr, i_) __builtin_amdgcn_global_load_lds((const unsigned*)(ptr), (LAS unsigned*)(lds + (bufoff) + ldsw + (i_) * 8192), 16, 0, 0)
#define G8_STAGE_B(bufoff, gbase) do { _Pragma("unroll") for (int _i = 0; _i < 2; ++_i) G8_GLDS(bufoff, (const char*)(gbase) + voffb[_i], _i); } while (0)
#define G8_STAGE_A(bufoff, abase, vA, h) do { _Pragma("unroll") for (int _i = 0; _i < 2; ++_i) \
        G8_GLDS(bufoff, GATHER ? ((const char*)(abase) + (vA)[h][_i]) : ((const char*)(abase) + (size_t)(h) * hstep + voff[_i]), _i); } while (0)
#define G8_LDA(dst, b, h) do { _Pragma("unroll") for (int m = 0; m < 4; ++m) _Pragma("unroll") for (int k = 0; k < 2; ++k) dst[m][k] = *(const LAS bf16x8*)(lds + G8_SA(b, h) + aoff + m * 2048 + k * 1024); } while (0)
#define G8_LDB(dst, b, h) do { _Pragma("unroll") for (int n = 0; n < 2; ++n) _Pragma("unroll") for (int k = 0; k < 2; ++k) dst[n][k] = *(const LAS bf16x8*)(lds + G8_SB(b, h) + boff + n * 2048 + k * 1024); } while (0)
#define G8_MMA(ai, bj, At, Bt) do { __builtin_amdgcn_s_setprio(1); _Pragma("unroll") for (int m = 0; m < 4; ++m) _Pragma("unroll") for (int n = 0; n < 2; ++n) _Pragma("unroll") for (int k = 0; k < 2; ++k) \
        acc[ai][bj][m][n] = __builtin_amdgcn_mfma_f32_16x16x32_bf16(Bt[n][k], At[m][k], acc[ai][bj][m][n], 0, 0, 0); __builtin_amdgcn_s_setprio(0); } while (0)
#define G8_WAIT_V(n) asm volatile("s_waitcnt vmcnt(" #n ")" ::: "memory")
#define G8_WAIT_L(n) asm volatile("s_waitcnt lgkmcnt(" #n ")" ::: "memory")
#define G8_BAR __builtin_amdgcn_s_barrier()
#define G8_SCHED __builtin_amdgcn_sched_barrier(0)
    Unit cur, nxt; int ui = 0;
    cur.A = nullptr; cur.B = nullptr; cur.i0 = cur.i1 = cur.i2 = cur.i3 = 0; cur.va[0][0] = cur.va[0][1] = cur.va[1][0] = cur.va[1][1] = 0u; nxt = cur;
    if (!S.next(0, cur, tid)) return;
    S.a_ready(cur);
    f32x4 acc[2][2][4][2];
#pragma unroll
    for (int a = 0; a < 2; ++a)
#pragma unroll
        for (int b = 0; b < 2; ++b)
#pragma unroll
            for (int m = 0; m < 4; ++m)
#pragma unroll
                for (int n = 0; n < 2; ++n) acc[a][b][m][n] = (f32x4){0.f, 0.f, 0.f, 0.f};
    bf16x8 At[4][2], B0[2][2], B1[2][2];
    G8_STAGE_B(G8_SB(0, 0), cur.B); G8_STAGE_B(G8_SB(0, 1), cur.B + hstep); G8_STAGE_A(G8_SA(0, 0), cur.A, cur.va, 0); G8_STAGE_A(G8_SA(0, 1), cur.A, cur.va, 1);
    if (wr == 1) G8_BAR;
    G8_WAIT_V(2); G8_BAR;
    G8_STAGE_B(G8_SB(1, 0), cur.B + kstep); G8_STAGE_A(G8_SA(1, 0), cur.A + kstep, cur.va, 0); G8_STAGE_B(G8_SB(1, 1), cur.B + hstep + kstep);
    G8_WAIT_V(6); G8_BAR;
    for (;;) {
        const bool has_next = S.next(ui + 1, nxt, tid);
        if (!has_next) nxt = cur;
#pragma unroll 1
        for (int t = 0; t < nt; t += 2) {
            const bool last = (t == nt - 2);
            if (last && has_next) S.a_ready(nxt);
            const char* a1 = cur.A + (size_t)(t + 1) * kstep;
            const char* a2 = last ? nxt.A : cur.A + (size_t)(t + 2) * kstep; const char* b2 = last ? nxt.B : cur.B + (size_t)(t + 2) * kstep;
            const char* a3 = a2 + kstep; const char* b3 = b2 + kstep;
            G8_LDB(B0, 0, 0); G8_LDB(B1, 0, 1); G8_SCHED; G8_LDA(At, 0, 0); G8_STAGE_A(G8_SA(1, 1), a1, cur.va, 1);
            if (GATHER && last) {
#pragma unroll
                for (int h = 0; h < 2; ++h)
#pragma unroll
                    for (int i = 0; i < 2; ++i) cur.va[h][i] = nxt.va[h][i];
            }
            G8_WAIT_V(8); G8_WAIT_L(0); G8_BAR; G8_MMA(0, 0, At, B0); G8_MMA(0, 1, At, B1); G8_BAR; G8_SCHED;
            G8_LDA(At, 0, 1); G8_STAGE_B(G8_SB(0, 0), b2); G8_STAGE_B(G8_SB(0, 1), b2 + hstep); G8_STAGE_A(G8_SA(0, 0), a2, cur.va, 0);
            G8_WAIT_V(8); G8_WAIT_L(0); G8_BAR; G8_MMA(1, 0, At, B0); G8_MMA(1, 1, At, B1); G8_BAR; G8_SCHED;
            G8_LDB(B0, 1, 0); G8_LDB(B1, 1, 1); G8_SCHED; G8_LDA(At, 1, 0); G8_STAGE_A(G8_SA(0, 1), a2, cur.va, 1);
            G8_WAIT_V(8); G8_WAIT_L(0); G8_BAR; G8_MMA(0, 0, At, B0); G8_MMA(0, 1, At, B1); G8_BAR; G8_SCHED;
            G8_LDA(At, 1, 1); G8_STAGE_B(G8_SB(1, 0), b3); G8_STAGE_B(G8_SB(1, 1), b3 + hstep); G8_STAGE_A(G8_SA(1, 0), a3, cur.va, 0);
            G8_WAIT_V(8); G8_WAIT_L(0); G8_BAR; G8_MMA(1, 0, At, B0); G8_MMA(1, 1, At, B1); G8_BAR; G8_SCHED;
        }
        if (wr == 0) G8_BAR;
        bool keep = false;
        { int efr = fr, efq = fq; asm volatile("" : "+v"(efr), "+v"(efq));
          keep = E(acc, cur, wr, wc, efr, efq, lds + STAGE_BYTES); }
        if (!has_next) break;
        if (!keep) {
#pragma unroll
        for (int a = 0; a < 2; ++a)
#pragma unroll
            for (int b = 0; b < 2; ++b)
#pragma unroll
                for (int m = 0; m < 4; ++m)
#pragma unroll
                    for (int n = 0; n < 2; ++n) acc[a][b][m][n] = (f32x4){0.f, 0.f, 0.f, 0.f};
        }
        cur = nxt; ++ui;
        if (wr == 1) G8_BAR;
    }
    G8_WAIT_V(0);
    G8_BAR;
#undef G8_SA
#undef G8_SB
#undef G8_GLDS
#undef G8_STAGE_A
#undef G8_STAGE_B
#undef G8_LDA
#undef G8_LDB
#undef G8_MMA
#undef G8_WAIT_V
#undef G8_WAIT_L
#undef G8_BAR
#undef G8_SCHED
}
}
constexpr int GX_OFF = g8::STAGE_BYTES;

#define FOR_ACC(ai, bj, m, n) \
    _Pragma("unroll") for (int ai = 0; ai < 2; ++ai) _Pragma("unroll") for (int bj = 0; bj < 2; ++bj) \
    _Pragma("unroll") for (int m = 0; m < 4; ++m) _Pragma("unroll") for (int n = 0; n < 2; ++n)
__device__ __forceinline__ int vcu_id() { const int G = gridDim.x, bx = blockIdx.x; return (G % 8 == 0) ? (bx % 8) * (G / 8) + bx / 8 : bx; }

struct P1Sched {
    __device__ __forceinline__ void a_ready(const g8::Unit&) const {}
    g8::TileOrder T; const char* U; const char* W;
    __device__ __forceinline__ bool next(int i, g8::Unit& u, int) const {
        int pm, pn; if (!T.tile(i, pm, pn)) return false;
        u.A = U + (size_t)pm * 256 * 1024 * 2; u.B = W + (size_t)pn * 256 * 1024 * 2; u.i0 = pm; u.i1 = pn; return true;
    }
};
struct P1Epi {
    const Params* pp;
    __device__ __forceinline__ bool operator()(f32x4 (&acc)[2][2][4][2], const g8::Unit& u, int wr, int wc, int fr, int fq, LAS char* xl) const {
        const Params& p = *pp;
        bf16_t* Q = (bf16_t*)(p.ws + WS_Q); bf16_t* C = (bf16_t*)(p.ws + WS_C); bf16_t* IQ = (bf16_t*)(p.ws + WS_IQ); bf16_t* IK = (bf16_t*)(p.ws + WS_IK);
        float* IW = (float*)(p.ws + WS_IW); bf16_t* PV = (bf16_t*)(p.ws + WS_PV); bf16_t* GT = (bf16_t*)(p.ws + WS_GATES);
        const int pm = u.i0, pn = u.i1;
        const int rowb = pm * 256 + wr * 64 + fr, colb = wc * 32 + 4 * fq;
        if (pn < 2) {
            FOR_ACC(ai, bj, m, n) st4bf(Q + (size_t)(rowb + ai * 128 + m * 16) * 512 + pn * 256 + bj * 128 + colb + n * 16, acc[ai][bj][m][n]);
        } else if (pn == 2) {
            LAS float* part = (LAS float*)xl;
#pragma unroll
            for (int ai = 0; ai < 2; ++ai)
#pragma unroll
                for (int m = 0; m < 4; ++m) {
                    float s = 0.f;
#pragma unroll
                    for (int n = 0; n < 2; ++n) { const f32x4 v = acc[ai][0][m][n]; s += v[0] * v[0] + v[1] * v[1] + v[2] * v[2] + v[3] * v[3]; }
                    s += __shfl_xor(s, 16); s += __shfl_xor(s, 32);
                    if (fq == 0) part[(ai * 128 + wr * 64 + m * 16 + fr) * 4 + wc] = s;
                }
            __syncthreads();
#pragma unroll
            for (int ai = 0; ai < 2; ++ai)
#pragma unroll
                for (int m = 0; m < 4; ++m) {
                    const int lr = ai * 128 + wr * 64 + m * 16 + fr;
                    const f32x4 ps = *(LAS f32x4*)(part + lr * 4);
                    const float rstd = rsqrtf((ps[0] + ps[1] + ps[2] + ps[3]) * (1.f / 128.f) + EPS);
                    const size_t R = (size_t)(rowb + ai * 128 + m * 16);
#pragma unroll
                    for (int n = 0; n < 2; ++n) {
                        const f32x4 g = *(const f32x4*)(p.kv_norm_g + colb + n * 16);
                        st4bf(C + R * 128 + colb + n * 16, acc[ai][0][m][n] * rstd * g);
                        st4bf(IQ + R * 256 + colb + n * 16, acc[ai][1][m][n]);
                    }
                }
            __syncthreads();
        } else if (pn == 3) {
#pragma unroll
            for (int ai = 0; ai < 2; ++ai)
#pragma unroll
                for (int m = 0; m < 4; ++m) {
                    const size_t R = (size_t)(rowb + ai * 128 + m * 16);
#pragma unroll
                    for (int n = 0; n < 2; ++n) {
                        st4bf(IQ + R * 256 + 128 + colb + n * 16, acc[ai][0][m][n]);
                        if (wc == 0) st4bf(IK + R * 32 + n * 16 + 4 * fq, acc[ai][1][m][n]);
                        if (wc == 1 && n == 0 && fq < 2) *(f32x4*)(IW + R * 8 + 4 * fq) = acc[ai][1][m][n] * IDX_SCALE;
                    }
                }
        } else if (pn < 6) {
            FOR_ACC(ai, bj, m, n) st4bf(PV + (size_t)(rowb + ai * 128 + m * 16) * 512 + (pn - 4) * 256 + bj * 128 + colb + n * 16, acc[ai][bj][m][n]);
        } else {
            FOR_ACC(ai, bj, m, n) {
                f32x4 v = acc[ai][bj][m][n];
#pragma unroll
                for (int r = 0; r < 4; ++r) v[r] = __builtin_amdgcn_rcpf(1.f + __expf(-v[r]));
                st4bf(GT + (size_t)(rowb + ai * 128 + m * 16) * 2048 + (pn - 6) * 256 + bj * 128 + colb + n * 16, v);
            }
        }
            return false;
    }
};
__device__ __forceinline__ void p1_phase(const Params& p, LAS char* lds) {
    P1Sched S; S.T.init(MPAD / 256, INP / 256, gridDim.x, blockIdx.x); S.U = (const char*)(p.ws + WS_U); S.W = (const char*)(p.ws + WS_WIN);
    P1Epi E{&p};
    g8::gemm_phase<P1Epi, P1Sched, false>(lds, 1024, S, E);
}
constexpr int SC_STRIDE = 2068;
constexpr int SC_BYTES = 16 * SC_STRIDE * 4;
constexpr int MASK_OFF = SC_BYTES;
constexpr int QS_STRIDE = 136;
constexpr float DEFER_THR = 6.0f;

__device__ __forceinline__ int kv_off(int row, int ch) { return 256 * row + 16 * (ch ^ (((row & 3) << 2) | ((row >> 2) & 3))); }
__device__ __forceinline__ unsigned f2ord(float f) { const unsigned u = __float_as_uint(f); return (u & 0x80000000u) ? ~u : (u | 0x80000000u); }
__device__ __forceinline__ int wave_sum_dpp(int v) {
    v += __builtin_amdgcn_update_dpp(0, v, 0x111, 0xf, 0xf, false);
    v += __builtin_amdgcn_update_dpp(0, v, 0x112, 0xf, 0xf, false);
    v += __builtin_amdgcn_update_dpp(0, v, 0x114, 0xf, 0xf, false);
    v += __builtin_amdgcn_update_dpp(0, v, 0x118, 0xf, 0xf, false);
    v += __builtin_amdgcn_update_dpp(0, v, 0x142, 0xa, 0xf, false);
    v += __builtin_amdgcn_update_dpp(0, v, 0x143, 0xc, 0xf, false);
    return __builtin_amdgcn_readlane(v, 63);
}

__device__ __forceinline__ void attn_item(const Params& p, int b, int j, int half, LAS char* lds) {
    int tid_ = threadIdx.x; asm volatile("" : "+v"(tid_));
    const int tid = tid_, wid = __builtin_amdgcn_readfirstlane(tid >> 6), lane = tid & 63, fr = lane & 15, fq = lane >> 4;
    const int nadm = 16 + 64 * j;
    const int t0 = 16 + 64 * (j - 1) + 32 * half;
    const size_t Rq0 = (size_t)b * TT + t0, Rk0 = (size_t)b * TT;
    const bf16_t* Q = (const bf16_t*)(p.ws + WS_Q); const bf16_t* C = (const bf16_t*)(p.ws + WS_C); const bf16_t* IQ = (const bf16_t*)(p.ws + WS_IQ);
    const bf16_t* IK = (const bf16_t*)(p.ws + WS_IK); const float* IW = (const float*)(p.ws + WS_IW);
    LAS unsigned* maskw = (LAS unsigned*)(lds + MASK_OFF);
    const int h = wid;

    MEAS_T0(21)
    {
        const bf16_t* Wuk = (const bf16_t*)(p.ws + WS_WUK) + (size_t)h * 128 * 64;
        bf16x8 bq[2][2];
#pragma unroll
        for (int qt = 0; qt < 2; ++qt)
#pragma unroll
            for (int ks = 0; ks < 2; ++ks) bq[qt][ks] = *(const bf16x8*)(Q + (Rq0 + qt * 16 + fr) * 512 + h * 64 + ks * 32 + fq * 8);
        LAS bf16_t* qs = (LAS bf16_t*)lds + (size_t)h * 32 * QS_STRIDE;
#pragma unroll
        for (int ct = 0; ct < 8; ++ct) {
            const bf16x8 a0 = *(const bf16x8*)(Wuk + (ct * 16 + fr) * 64 + fq * 8), a1 = *(const bf16x8*)(Wuk + (ct * 16 + fr) * 64 + 32 + fq * 8);
#pragma unroll
            for (int qt = 0; qt < 2; ++qt) {
                f32x4 d = {0.f, 0.f, 0.f, 0.f};
                d = mfma16(a0, bq[qt][0], d); d = mfma16(a1, bq[qt][1], d);
                d = d * (ATTN_SCALE * LOG2E);
                u32x2 o; o.x = cvt_pk_bf16(d[0], d[1]); o.y = cvt_pk_bf16(d[2], d[3]);
                *(LAS u32x2*)(qs + (qt * 16 + fr) * QS_STRIDE + ct * 16 + 4 * fq) = o;
            }
        }
    }
    __syncthreads();
    bf16x8 qf[8];
    {
        const LAS bf16_t* qs = (const LAS bf16_t*)lds + (size_t)h * 32 * QS_STRIDE + (lane & 31) * QS_STRIDE + (lane >> 5) * 8;
#pragma unroll
        for (int ks = 0; ks < 8; ++ks) qf[ks] = *(const LAS bf16x8*)(qs + ks * 16);
    }
    __syncthreads();

    MEAS_T1(21, p.ws)
    MEAS_T0(22)
    if (nadm <= 256) {
        for (int idx = tid; idx < 32 * 66; idx += 512) {
            const int w = idx % 66; const int lo = w * 32;
            unsigned v = 0u;
            if (lo + 32 <= nadm) v = 0xffffffffu; else if (lo < nadm) v = (1u << (nadm - lo)) - 1u;
            maskw[idx] = v;
        }
    } else {
        LAS float* sc = (LAS float*)lds;
        const int nkt = nadm >> 4;
        const int ni = (nadm + 63) >> 6;
#pragma unroll 1
        for (int sub = 0; sub < 2; ++sub) {
            MEAS_T0(25)
            {
                bf16x8 bq[8]; float wq[8];
                const size_t Rq = Rq0 + sub * 16 + fr;
#pragma unroll
                for (int hh = 0; hh < 8; ++hh) { bq[hh] = *(const bf16x8*)(IQ + Rq * 256 + hh * 32 + fq * 8); }
                { const f32x4 w0 = *(const f32x4*)(IW + Rq * 8), w1 = *(const f32x4*)(IW + Rq * 8 + 4);
                  wq[0] = w0[0]; wq[1] = w0[1]; wq[2] = w0[2]; wq[3] = w0[3]; wq[4] = w1[0]; wq[5] = w1[1]; wq[6] = w1[2]; wq[7] = w1[3]; }
                const bf16_t* ikp = IK + (Rk0 + fr) * 32 + fq * 8;
#pragma unroll 1
                for (int kb = wid; kb < nkt; kb += 64) {
                    bf16x8 a[8];
#pragma unroll
                    for (int i = 0; i < 8; ++i) { const int kt = kb + 8 * i; a[i] = *(const bf16x8*)(ikp + (size_t)(kt < nkt ? kt : kb) * 16 * 32); }
#pragma unroll
                    for (int i = 0; i < 8; ++i) {
                        const int kt = kb + 8 * i;
                        if (kt < nkt) {
                            f32x4 s = {0.f, 0.f, 0.f, 0.f};
#pragma unroll
                            for (int hh = 0; hh < 8; ++hh) {
                                f32x4 d = {0.f, 0.f, 0.f, 0.f};
                                d = mfma16(a[i], bq[hh], d);
#pragma unroll
                                for (int r = 0; r < 4; ++r) { const int di = __float_as_int(d[r]); s[r] += __int_as_float(di > 0 ? di : 0) * wq[hh]; }
                            }
                            *(LAS f32x4*)(sc + fr * SC_STRIDE + kt * 16 + 4 * fq) = s;
                        }
                    }
                }
            }
            __syncthreads();
            MEAS_T1(25, p.ws)
            MEAS_T0(26)
#pragma unroll 1
            for (int qq = 0; qq < 2; ++qq) {
                const int ql = 2 * wid + qq;
                unsigned key[33];
                int nadm_q = nadm; asm volatile("" : "+s"(nadm_q));
#pragma unroll
                for (int i = 0; i < 33; ++i) { const int k = lane + 64 * i; const unsigned o = f2ord(sc[ql * SC_STRIDE + k]); key[i] = (k < nadm_q) ? o : 0u; }
                unsigned prefix = 0u; bool exact = false;
#pragma unroll 1
                for (int bit = 31; bit >= 0; --bit) {
                    const unsigned cand = prefix | (1u << bit);
                    int c = 0;
#pragma unroll
                    for (int g = 0; g < 33; g += 8)
                        if (g < ni) {
#pragma unroll
                            for (int i = g; i < g + 8 && i < 33; ++i) c += (key[i] >= cand) ? 1 : 0;
                        }
                    c = wave_sum_dpp(c);
                    if (c >= 256) prefix = cand;
                    if (c == 256) { exact = true; break; }
                }
                int need = 0;
                if (!exact) {
                    int cg = 0;
#pragma unroll
                    for (int i = 0; i < 33; ++i) cg += (key[i] > prefix) ? 1 : 0;
                    need = 256 - wave_sum_dpp(cg);
                }
                int mlo = 0, mhi = 0;
                if (exact) {
#pragma unroll
                    for (int g = 0; g < 33; g += 8)
                        if (g < ni) {
#pragma unroll
                            for (int i = g; i < g + 8 && i < 33; ++i) {
                                const unsigned long long bs = __ballot(key[i] >= prefix);
                                mlo = (lane == i) ? (int)(unsigned)bs : mlo; mhi = (lane == i) ? (int)(unsigned)(bs >> 32) : mhi;
                            }
                        }
                } else {
                    int running = 0;
                    const unsigned long long lt = (1ull << lane) - 1ull;
#pragma unroll
                    for (int i = 0; i < 33; ++i) {
                        const bool eq = key[i] == prefix;
                        const unsigned long long be = __ballot(eq);
                        const int rank = running + __popcll(be & lt);
                        const bool sel = (key[i] > prefix) || (eq && rank < need);
                        running += __popcll(be);
                        const unsigned long long bs = __ballot(sel);
                        mlo = (lane == i) ? (int)(unsigned)bs : mlo; mhi = (lane == i) ? (int)(unsigned)(bs >> 32) : mhi;
                        __builtin_amdgcn_sched_barrier(0);
                    }
                }
                if (lane < 33) { u32x2 mw; mw.x = (unsigned)mlo; mw.y = (unsigned)mhi; *(LAS u32x2*)(maskw + (sub * 16 + ql) * 66 + 2 * lane) = mw; }
            }
            MEAS_T1(26, p.ws)
            __syncthreads();
        }
    }
    __syncthreads();

    MEAS_T1(22, p.ws)
    MEAS_T0(23)
    const int ntile = (nadm + 63) >> 6;
    f32x16 O[4];
#pragma unroll
    for (int mt = 0; mt < 4; ++mt)
#pragma unroll
        for (int r = 0; r < 16; ++r) O[mt][r] = 0.f;
    float mrun = 0.f, lrun = 0.f;
    {
        const bf16_t* kvsrc = C + (Rk0 + (tid >> 4)) * 128 + (tid & 15) * 8;
        const int kvdst0 = kv_off(tid >> 4, tid & 15), kvdst1 = kv_off((tid >> 4) + 32, tid & 15);
        u32x4 rr0 = *(const u32x4*)kvsrc, rr1 = *(const u32x4*)(kvsrc + 32 * 128);
        *(LAS u32x4*)(lds + kvdst0) = rr0; *(LAS u32x4*)(lds + kvdst1) = rr1;
        __syncthreads();
        const int hq = lane >> 5, ql = lane & 31;
        const int tg = lane >> 4, ti = lane & 15, tq = ti >> 2, tp = ti & 3;
#pragma unroll 1
        for (int T = 0; T < ntile; ++T) {
            const bool more = T + 1 < ntile;
            if (more) { rr0 = *(const u32x4*)(kvsrc + (size_t)(T + 1) * 64 * 128); rr1 = *(const u32x4*)(kvsrc + (size_t)(T + 1) * 64 * 128 + 32 * 128); }
            LAS char* kb = lds + (T & 1) * 16384;
            const u32x2 mw2 = *(LAS u32x2*)(maskw + ql * 66 + 2 * T);
            const float nm = -mrun;
            f32x16 S[2];
#pragma unroll
            for (int kh = 0; kh < 2; ++kh) {
                const int mw = (int)((kh ? mw2.y : mw2.x) >> (4 * hq));
#pragma unroll
                for (int r = 0; r < 16; ++r) {
                    const unsigned m = (unsigned)__builtin_amdgcn_sbfe(mw, (r & 3) + 8 * (r >> 2), 1);
                    S[kh][r] = __uint_as_float((__float_as_uint(nm) & m) | (0xf149f2cau & ~m));
                }
#pragma unroll
                for (int ks = 0; ks < 8; ++ks) {
                    const bf16x8 a = *(LAS bf16x8*)(kb + kv_off(32 * kh + ql, 2 * ks + hq));
                    S[kh] = mfma32(a, qf[ks], S[kh]);
                }
            }
            float mx = -3e38f;
#pragma unroll
            for (int kh = 0; kh < 2; ++kh)
#pragma unroll
                for (int r = 0; r < 16; r += 2) mx = fmaxf(fmaxf(mx, S[kh][r]), S[kh][r + 1]);
            mx = fmaxf(mx, __shfl_xor(mx, 32));
            if (__any(mx > DEFER_THR)) {
                const float dm = fmaxf(mx, 0.f);
                const float alpha = __builtin_amdgcn_exp2f(-dm);
                lrun *= alpha; mrun += dm;
#pragma unroll
                for (int mt = 0; mt < 4; ++mt)
#pragma unroll
                    for (int r = 0; r < 16; ++r) O[mt][r] *= alpha;
#pragma unroll
                for (int kh = 0; kh < 2; ++kh)
#pragma unroll
                    for (int r = 0; r < 16; ++r) S[kh][r] -= dm;
            }
            float rs0 = 0.f, rs1 = 0.f;
#pragma unroll
            for (int kh = 0; kh < 2; ++kh)
#pragma unroll
                for (int r = 0; r < 16; r += 2) { S[kh][r] = __builtin_amdgcn_exp2f(S[kh][r]); S[kh][r + 1] = __builtin_amdgcn_exp2f(S[kh][r + 1]); rs0 += S[kh][r]; rs1 += S[kh][r + 1]; }
            float rs = rs0 + rs1;
            rs += __shfl_xor(rs, 32);
            lrun += rs;
            bf16x8 pf[4];
#pragma unroll
            for (int s2 = 0; s2 < 4; ++s2) {
                const int kh = s2 >> 1, o = 8 * (s2 & 1);
                u32x4 w;
                w.x = cvt_pk_bf16(S[kh][o + 0], S[kh][o + 1]); w.y = cvt_pk_bf16(S[kh][o + 2], S[kh][o + 3]);
                w.z = cvt_pk_bf16(S[kh][o + 4], S[kh][o + 5]); w.w = cvt_pk_bf16(S[kh][o + 6], S[kh][o + 7]);
                pf[s2] = __builtin_bit_cast(bf16x8, w);
            }
#pragma unroll
            for (int mt = 0; mt < 4; ++mt)
#pragma unroll
                for (int s2 = 0; s2 < 4; ++s2) {
                    const int colb = 32 * mt + 16 * (tg & 1) + 4 * tp;
                    const int row1 = 16 * s2 + 4 * (tg >> 1) + tq;
                    const s16x4 v0 = __builtin_amdgcn_ds_read_tr16_b64_v4i16((LAS s16x4*)(kb + kv_off(row1, colb >> 3) + (colb & 7) * 2));
                    const s16x4 v1 = __builtin_amdgcn_ds_read_tr16_b64_v4i16((LAS s16x4*)(kb + kv_off(row1 + 8, colb >> 3) + (colb & 7) * 2));
                    bf16x8 a; a[0] = v0[0]; a[1] = v0[1]; a[2] = v0[2]; a[3] = v0[3]; a[4] = v1[0]; a[5] = v1[1]; a[6] = v1[2]; a[7] = v1[3];
                    O[mt] = mfma32(a, pf[s2], O[mt]);
                }
            if (more) { LAS char* nb = lds + ((T + 1) & 1) * 16384; *(LAS u32x4*)(nb + kvdst0) = rr0; *(LAS u32x4*)(nb + kvdst1) = rr1; }
            __syncthreads();
        }
    }
    MEAS_T1(23, p.ws)
    MEAS_T0(24)
    {
        const float inv = 1.f / lrun;
        const int hq = lane >> 5, ql = lane & 31;
        LAS bf16_t* os = (LAS bf16_t*)(lds + 32768) + (size_t)h * 32 * QS_STRIDE;
#pragma unroll
        for (int mt = 0; mt < 4; ++mt)
#pragma unroll
            for (int rg = 0; rg < 4; ++rg) {
                u32x2 o; o.x = cvt_pk_bf16(O[mt][4 * rg] * inv, O[mt][4 * rg + 1] * inv); o.y = cvt_pk_bf16(O[mt][4 * rg + 2] * inv, O[mt][4 * rg + 3] * inv);
                *(LAS u32x2*)(os + ql * QS_STRIDE + 32 * mt + 8 * rg + 4 * hq) = o;
            }
        __syncthreads();
        const bf16_t* Wuv = (const bf16_t*)(p.ws + WS_WUV) + (size_t)h * 64 * 128;
        bf16_t* AT = (bf16_t*)(p.ws + WS_ATTN);
        const size_t n0 = (size_t)b * SEQ + (t0 - 16);
        bf16x8 bo[2][4];
#pragma unroll
        for (int qt = 0; qt < 2; ++qt)
#pragma unroll
            for (int ks = 0; ks < 4; ++ks) bo[qt][ks] = *(LAS bf16x8*)(os + (qt * 16 + fr) * QS_STRIDE + ks * 32 + fq * 8);
#pragma unroll
        for (int dt = 0; dt < 4; ++dt) {
            bf16x8 a[4];
#pragma unroll
            for (int ks = 0; ks < 4; ++ks) a[ks] = *(const bf16x8*)(Wuv + (dt * 16 + fr) * 128 + ks * 32 + fq * 8);
#pragma unroll
            for (int qt = 0; qt < 2; ++qt) {
                f32x4 d = {0.f, 0.f, 0.f, 0.f};
#pragma unroll
                for (int ks = 0; ks < 4; ++ks) d = mfma16(a[ks], bo[qt][ks], d);
                st4bf(AT + (n0 + qt * 16 + fr) * 512 + h * 64 + dt * 16 + 4 * fq, d);
            }
        }
    }
    __syncthreads();
    MEAS_T1(24, p.ws)
}

__device__ __forceinline__ void p2_phase(const Params& p, LAS char* lds) {
    const int tid = threadIdx.x;
    {
        const bf16_t* PV = (const bf16_t*)(p.ws + WS_PV); bf16_t* DD = (bf16_t*)(p.ws + WS_DD);
        for (int rc = blockIdx.x; rc < NTOK / 64; rc += gridDim.x) {
            const int n0 = rc * 64, b = n0 >> 11, s0 = n0 & 2047;
            const size_t R0 = (size_t)b * TT + 16 + s0 - 15;
            for (int idx = tid; idx < 79 * 64; idx += 512) *(LAS u32x4*)(lds + idx * 16) = *(const u32x4*)(PV + R0 * 512 + (size_t)idx * 8);
            __syncthreads();
#pragma unroll 1
            for (int it = 0; it < 8; ++it) {
                const int idx = tid + 512 * it, r = idx >> 6, ch8 = idx & 63;
                const int g = ch8 >> 4, w = 2 << g;
                float a[8];
#pragma unroll
                for (int e = 0; e < 8; ++e) a[e] = 0.f;
                const LAS char* src = lds + ((r + 15) * 64 + ch8) * 16;
                const u32x4 self = *(const LAS u32x4*)src;
                for (int i = 0; i < w; ++i) {
                    const u32x4 v = *(const LAS u32x4*)(src - i * 1024);
                    a[0] += bf_lo(v.x); a[1] += bf_hi(v.x); a[2] += bf_lo(v.y); a[3] += bf_hi(v.y); a[4] += bf_lo(v.z); a[5] += bf_hi(v.z); a[6] += bf_lo(v.w); a[7] += bf_hi(v.w);
                }
                const float iw = 1.f / (float)w;
                u32x4 o;
                o.x = cvt_pk_bf16(a[0] * iw - bf_lo(self.x), a[1] * iw - bf_hi(self.x)); o.y = cvt_pk_bf16(a[2] * iw - bf_lo(self.y), a[3] * iw - bf_hi(self.y));
                o.z = cvt_pk_bf16(a[4] * iw - bf_lo(self.z), a[5] * iw - bf_hi(self.z)); o.w = cvt_pk_bf16(a[6] * iw - bf_lo(self.w), a[7] * iw - bf_hi(self.w));
                *(u32x4*)(DD + (size_t)(n0 + r) * 512 + ch8 * 8) = o;
            }
            __syncthreads();
        }
    }
    for (int x = blockIdx.x; x < 256; x += gridDim.x) {
        const int b = x & 7, r = x >> 3;
#pragma unroll 1
        for (int rep = 0; rep < 2; ++rep) attn_item(p, b, rep == 0 ? 32 - (r >> 1) : 1 + (r >> 1), r & 1, lds);
    }
}

__device__ __forceinline__ void wave_arrive(int* cnt) { asm volatile("s_waitcnt vmcnt(0)" ::: "memory"); if ((threadIdx.x & 63) == 0) __hip_atomic_fetch_add(cnt, 1, __ATOMIC_RELAXED, __HIP_MEMORY_SCOPE_AGENT); }
__device__ __forceinline__ void panel_wait(int* cnt, int want) {
    if (__builtin_amdgcn_readfirstlane(threadIdx.x >> 6) == 0) {
        unsigned sp = 0;
        while (__hip_atomic_load(cnt, __ATOMIC_RELAXED, __HIP_MEMORY_SCOPE_AGENT) < want) { __builtin_amdgcn_s_sleep(8); if (++sp > (1u << 21)) break; }
        __builtin_amdgcn_fence(__ATOMIC_ACQUIRE, "agent");
        asm volatile("s_waitcnt vmcnt(0)" ::: "memory");
    }
    __builtin_amdgcn_s_barrier();
}
__device__ __forceinline__ void st8bf_sc1(const __amdgpu_buffer_rsrc_t rsrc, size_t elem_off, f32x4 a, f32x4 b) {
    u32x4 o; o[0] = cvt_pk_bf16(a[0], a[1]); o[1] = cvt_pk_bf16(a[2], a[3]); o[2] = cvt_pk_bf16(b[0], b[1]); o[3] = cvt_pk_bf16(b[2], b[3]);
    __builtin_amdgcn_raw_buffer_store_b128(o, rsrc, (int)(elem_off * 2), 0, 16);
}

struct P3Sched {
    __device__ __forceinline__ void a_ready(const g8::Unit&) const {}
    g8::TileOrder T; const char *AT, *DD, *WA, *WF;
    __device__ __forceinline__ bool next(int i, g8::Unit& u, int) const {
        int pm, pn; if (!T.tile(i >> 1, pm, pn)) return false;
        const int br = i & 1;
        u.A = (br ? DD : AT) + (size_t)pm * 256 * 512 * 2; u.B = (br ? WF : WA) + (size_t)pn * 256 * 512 * 2; u.i0 = pm; u.i1 = pn; u.i2 = br; return true;
    }
};
struct P3Epi {
    const Params* pp;
    __device__ __forceinline__ bool operator()(f32x4 (&acc)[2][2][4][2], const g8::Unit& u, int wr, int wc, int fr, int fq, LAS char*) const {
        const Params& p = *pp;
        const bf16_t* GT = (const bf16_t*)(p.ws + WS_GATES);
        const __amdgpu_buffer_rsrc_t rs = __builtin_amdgcn_make_buffer_rsrc((void*)(p.ws + WS_U), 0, (int)((size_t)NTOK * 1024 * 2), 0x00020000);
        const int rowb = u.i0 * 256 + wr * 64 + fr, colb = u.i1 * 256 + wc * 32 + 8 * fq, br = u.i2;
#pragma unroll
        for (int ai = 0; ai < 2; ++ai)
#pragma unroll
            for (int bj = 0; bj < 2; ++bj)
#pragma unroll
                for (int m = 0; m < 4; ++m) {
                    const int nrow = rowb + ai * 128 + m * 16, col = colb + bj * 128;
                    const size_t R = (size_t)nrow + 16 + 16 * (nrow >> 11);
                    const u32x4 gp = *(const u32x4*)(GT + R * 2048 + 1024 + col);
                    f32x4 v0 = acc[ai][bj][m][0], v1 = acc[ai][bj][m][1];
                    if (br == 0) {
                        const u32x4 ga = *(const u32x4*)(GT + R * 2048 + col);
                        v0[0] *= bf_lo(ga[0]) * __builtin_amdgcn_rcpf(bf_lo(gp[0])); v0[1] *= bf_hi(ga[0]) * __builtin_amdgcn_rcpf(bf_hi(gp[0]));
                        v0[2] *= bf_lo(ga[1]) * __builtin_amdgcn_rcpf(bf_lo(gp[1])); v0[3] *= bf_hi(ga[1]) * __builtin_amdgcn_rcpf(bf_hi(gp[1]));
                        v1[0] *= bf_lo(ga[2]) * __builtin_amdgcn_rcpf(bf_lo(gp[2])); v1[1] *= bf_hi(ga[2]) * __builtin_amdgcn_rcpf(bf_hi(gp[2]));
                        v1[2] *= bf_lo(ga[3]) * __builtin_amdgcn_rcpf(bf_lo(gp[3])); v1[3] *= bf_hi(ga[3]) * __builtin_amdgcn_rcpf(bf_hi(gp[3]));
                        acc[ai][bj][m][0] = v0; acc[ai][bj][m][1] = v1;
                    } else {
                        v0[0] *= bf_lo(gp[0]); v0[1] *= bf_hi(gp[0]); v0[2] *= bf_lo(gp[1]); v0[3] *= bf_hi(gp[1]);
                        v1[0] *= bf_lo(gp[2]); v1[1] *= bf_hi(gp[2]); v1[2] *= bf_lo(gp[3]); v1[3] *= bf_hi(gp[3]);
                        st8bf_sc1(rs, (size_t)nrow * 1024 + col, v0, v1);
                    }
                }
        if (br) wave_arrive((int*)(p.ws + WS_READY3) + u.i0);
        return br == 0;
    }
};
__device__ __forceinline__ void p3_phase(const Params& p, LAS char* lds) {
    P3Sched S; S.T.init(NTOK / 256, 4, gridDim.x, blockIdx.x);
    S.AT = (const char*)(p.ws + WS_ATTN); S.DD = (const char*)(p.ws + WS_DD); S.WA = (const char*)(p.ws + WS_WA); S.WF = (const char*)(p.ws + WS_WF);
    P3Epi E{&p};
    g8::gemm_phase<P3Epi, P3Sched, false, true>(lds, 512, S, E);
}

struct P4Sched {
    g8::TileOrder T; const char *MG, *WO; int* ready3;
    __device__ __forceinline__ void a_ready(const g8::Unit& u) const { panel_wait(ready3 + u.i0, 32); }
    __device__ __forceinline__ bool next(int i, g8::Unit& u, int) const {
        int pm, pn; if (!T.tile(i, pm, pn)) return false;
        u.A = MG + (size_t)pm * 256 * 1024 * 2; u.B = WO + (size_t)pn * 256 * 1024 * 2; u.i0 = pm; u.i1 = pn; return true;
    }
};
struct P4Epi {
    const Params* pp;
    __device__ __forceinline__ bool operator()(f32x4 (&acc)[2][2][4][2], const g8::Unit& u, int wr, int wc, int fr, int fq, LAS char*) const {
        const Params& p = *pp;
        const __amdgpu_buffer_rsrc_t rs = __builtin_amdgcn_make_buffer_rsrc((void*)(p.ws + WS_H2), 0, (int)((size_t)NTOK * 1024 * 2), 0x00020000);
        const int rowb = u.i0 * 256 + wr * 64 + fr, colb = u.i1 * 256 + wc * 32 + 8 * fq;
#pragma unroll
        for (int ai = 0; ai < 2; ++ai)
#pragma unroll
            for (int bj = 0; bj < 2; ++bj)
#pragma unroll
                for (int m = 0; m < 4; ++m) {
                    const size_t off = (size_t)(rowb + ai * 128 + m * 16) * 1024 + colb + bj * 128;
                    st8bf_sc1(rs, off, *(const f32x4*)(p.x + off) + acc[ai][bj][m][0], *(const f32x4*)(p.x + off + 4) + acc[ai][bj][m][1]);
                }
        wave_arrive((int*)(p.ws + WS_READY4) + u.i0);
        return false;
    }
};
__device__ __forceinline__ void p4_phase(const Params& p, LAS char* lds) {
    P4Sched S; S.T.init(NTOK / 256, 4, gridDim.x, blockIdx.x); S.MG = (const char*)(p.ws + WS_U); S.WO = (const char*)(p.ws + WS_WO); S.ready3 = (int*)(p.ws + WS_READY3);
    P4Epi E{&p};
    g8::gemm_phase<P4Epi, P4Sched, false, true>(lds, 1024, S, E);
}

constexpr int P5_USTR = 1032;
constexpr int P5_ULO = 32 * P5_USTR * 2;
constexpr int P5_PART = 2 * P5_ULO;
constexpr int P5_MISC = P5_PART + 4 * 48 * 32 * 4;
__device__ __forceinline__ void p5_phase(const Params& p, LAS char* lds) {
    const int tid = threadIdx.x, wid = __builtin_amdgcn_readfirstlane(tid >> 6), lane = tid & 63, fr0 = lane & 15, fq0 = lane >> 4;
    LAS bf16_t* Uhi = (LAS bf16_t*)lds; LAS bf16_t* Ulo = (LAS bf16_t*)(lds + P5_ULO);
    LAS float* part = (LAS float*)(lds + P5_PART);
    LAS int* lcnt = (LAS int*)(lds + P5_MISC);
    LAS int* lbase = lcnt + 32;
    LAS int* tk_e = lbase + 32;
    LAS int* tk_r = tk_e + 128;
    LAS float* tk_w = (LAS float*)(tk_r + 128);
    bf16_t* U2 = (bf16_t*)(p.ws + WS_U);
    const bf16_t* WRH = (const bf16_t*)(p.ws + WS_WRH); const bf16_t* WRL = (const bf16_t*)(p.ws + WS_WRL);
    int* cnt = (int*)(p.ws + WS_CNT); int* list = (int*)(p.ws + WS_LIST); float* wts = (float*)(p.ws + WS_WTS); int* tokrow = (int*)(p.ws + WS_TOKROW);
    for (int chunk = blockIdx.x; chunk < NTOK / 64; chunk += gridDim.x) {
        panel_wait((int*)(p.ws + WS_READY4) + (chunk >> 2), 32);
        if (tid < 32) lcnt[tid] = 0;
        f32x4 gg[4];
#pragma unroll
        for (int j = 0; j < 4; ++j) gg[j] = *(const f32x4*)(p.norm2_g + j * 256 + lane * 4);
#pragma unroll 1
        for (int pass = 0; pass < 2; ++pass) {
            const int tb0 = chunk * 64 + pass * 32;
            f32x4 v[4][4];
#pragma unroll
            for (int t = 0; t < 4; ++t)
#pragma unroll
                for (int j = 0; j < 4; ++j) { const u32x2 hb = *(const u32x2*)((const bf16_t*)(p.ws + WS_H2) + (size_t)(tb0 + wid * 4 + t) * 1024 + j * 256 + lane * 4);
                    v[t][j] = (f32x4){bf_lo(hb.x), bf_hi(hb.x), bf_lo(hb.y), bf_hi(hb.y)}; }
#pragma unroll
            for (int t = 0; t < 4; ++t) {
                float ss = 0.f;
#pragma unroll
                for (int j = 0; j < 4; ++j) ss += v[t][j][0] * v[t][j][0] + v[t][j][1] * v[t][j][1] + v[t][j][2] * v[t][j][2] + v[t][j][3] * v[t][j][3];
                ss = wave_sum(ss);
                const float rstd = rsqrtf(ss * (1.f / 1024.f) + EPS);
                const int tl = wid * 4 + t;
#pragma unroll
                for (int j = 0; j < 4; ++j) {
                    const f32x4 u = v[t][j] * rstd * gg[j];
                    u32x2 hi; hi.x = cvt_pk_bf16(u[0], u[1]); hi.y = cvt_pk_bf16(u[2], u[3]);
                    u32x2 lo; lo.x = cvt_pk_bf16(u[0] - bf_lo(hi.x), u[1] - bf_hi(hi.x)); lo.y = cvt_pk_bf16(u[2] - bf_lo(hi.y), u[3] - bf_hi(hi.y));
                    *(u32x2*)(U2 + (size_t)(tb0 + tl) * 1024 + j * 256 + lane * 4) = hi;
                    *(LAS u32x2*)(Uhi + tl * P5_USTR + j * 256 + lane * 4) = hi;
                    *(LAS u32x2*)(Ulo + tl * P5_USTR + j * 256 + lane * 4) = lo;
                }
            }
            __syncthreads();
            {
                const int tw = wid & 1, kq = wid >> 1;
                int fr = fr0, fq = fq0; asm volatile("" : "+v"(fr), "+v"(fq));
                f32x4 acc[3];
#pragma unroll
                for (int ot = 0; ot < 3; ++ot) acc[ot] = (f32x4){0.f, 0.f, 0.f, 0.f};
                const LAS bf16_t* bh = Uhi + (tw * 16 + fr) * P5_USTR + kq * 256 + fq * 8;
                const LAS bf16_t* bl = Ulo + (tw * 16 + fr) * P5_USTR + kq * 256 + fq * 8;
                const bf16_t* ah = WRH + (size_t)fr * 1024 + kq * 256 + fq * 8;
                const bf16_t* al = WRL + (size_t)fr * 1024 + kq * 256 + fq * 8;
#pragma unroll 2
                for (int ks = 0; ks < 8; ++ks) {
                    const bf16x8 bhi = *(const LAS bf16x8*)(bh + ks * 32), blo = *(const LAS bf16x8*)(bl + ks * 32);
#pragma unroll
                    for (int ot = 0; ot < 3; ++ot) {
                        const bf16x8 ahi = *(const bf16x8*)(ah + (size_t)ot * 16 * 1024 + ks * 32), alo = *(const bf16x8*)(al + (size_t)ot * 16 * 1024 + ks * 32);
                        acc[ot] = mfma16(ahi, bhi, acc[ot]); acc[ot] = mfma16(alo, bhi, acc[ot]); acc[ot] = mfma16(ahi, blo, acc[ot]);
                    }
                }
#pragma unroll
                for (int ot = 0; ot < 3; ++ot)
#pragma unroll
                    for (int r = 0; r < 4; ++r) part[(kq * 48 + ot * 16 + 4 * fq + r) * 32 + tw * 16 + fr] = acc[ot][r];
            }
            __syncthreads();
            if (tid < 32) {
                float L[36];
                int tq = tid; asm volatile("" : "+v"(tq));
                const LAS float* pt = part + tq;
#pragma unroll
                for (int o = 0; o < 36; ++o) L[o] = (pt[o * 32] + pt[(48 + o) * 32]) + (pt[(96 + o) * 32] + pt[(144 + o) * 32]);
                float gl[4];
#pragma unroll
                for (int g = 0; g < 4; ++g) gl[g] = L[g] + p.b_gr[g];
                int gs = 0; float gm = gl[0];
#pragma unroll
                for (int g = 1; g < 4; ++g) if (gl[g] > gm) { gm = gl[g]; gs = g; }
                float gsum = 0.f;
#pragma unroll
                for (int g = 0; g < 4; ++g) gsum += __expf(gl[g] - gm);
                const float pg = 1.f / gsum;
                float el[8];
#pragma unroll
                for (int e = 0; e < 8; ++e) {
                    const float l0 = L[4 + e] + p.b_er[e], l1 = L[12 + e] + p.b_er[8 + e], l2 = L[20 + e] + p.b_er[16 + e], l3 = L[28 + e] + p.b_er[24 + e];
                    el[e] = gs == 0 ? l0 : (gs == 1 ? l1 : (gs == 2 ? l2 : l3));
                }
                int i1 = 0; float v1 = el[0];
#pragma unroll
                for (int e = 1; e < 8; ++e) if (el[e] > v1) { v1 = el[e]; i1 = e; }
                int i2 = (i1 == 0) ? 1 : 0; float v2 = -INFINITY;
#pragma unroll
                for (int e = 0; e < 8; ++e) if (e != i1 && el[e] > v2) { v2 = el[e]; i2 = e; }
                const float e2 = __expf(v2 - v1), p1 = 1.f / (1.f + e2), p2 = e2 * p1;
                const int tl = pass * 32 + tid, ea = gs * 8 + i1, eb = gs * 8 + i2;
                tk_e[tl * 2] = ea; tk_e[tl * 2 + 1] = eb;
                tk_r[tl * 2] = __hip_atomic_fetch_add(&lcnt[ea], 1, __ATOMIC_RELAXED, __HIP_MEMORY_SCOPE_WORKGROUP); tk_r[tl * 2 + 1] = __hip_atomic_fetch_add(&lcnt[eb], 1, __ATOMIC_RELAXED, __HIP_MEMORY_SCOPE_WORKGROUP);
                tk_w[tl * 2] = pg * p1; tk_w[tl * 2 + 1] = pg * p2;
            }
            __syncthreads();
        }
        if (tid < 32) lbase[tid] = atomicAdd(&cnt[tid], lcnt[tid]);
        __syncthreads();
        if (tid < 128) {
            const int e = tk_e[tid], slot = lbase[e] + tk_r[tid], n = chunk * 64 + (tid >> 1);
            list[e * LISTCAP + slot] = n; wts[e * LISTCAP + slot] = tk_w[tid]; tokrow[n * 2 + (tid & 1)] = e * LISTCAP + slot;
        }
        __syncthreads();
    }
}

__device__ __forceinline__ void moe_tables(const Params& p, LAS int* tb) {
    if (threadIdx.x == 0) {
        const int* cnt = (const int*)(p.ws + WS_CNT);
        int acc = 0;
        for (int e = 0; e < 32; ++e) { const int c = __hip_atomic_load(cnt + e, __ATOMIC_RELAXED, __HIP_MEMORY_SCOPE_AGENT); tb[e] = c; tb[32 + e] = acc; acc += (c + 255) >> 8; }
        tb[64] = acc;
    }
    __syncthreads();
}

struct P6Sched {
    __device__ __forceinline__ void a_ready(const g8::Unit&) const {}
    const LAS int* tb; const char *U2, *W1; const int* list; int G, c, nunits;
    __device__ __forceinline__ bool next(int i, g8::Unit& u, int tid) const {
        const int g = i * G + c; if (g >= nunits) return false;
        int e = 0;
#pragma unroll 1
        for (int q = 1; q < 32; ++q) if (2 * tb[32 + q] <= g) e = q;
        const int nte = tb[33 + e] - tb[32 + e], l = g - 2 * tb[32 + e], pn = l / nte, rt = l - pn * nte, ce = tb[e];
        u.A = U2; u.B = W1 + ((size_t)e * 512 + pn * 256) * 1024 * 2; u.i0 = e; u.i1 = rt; u.i2 = pn; u.i3 = tb[32 + e] + rt;
#pragma unroll
        for (int h = 0; h < 2; ++h)
#pragma unroll
            for (int k = 0; k < 2; ++k) { int sR, sC; g8::stage_rc(tid * 16 + k * 8192, sR, sC); const int slot = rt * 256 + h * 128 + sR; const int tok = slot < ce ? list[e * LISTCAP + slot] : 0; u.va[h][k] = (unsigned)(tok * 1024 + sC) * 2u; }
        return true;
    }
};
struct P6Epi {
    const Params* pp; const LAS int* tb;
    __device__ __forceinline__ bool operator()(f32x4 (&acc)[2][2][4][2], const g8::Unit& u, int wr, int wc, int fr, int fq, LAS char*) const {
        const Params& p = *pp;
        const float* wts = (const float*)(p.ws + WS_WTS);
        const int e = u.i0, rt = u.i1, pn = u.i2, ce = tb[e];
        const size_t rowbase = (size_t)u.i3 * 256;
        const __amdgpu_buffer_rsrc_t rsrc = __builtin_amdgcn_make_buffer_rsrc((void*)(p.ws + WS_HID), 0, (int)((size_t)YROWS * 256 * 2), 0x00020000);
#pragma unroll
        for (int ai = 0; ai < 2; ++ai)
#pragma unroll
            for (int m = 0; m < 4; ++m) {
                const int lr = ai * 128 + wr * 64 + m * 16 + fr, slot = rt * 256 + lr;
                const float w = slot < ce ? wts[e * LISTCAP + slot] : 0.f;
                u32x4 o;
#pragma unroll
                for (int n = 0; n < 2; ++n) {
                    const f32x4 g = acc[ai][0][m][n], uu = acc[ai][1][m][n]; f32x4 hv;
#pragma unroll
                    for (int r = 0; r < 4; ++r) hv[r] = g[r] * __builtin_amdgcn_rcpf(1.f + __expf(-g[r])) * uu[r] * w;
                    o[2 * n] = cvt_pk_bf16(hv[0], hv[1]); o[2 * n + 1] = cvt_pk_bf16(hv[2], hv[3]);
                }
                __builtin_amdgcn_raw_buffer_store_b128(o, rsrc, (int)(((rowbase + lr) * 256 + pn * 128 + wc * 32 + 8 * fq) * 2), 0, 16);
            }
        asm volatile("s_waitcnt vmcnt(0)" ::: "memory");
        if (fr == 0 && fq == 0) __hip_atomic_fetch_add((int*)(p.ws + WS_READY) + u.i3, 1, __ATOMIC_RELAXED, __HIP_MEMORY_SCOPE_AGENT);
            return false;
    }
};
__device__ __forceinline__ void p6_phase(const Params& p, LAS char* lds) {
    LAS int* tb = (LAS int*)(lds + GX_OFF);
    moe_tables(p, tb);
    P6Sched S; S.tb = tb; S.U2 = (const char*)(p.ws + WS_U); S.W1 = (const char*)(p.ws + WS_W1); S.list = (const int*)(p.ws + WS_LIST); S.G = gridDim.x; S.c = vcu_id(); S.nunits = tb[64] * 2;
    P6Epi E{&p, tb};
    g8::gemm_phase<P6Epi, P6Sched, true, true>(lds, 1024, S, E);
}

struct P7Sched {
    const LAS int* tb; const char *HID, *W2; int* ready; int G, c, nunits, nheavy;
    __device__ __forceinline__ void a_ready(const g8::Unit& u) const {
        if (__builtin_amdgcn_readfirstlane(threadIdx.x >> 6) == 0) {
            int* w = ready + u.i0; unsigned sp = 0;
            while (__hip_atomic_load(w, __ATOMIC_RELAXED, __HIP_MEMORY_SCOPE_AGENT) < 16) { __builtin_amdgcn_s_sleep(8); if (++sp > (1u << 21)) break; }
            __builtin_amdgcn_fence(__ATOMIC_ACQUIRE, "agent");
            asm volatile("s_waitcnt vmcnt(0)" ::: "memory");
        }
        __builtin_amdgcn_s_barrier();
    }
    __device__ __forceinline__ bool next(int i, g8::Unit& u, int) const {
        if (c < nheavy) return false;
        const int g = i * (G - nheavy) + (c - nheavy); if (g >= nunits) return false;
        int e = 0;
#pragma unroll 1
        for (int q = 1; q < 32; ++q) if (4 * tb[32 + q] <= g) e = q;
        const int nte = tb[33 + e] - tb[32 + e], l = g - 4 * tb[32 + e], pn = l / nte, rt = l - pn * nte, ti = tb[32 + e] + rt;
        u.A = HID + (size_t)ti * 256 * 256 * 2; u.B = W2 + ((size_t)e * 1024 + pn * 256) * 256 * 2; u.i0 = ti; u.i1 = pn; return true;
    }
};
struct P7Epi {
    const Params* pp;
    __device__ __forceinline__ bool operator()(f32x4 (&acc)[2][2][4][2], const g8::Unit& u, int wr, int wc, int fr, int fq, LAS char*) const {
        bf16_t* Y = (bf16_t*)(pp->ws + WS_Y);
        FOR_ACC(ai, bj, m, n) st4bf(Y + ((size_t)u.i0 * 256 + ai * 128 + wr * 64 + m * 16 + fr) * 1024 + u.i1 * 256 + bj * 128 + wc * 32 + n * 16 + 4 * fq, acc[ai][bj][m][n]);
            return false;
    }
};
__device__ __forceinline__ void p7_phase(const Params& p, LAS char* lds) {
    LAS int* tb = (LAS int*)(lds + GX_OFF);
    moe_tables(p, tb);
    P7Sched S; S.tb = tb; S.HID = (const char*)(p.ws + WS_HID); S.W2 = (const char*)(p.ws + WS_W2); S.ready = (int*)(p.ws + WS_READY); S.G = gridDim.x; S.c = vcu_id(); S.nunits = tb[64] * 4; { const int n6 = tb[64] * 2 - (int)gridDim.x; S.nheavy = n6 < 0 ? 0 : (n6 > (int)gridDim.x / 2 ? (int)gridDim.x / 2 : n6); }
    P7Epi E{&p};
    g8::gemm_phase<P7Epi, P7Sched, false>(lds, 256, S, E);
}

__device__ __forceinline__ void p8_phase(const Params& p, LAS char* lds) {
    const int tid = threadIdx.x, wid = tid >> 6, lane = tid & 63;
    LAS int* tb = (LAS int*)lds;
    moe_tables(p, tb);
    const bf16_t* Y = (const bf16_t*)(p.ws + WS_Y); const bf16_t* H2 = (const bf16_t*)(p.ws + WS_H2); const int* tokrow = (const int*)(p.ws + WS_TOKROW);
    f32x4 g[4];
#pragma unroll
    for (int j = 0; j < 4; ++j) g[j] = *(const f32x4*)(p.final_g + j * 256 + lane * 4);
    const int stride = gridDim.x * 8;
    for (int n0 = blockIdx.x * 8 + wid; n0 < NTOK; n0 += 4 * stride) {
        u32x2 hb[4][4], ya[4][4], yc[4][4]; bool ok[4];
#pragma unroll
        for (int q = 0; q < 4; ++q) {
            const int n = n0 + q * stride; ok[q] = n < NTOK;
            const int nn = ok[q] ? n : n0;
            const int r1 = tokrow[nn * 2], r2 = tokrow[nn * 2 + 1];
            const size_t y1 = (size_t)tb[32 + (r1 >> 14)] * 256 + (r1 & 16383), y2 = (size_t)tb[32 + (r2 >> 14)] * 256 + (r2 & 16383);
#pragma unroll
            for (int j = 0; j < 4; ++j) {
                hb[q][j] = *(const u32x2*)(H2 + (size_t)nn * 1024 + j * 256 + lane * 4);
                ya[q][j] = *(const u32x2*)(Y + y1 * 1024 + j * 256 + lane * 4); yc[q][j] = *(const u32x2*)(Y + y2 * 1024 + j * 256 + lane * 4);
            }
        }
#pragma unroll
        for (int q = 0; q < 4; ++q) {
            f32x4 v[4]; float ss = 0.f;
#pragma unroll
            for (int j = 0; j < 4; ++j) {
                v[j][0] = bf_lo(hb[q][j].x) + bf_lo(ya[q][j].x) + bf_lo(yc[q][j].x); v[j][1] = bf_hi(hb[q][j].x) + bf_hi(ya[q][j].x) + bf_hi(yc[q][j].x);
                v[j][2] = bf_lo(hb[q][j].y) + bf_lo(ya[q][j].y) + bf_lo(yc[q][j].y); v[j][3] = bf_hi(hb[q][j].y) + bf_hi(ya[q][j].y) + bf_hi(yc[q][j].y);
                ss += v[j][0] * v[j][0] + v[j][1] * v[j][1] + v[j][2] * v[j][2] + v[j][3] * v[j][3];
            }
            ss = wave_sum(ss);
            const float rstd = rsqrtf(ss * (1.f / 1024.f) + EPS);
            if (ok[q]) {
#pragma unroll
                for (int j = 0; j < 4; ++j) *(f32x4*)(p.out + (size_t)(n0 + q * stride) * 1024 + j * 256 + lane * 4) = v[j] * rstd * g[j];
            }
        }
    }
}

__global__ void __launch_bounds__(512, 2) fwd_kernel(Params p) {
    extern __shared__ __attribute__((aligned(16))) unsigned char smem[];
    LAS char* lds = (LAS char*)smem;
    volatile LAS unsigned* barw = (volatile LAS unsigned*)(lds + LDS_BARW);
    if (threadIdx.x < 2) barw[threadIdx.x] = 0u;
    __syncthreads();
    XcdBarrier bar; bar.bar = (unsigned*)(p.ws + WS_BAR); bar.x = 0; bar.st = nullptr;
    if (N_LAUNCHES == 1) bar = xcd_barrier_post((unsigned*)(p.ws + WS_BAR), barw);
    const int lo = p.ph_lo, hi = p.ph_hi;
    unsigned long long _kstart = 0; if (MEAS_SEC >= 50 && MEAS_SEC < 60) _kstart = __builtin_amdgcn_s_memtime();
#define MEAS_SEAM(k) if (MEAS_SEC == 50 + (k)) { __builtin_amdgcn_s_waitcnt(0); const unsigned long long _d = __builtin_amdgcn_s_memtime() - _kstart; \
    if (blockIdx.x == MEAS_BLK && threadIdx.x == 0) { unsigned long long* _slot = (unsigned long long*)(p.ws + WS_CNT + 128); if (*_slot == 0ull) *_slot = _d; } }
#define IN(k) (lo <= (k) && (k) < hi)
#define SEAM(k) do { if (IN(k) && IN((k) + 1)) xcd_barrier(bar); } while (0)
#ifndef PH_MASK
#define PH_MASK 0x7ff
#endif
#define HAS(k) ((PH_MASK >> (k)) & 1)
    if (HAS(0) && IN(0)) { MEAS_T0(10) p0_phase(p, lds); MEAS_T1(10, p.ws) if (DUP_PHASE == 0) { xcd_barrier(bar); p0_phase(p, lds); } } SEAM(0); MEAS_SEAM(0)
    if (HAS(1) && IN(1)) { MEAS_T0(11) p1_phase(p, lds); MEAS_T1(11, p.ws) if (DUP_PHASE == 1) { xcd_barrier(bar); p1_phase(p, lds); } } SEAM(1); MEAS_SEAM(1)
    if (HAS(2) && IN(2)) { MEAS_T0(12) p2_phase(p, lds); MEAS_T1(12, p.ws) if (DUP_PHASE == 2) { xcd_barrier(bar); p2_phase(p, lds); } } SEAM(2); MEAS_SEAM(2)
    if (HAS(3) && IN(3)) { MEAS_T0(13) p3_phase(p, lds); MEAS_T1(13, p.ws) if (DUP_PHASE == 3) { xcd_barrier(bar); p3_phase(p, lds); } }   MEAS_SEAM(3)
    if (HAS(4) && IN(4)) { MEAS_T0(14) p4_phase(p, lds); MEAS_T1(14, p.ws) if (DUP_PHASE == 4) { xcd_barrier(bar); p4_phase(p, lds); } }   MEAS_SEAM(4)
    if (HAS(5) && IN(5)) { MEAS_T0(15) p5_phase(p, lds); MEAS_T1(15, p.ws) if (DUP_PHASE == 5) { xcd_barrier(bar); if (blockIdx.x == 0 && threadIdx.x < 32) ((int*)(p.ws + WS_CNT))[threadIdx.x] = 0; xcd_barrier(bar); p5_phase(p, lds); } } SEAM(5); MEAS_SEAM(5)
    if (HAS(6) && IN(6)) { MEAS_T0(16) p6_phase(p, lds); MEAS_T1(16, p.ws) }   MEAS_SEAM(6)
    if (HAS(7) && IN(7)) { MEAS_T0(17) p7_phase(p, lds); MEAS_T1(17, p.ws) if (DUP_PHASE == 7) { xcd_barrier(bar); p7_phase(p, lds); } } SEAM(7); MEAS_SEAM(7)
    if (HAS(8) && IN(8)) { MEAS_T0(18) p8_phase(p, lds); MEAS_T1(18, p.ws) } MEAS_SEAM(8)
    if (MEAS_SEC != 0 && blockIdx.x == 0 && threadIdx.x == 0) {
        const unsigned long long d = *(volatile unsigned long long*)(p.ws + WS_CNT + 128);
        const unsigned long long t0 = __builtin_amdgcn_s_memtime();
        while (__builtin_amdgcn_s_memtime() - t0 < d * MEAS_MULT) __builtin_amdgcn_s_sleep(8);
    }
}

extern "C" void kernel_launch(void* const* d_in, const int* in_sizes, int n_in, void* d_out, int out_size, void* d_ws, size_t ws_size, hipStream_t stream) {
    static int grid = 0;
    if (grid == 0) {
        if (n_in != 21 || ws_size < WS_END) { fprintf(stderr, "kernel_launch: unexpected n_in %d or ws_size %zu (< %zu)\n", n_in, ws_size, (size_t)WS_END); grid = -1; return; }
        int dev = 0, cus = 0;
        if (hipGetDevice(&dev) != hipSuccess || hipDeviceGetAttribute(&cus, hipDeviceAttributeMultiprocessorCount, dev) != hipSuccess) { grid = -1; return; }
        if (hipFuncSetAttribute((const void*)fwd_kernel, hipFuncAttributeMaxDynamicSharedMemorySize, LDS_BYTES) != hipSuccess) { fprintf(stderr, "kernel_launch: hipFuncSetAttribute failed\n"); grid = -1; return; }
        grid = cus;
    }
    if (grid < 0) return;
    (void)hipMemsetAsync((char*)d_ws + WS_BAR, 0, WS_ZERO_BYTES, stream);
#if EXTRA_MEMSET
    (void)hipMemsetAsync((char*)d_ws + WS_BAR, 0, WS_ZERO_BYTES, stream);
#endif
    Params p{};
    const float** f = (const float**)&p;
    for (int i = 0; i < 21; ++i) f[i] = (const float*)d_in[i];
    p.out = (float*)d_out; p.ws = (unsigned char*)d_ws;
    if (N_LAUNCHES == 1) { p.ph_lo = 0; p.ph_hi = NPH; hipLaunchKernelGGL(fwd_kernel, dim3(grid), dim3(512), LDS_BYTES, stream, p); }
    else for (int k = 0; k < NPH; ++k) { p.ph_lo = k; p.ph_hi = k + 1; hipLaunchKernelGGL(fwd_kernel, dim3(grid), dim3(512), LDS_BYTES, stream, p); }
}
```

```cpp
#include <hip/hip_runtime.h>
#include <stdint.h>
#include <stdio.h>

#ifndef DUP_PHASE
#define DUP_PHASE -1
#endif
#ifndef MEAS_SEC
#define MEAS_SEC 0
#endif
#ifndef MEAS_BLK
#define MEAS_BLK 0
#endif
#ifndef MEAS_MULT
#define MEAS_MULT 100
#endif
#ifndef EXTRA_MEMSET
#define EXTRA_MEMSET 0
#endif
#ifndef N_LAUNCHES
#define N_LAUNCHES 1
#endif

#define LAS __attribute__((address_space(3)))
typedef unsigned short bf16_t;
typedef short bf16x8 __attribute__((ext_vector_type(8)));
typedef short s16x4 __attribute__((ext_vector_type(4)));
typedef float f32x4 __attribute__((ext_vector_type(4)));
typedef float f32x16 __attribute__((ext_vector_type(16)));
typedef unsigned u32x4 __attribute__((ext_vector_type(4)));
typedef unsigned u32x2 __attribute__((ext_vector_type(2)));

constexpr int NB = 8, SEQ = 2048, TT = 2064, DM = 1024;
constexpr int MALL = NB * TT;
constexpr int MPAD = 16640;
constexpr int NTOK = NB * SEQ;
constexpr int INW = 3496, INP = 3584;
constexpr float EPS = 1e-6f;
constexpr float ATTN_SCALE = 0.125f;
constexpr float IDX_SCALE = 0.0625f;
constexpr float LOG2E = 1.4426950408889634f;
constexpr int NPH = 9;
constexpr int LISTCAP = 16384;
constexpr int YROWS = 40960;

constexpr size_t AL(size_t x) { return (x + 255) & ~(size_t)255; }
constexpr size_t WS_BAR   = 0;
constexpr size_t WS_CNT   = WS_BAR + 16384;
constexpr size_t WS_READY = WS_CNT + 256;
constexpr size_t WS_READY3 = WS_CNT + 2048;
constexpr size_t WS_READY4 = WS_CNT + 3072;
constexpr size_t WS_ZERO_BYTES = 16384 + 4096;
constexpr size_t WS_WIN   = AL(WS_CNT + 4096);
constexpr size_t WS_WUK   = AL(WS_WIN + (size_t)INP * DM * 2);
constexpr size_t WS_WUV   = AL(WS_WUK + 8 * 128 * 64 * 2);
constexpr size_t WS_WF    = AL(WS_WUV + 8 * 64 * 128 * 2);
constexpr size_t WS_WA    = AL(WS_WF + 1024 * 512 * 2);
constexpr size_t WS_WO    = AL(WS_WA + 1024 * 512 * 2);
constexpr size_t WS_W1    = AL(WS_WO + 1024 * 1024 * 2);
constexpr size_t WS_W2    = AL(WS_W1 + (size_t)32 * 512 * 1024 * 2);
constexpr size_t WS_WRH   = AL(WS_W2 + (size_t)32 * 1024 * 256 * 2);
constexpr size_t WS_WRL   = AL(WS_WRH + 48 * 1024 * 2);
constexpr size_t WS_U     = AL(WS_WRL + 48 * 1024 * 2);
constexpr size_t WS_LIST  = AL(WS_U + (size_t)MPAD * DM * 2);
constexpr size_t WS_WTS   = AL(WS_LIST + (size_t)32 * LISTCAP * 4);
constexpr size_t WS_TOKROW= AL(WS_WTS + (size_t)32 * LISTCAP * 4);
constexpr size_t WS_UNION = AL(WS_TOKROW + (size_t)NTOK * 2 * 4);
constexpr size_t WS_Q     = WS_UNION;
constexpr size_t WS_C     = AL(WS_Q + (size_t)MPAD * 512 * 2);
constexpr size_t WS_IQ    = AL(WS_C + (size_t)MPAD * 128 * 2);
constexpr size_t WS_IK    = AL(WS_IQ + (size_t)MPAD * 256 * 2);
constexpr size_t WS_IW    = AL(WS_IK + (size_t)MPAD * 32 * 2);
constexpr size_t WS_PV    = AL(WS_IW + (size_t)MPAD * 8 * 4);
constexpr size_t WS_GATES = AL(WS_PV + (size_t)MPAD * 512 * 2);
constexpr size_t WS_ATTN  = AL(WS_GATES + (size_t)MPAD * 2048 * 2);
constexpr size_t WS_DD    = AL(WS_ATTN + (size_t)NTOK * 512 * 2);
constexpr size_t WS_ENDA  = AL(WS_DD + (size_t)NTOK * 512 * 2);
constexpr size_t WS_HID   = WS_UNION;
constexpr size_t WS_Y     = AL(WS_HID + (size_t)YROWS * 256 * 2);
constexpr size_t WS_H2    = AL(WS_Y + (size_t)YROWS * 1024 * 2);
constexpr size_t WS_ENDB  = AL(WS_H2 + (size_t)NTOK * 1024 * 2);
constexpr size_t WS_END   = WS_ENDA > WS_ENDB ? WS_ENDA : WS_ENDB;

constexpr int LDS_BYTES = 156 * 1024;
constexpr int LDS_BARW  = LDS_BYTES - 16;

struct Params {
    const float *x, *meta, *norm1_g, *w_in, *kv_norm_g, *w_uk, *w_uv, *w_pool, *pool_scale, *w_ba, *w_bp, *w_out, *norm2_g,
                *w_gr, *b_gr, *w_er, *b_er, *w_eg, *w_eu, *w_ed, *final_g;
    float* out; unsigned char* ws; int ph_lo, ph_hi;
};

typedef __bf16 bf16v2_t __attribute__((ext_vector_type(2)));
typedef float f32x2 __attribute__((ext_vector_type(2)));
__device__ __forceinline__ unsigned cvt_pk_bf16(float lo, float hi) { const f32x2 v = {lo, hi}; return __builtin_bit_cast(unsigned, __builtin_convertvector(v, bf16v2_t)); }
__device__ __forceinline__ float bf_lo(unsigned u) { return __uint_as_float(u << 16); }
__device__ __forceinline__ float bf_hi(unsigned u) { return __uint_as_float(u & 0xffff0000u); }
__device__ __forceinline__ float wave_sum(float v) {
#pragma unroll
    for (int o = 1; o < 64; o <<= 1) v += __shfl_xor(v, o);
    return v;
}
__device__ __forceinline__ void st4bf(bf16_t* p, f32x4 v) { u32x2 o; o.x = cvt_pk_bf16(v[0], v[1]); o.y = cvt_pk_bf16(v[2], v[3]); *(u32x2*)p = o; }
__device__ __forceinline__ f32x4 mfma16(bf16x8 a, bf16x8 b, f32x4 c) { return __builtin_amdgcn_mfma_f32_16x16x32_bf16(a, b, c, 0, 0, 0); }
__device__ __forceinline__ f32x16 mfma32(bf16x8 a, bf16x8 b, f32x16 c) { return __builtin_amdgcn_mfma_f32_32x32x16_bf16(a, b, c, 0, 0, 0); }

#define MEAS_T0(k) unsigned long long _mt##k = 0; if (MEAS_SEC == (k) || ((k) == 30 && MEAS_SEC >= 31 && MEAS_SEC <= 33)) { __builtin_amdgcn_sched_barrier(0); _mt##k = __builtin_amdgcn_s_memtime(); __builtin_amdgcn_sched_barrier(0); }
#define MEAS_T1(k, ws) if (MEAS_SEC == (k)) { __builtin_amdgcn_s_waitcnt(0); __builtin_amdgcn_sched_barrier(0); const unsigned long long _d = __builtin_amdgcn_s_memtime() - _mt##k; \
    if (blockIdx.x == MEAS_BLK && threadIdx.x == 0) { unsigned long long* _slot = (unsigned long long*)((ws) + WS_CNT + 128); if (*_slot == 0ull) *_slot = _d; } }

#define MEAS_T1X(k, k0, ws) if (MEAS_SEC == (k)) { __builtin_amdgcn_s_waitcnt(0); const unsigned long long _d = __builtin_amdgcn_s_memtime() - _mt##k0; \
    if (blockIdx.x == MEAS_BLK && threadIdx.x == 0) { unsigned long long* _slot = (unsigned long long*)((ws) + WS_CNT + 128); if (*_slot == 0ull) *_slot = _d; } }
#define XB_TMO      128
#define XB_XCNT(j)  (256  + 64 * (j))
#define XB_XSUB(j)  (1280 + 64 * (j))
#define XB_XGEN(j)  (2304 + 64 * (j))
#define XB_TOP      3328
#define XB_TOPGEN   3392
#define XCD_BAR_WORDS 3456
#define XB_SPIN_CAP (1u << 20)
__device__ __forceinline__ unsigned xb_ld(unsigned* p)              { return __hip_atomic_load(p, __ATOMIC_RELAXED, __HIP_MEMORY_SCOPE_AGENT); }
__device__ __forceinline__ unsigned xb_add(unsigned* p, unsigned v) { return __hip_atomic_fetch_add(p, v, __ATOMIC_RELAXED, __HIP_MEMORY_SCOPE_AGENT); }
__device__ __forceinline__ unsigned xb_xcc_id() { return (unsigned)__builtin_amdgcn_s_getreg((3 << 11) | 20) & 0xFu; }
#define XB_SPIN(cond, bar) do { unsigned _sp = 0; while (cond) { __builtin_amdgcn_s_sleep(1); \
    if ((++_sp & 255u) == 0u) { if (xb_ld(&(bar)[XB_TMO])) break; if (_sp > XB_SPIN_CAP) { atomicAdd(&(bar)[XB_TMO], 1u); break; } } } } while (0)
struct XcdBarrier { unsigned* bar; unsigned x; volatile LAS unsigned* st; };
__device__ __forceinline__ XcdBarrier xcd_barrier_post(unsigned* bar, volatile LAS unsigned* st) {
    XcdBarrier b; b.bar = bar; b.x = xb_xcc_id(); b.st = st;
    if (threadIdx.x == 0) (void)xb_add(&bar[XB_XCNT(b.x)], 1u);
    return b;
}
__device__ __forceinline__ void xcd_barrier_complete(unsigned* bar, unsigned x, unsigned& nloc, unsigned& nx) {
    const unsigned G = gridDim.x * gridDim.y * gridDim.z;
    unsigned sum, cnt, mine, sp = 0u;
    for (;;) {
        sum = 0u; cnt = 0u; mine = 0u;
#pragma unroll
        for (unsigned j = 0; j < 16; ++j) { const unsigned c = xb_ld(&bar[XB_XCNT(j)]); sum += c; cnt += (c > 0u) ? 1u : 0u; mine = (j == x) ? c : mine; }
        if (sum == G) break;
        __builtin_amdgcn_s_sleep(1);
        if ((++sp & 255u) == 0u) { if (xb_ld(&bar[XB_TMO])) break; if (sp > XB_SPIN_CAP) { atomicAdd(&bar[XB_TMO], 1u); break; } }
    }
    nloc = mine > 0u ? mine : 1u; nx = cnt > 0u ? cnt : 1u;
}
__device__ __forceinline__ void xcd_barrier(const XcdBarrier& b) {
    asm volatile("s_waitcnt vmcnt(0)" ::: "memory");
    __syncthreads();
    if (threadIdx.x == 0) {
        unsigned* bar = b.bar;
        __builtin_amdgcn_s_waitcnt(0);
        unsigned nloc = b.st[0], nx = b.st[1];
        if (nloc == 0u) { xcd_barrier_complete(bar, b.x, nloc, nx); b.st[0] = nloc; b.st[1] = nx; }
        const unsigned old = xb_add(&bar[XB_XSUB(b.x)], 1u);
        const unsigned gen = old / nloc;
        if (old + 1u == (gen + 1u) * nloc) {
            __builtin_amdgcn_fence(__ATOMIC_RELEASE, "agent");
            asm volatile("s_waitcnt vmcnt(0)" ::: "memory");
            const unsigned og = xb_add(&bar[XB_TOP], 1u);
            const unsigned tg = og / nx;
            if (og + 1u == (tg + 1u) * nx) xb_add(&bar[XB_TOPGEN], 1u);
            else XB_SPIN(xb_ld(&bar[XB_TOPGEN]) == tg, bar);
            __builtin_amdgcn_fence(__ATOMIC_ACQUIRE, "agent");
            xb_add(&bar[XB_XGEN(b.x)], 1u);
            asm volatile("s_waitcnt vmcnt(0)" ::: "memory");
        } else {
            XB_SPIN(xb_ld(&bar[XB_XGEN(b.x)]) == gen, bar);
            __builtin_amdgcn_fence(__ATOMIC_ACQUIRE, "agent");
            asm volatile("s_waitcnt vmcnt(0)" ::: "memory");
        }
    }
    __syncthreads();
}

struct TJob { const float* src; bf16_t* dst; int src_ld, dst_ld, N, ktiles, ntiles, nbatch, split; size_t sbs, dbs; };
__device__ __forceinline__ TJob tjob(const Params& p, int j) {
    bf16_t* win = (bf16_t*)(p.ws + WS_WIN); bf16_t* w1 = (bf16_t*)(p.ws + WS_W1);
    TJob J;
    switch (j) {
    case 0:  J = TJob{p.w_in,        win,                 INW, 1024, 936, 16, 4, 1, 0, 0, 0}; break;
    case 1:  J = TJob{p.w_in + 936,  win + 1024 * 1024,   INW, 1024, 512, 16, 2, 1, 0, 0, 0}; break;
    case 2:  J = TJob{p.w_in + 1448, win + 1536 * 1024,   INW, 1024, 2048, 16, 8, 1, 0, 0, 0}; break;
    case 3:  J = TJob{p.w_uv, (bf16_t*)(p.ws + WS_WUV),   512, 128, 64, 2, 1, 8, 0, 64, 64 * 128}; break;
    case 4:  J = TJob{p.w_ba, (bf16_t*)(p.ws + WS_WA),    1024, 512, 1024, 8, 4, 1, 0, 0, 0}; break;
    case 5:  J = TJob{p.w_out, (bf16_t*)(p.ws + WS_WO),   1024, 1024, 1024, 16, 4, 1, 0, 0, 0}; break;
    case 6:  J = TJob{p.w_eg, w1,                         256, 1024, 256, 16, 1, 32, 1, 262144, 524288}; break;
    case 7:  J = TJob{p.w_eu, w1 + 128 * 1024,            256, 1024, 256, 16, 1, 32, 1, 262144, 524288}; break;
    default: J = TJob{p.w_ed, (bf16_t*)(p.ws + WS_W2),    1024, 256, 1024, 4, 4, 32, 0, 262144, 262144}; break;
    }
    return J;
}
constexpr int NTJOBS = 9;
__device__ __forceinline__ int tjob_tiles(int j) {
    constexpr int t[NTJOBS] = {64, 32, 128, 16, 32, 64, 512, 512, 512};
    return t[j];
}
constexpr int P0_TILES = 64 + 32 + 128 + 16 + 32 + 64 + 512 + 512 + 512;
constexpr int P0_WUK = 128, P0_WF = 512, P0_PAD = 88, P0_WR = 48, P0_NORM = MPAD / 4;
constexpr int P0_WITEMS = P0_WF + P0_WUK + P0_PAD + P0_WR + P0_NORM;
constexpr int T_LD = 257;

struct TItem { const float* src; bf16_t* dst; int src_ld, dst_ld, N, k0, n0, split; };
__device__ __forceinline__ bool p0_titem(const Params& p, int it, TItem& T) {
    if (it >= P0_TILES) return false;
    int r = it, j = 0;
#pragma unroll 1
    for (; j < NTJOBS - 1; ++j) { const int n = tjob_tiles(j); if (r < n) break; r -= n; }
    const TJob J = tjob(p, j);
    const int per = J.ktiles * J.ntiles, bi = r / per, rr = r % per, kt = rr / J.ntiles, nt = rr % J.ntiles;
    T.src = J.src + (size_t)bi * J.sbs; T.dst = J.dst + (size_t)bi * J.dbs; T.src_ld = J.src_ld; T.dst_ld = J.dst_ld; T.N = J.N; T.k0 = kt * 64; T.n0 = nt * 256; T.split = J.split;
    return true;
}
__device__ __forceinline__ void p0_tload(const TItem& T, f32x4 (&v)[8], int tid) {
#pragma unroll
    for (int i = 0; i < 8; ++i) {
        const int kk = (tid >> 6) + 8 * i, n4 = (tid & 63) * 4;
        v[i] = (f32x4){0.f, 0.f, 0.f, 0.f};
        if (T.n0 + n4 < T.N) v[i] = *(const f32x4*)(T.src + (size_t)(T.k0 + kk) * T.src_ld + T.n0 + n4);
    }
}

__device__ __forceinline__ void p0_phase(const Params& p, LAS char* lds) {
    const int tid = threadIdx.x, wid = __builtin_amdgcn_readfirstlane(tid >> 6), lane = tid & 63, fr = lane & 15, fq = lane >> 4;
    MEAS_T0(34)
    {
        LAS float* tile = (LAS float*)lds;
        TItem T, Tn; f32x4 v[8];
        int it = blockIdx.x;
        bool have = p0_titem(p, it, T);
        if (have) p0_tload(T, v, tid);
        while (have) {
#pragma unroll
            for (int i = 0; i < 8; ++i) {
                const int kk = (tid >> 6) + 8 * i, n4 = (tid & 63) * 4;
                tile[kk * T_LD + n4 + 0] = v[i][0]; tile[kk * T_LD + n4 + 1] = v[i][1]; tile[kk * T_LD + n4 + 2] = v[i][2]; tile[kk * T_LD + n4 + 3] = v[i][3];
            }
            it += gridDim.x;
            const bool hn = p0_titem(p, it, Tn);
            if (hn) p0_tload(Tn, v, tid);
            __syncthreads();
#pragma unroll
            for (int c = 0; c < 4; ++c) {
                const int idx = tid + 512 * c, n = idx >> 3, kc = idx & 7;
                if (T.n0 + n < T.N) {
                    const LAS float* sp = tile + (kc * 8) * T_LD + n;
                    u32x4 o; o.x = cvt_pk_bf16(sp[0], sp[T_LD]); o.y = cvt_pk_bf16(sp[2 * T_LD], sp[3 * T_LD]); o.z = cvt_pk_bf16(sp[4 * T_LD], sp[5 * T_LD]); o.w = cvt_pk_bf16(sp[6 * T_LD], sp[7 * T_LD]);
                    const int nn = T.n0 + n, drow = T.split ? ((nn & 127) + (nn >> 7) * 256) : nn;
                    *(u32x4*)(T.dst + (size_t)drow * T.dst_ld + T.k0 + kc * 8) = o;
                }
            }
            __syncthreads();
            T = Tn; have = hn;
        }
    }
    MEAS_T1(34, p.ws)
    MEAS_T0(35)
    for (int it = blockIdx.x * 8 + wid; it < P0_WITEMS; it += gridDim.x * 8) {
        int r = it;
        if (r < P0_WF) {
            const int kt = r >> 4, nq = r & 15, k0 = kt * 16, g = k0 >> 7, n0 = nq * 64;
            f32x4 acc[4];
#pragma unroll
            for (int i = 0; i < 4; ++i) acc[i] = (f32x4){0.f, 0.f, 0.f, 0.f};
            const float* wp = p.w_pool + (size_t)(k0 + fr) * 128 + fq; const float* ps = p.pool_scale + g * 128 + fq;
            const float* wb = p.w_bp + (size_t)(g * 128 + fq) * 1024 + n0 + fr;
#pragma unroll 8
            for (int st = 0; st < 32; ++st) {
                const float a = wp[4 * st] * ps[4 * st];
#pragma unroll
                for (int i = 0; i < 4; ++i) acc[i] = __builtin_amdgcn_mfma_f32_16x16x4f32(a, wb[(size_t)(4 * st) * 1024 + i * 16], acc[i], 0, 0, 0);
            }
            bf16_t* wf = (bf16_t*)(p.ws + WS_WF);
#pragma unroll
            for (int i = 0; i < 4; ++i) st4bf(wf + (size_t)(n0 + 16 * i + fr) * 512 + k0 + 4 * fq, acc[i]);
            continue;
        }
        r -= P0_WF;
        if (r < P0_WUK) {
            const int o = r * 512 + lane * 8, h = o >> 13, c = (o >> 6) & 127, d = o & 63;
            const float* sp = p.w_uk + c * 512 + h * 64 + d;
            const f32x4 a = *(const f32x4*)sp, b = *(const f32x4*)(sp + 4);
            u32x4 w; w.x = cvt_pk_bf16(a[0], a[1]); w.y = cvt_pk_bf16(a[2], a[3]); w.z = cvt_pk_bf16(b[0], b[1]); w.w = cvt_pk_bf16(b[2], b[3]);
            *(u32x4*)((bf16_t*)(p.ws + WS_WUK) + o) = w;
            continue;
        }
        r -= P0_WUK;
        if (r < P0_PAD) {
            bf16_t* win = (bf16_t*)(p.ws + WS_WIN) + (size_t)(936 + r) * 1024;
            const u32x4 z = {0u, 0u, 0u, 0u};
            *(u32x4*)(win + lane * 8) = z; *(u32x4*)(win + 512 + lane * 8) = z;
            continue;
        }
        r -= P0_PAD;
        if (r < P0_WR) {
            bf16_t* wh = (bf16_t*)(p.ws + WS_WRH) + (size_t)r * 1024; bf16_t* wl = (bf16_t*)(p.ws + WS_WRL) + (size_t)r * 1024;
#pragma unroll 16
            for (int i = 0; i < 16; ++i) {
                const int k = lane + 64 * i;
                const float w = r < 4 ? p.w_gr[(size_t)k * 4 + r] : (r < 36 ? p.w_er[(size_t)k * 32 + (r - 4)] : 0.f);
                const unsigned h = cvt_pk_bf16(w, 0.f) & 0xffffu;
                wh[k] = (bf16_t)h; wl[k] = (bf16_t)(cvt_pk_bf16(w - bf_lo(h), 0.f) & 0xffffu);
            }
            continue;
        }
        r -= P0_WR;
        {
            const int R0 = r * 4;
            f32x4 v[4][4];
#pragma unroll
            for (int q = 0; q < 4; ++q) {
                const int R = R0 + q;
                if (R < MALL) {
                    const int b = R / TT, t = R - b * TT;
                    const float* src = (t < 16) ? (p.meta + (size_t)t * 1024) : (p.x + ((size_t)b * SEQ + (t - 16)) * 1024);
#pragma unroll
                    for (int j = 0; j < 4; ++j) v[q][j] = *(const f32x4*)(src + j * 256 + lane * 4);
                } else {
#pragma unroll
                    for (int j = 0; j < 4; ++j) v[q][j] = (f32x4){0.f, 0.f, 0.f, 0.f};
                }
            }
            f32x4 g[4];
#pragma unroll
            for (int j = 0; j < 4; ++j) g[j] = *(const f32x4*)(p.norm1_g + j * 256 + lane * 4);
#pragma unroll
            for (int q = 0; q < 4; ++q) {
                float ss = 0.f;
#pragma unroll
                for (int j = 0; j < 4; ++j) ss += v[q][j][0] * v[q][j][0] + v[q][j][1] * v[q][j][1] + v[q][j][2] * v[q][j][2] + v[q][j][3] * v[q][j][3];
                ss = wave_sum(ss);
                const float rstd = rsqrtf(ss * (1.f / 1024.f) + EPS);
                bf16_t* urow = (bf16_t*)(p.ws + WS_U) + (size_t)(R0 + q) * 1024;
#pragma unroll
                for (int j = 0; j < 4; ++j) st4bf(urow + j * 256 + lane * 4, v[q][j] * rstd * g[j]);
            }
        }
    }
    MEAS_T1(35, p.ws)
    __syncthreads();
}

namespace g8 {
constexpr int BM = 256, BK = 64, HALF = 128, HTB = HALF * BK * 2, STAGE_BYTES = 8 * HTB, NXCD = 8, WGM = 8;
__device__ __forceinline__ int lds_byte(int r, int c) { const int st = (r >> 4) * 2 + (c >> 5), rr = r & 15, cc = c & 31, ob = rr * 64 + cc * 2; return st * 1024 + (ob ^ (((ob >> 9) & 1) << 5)); }
__device__ __forceinline__ void stage_rc(int b, int& R, int& C) { const int st = b / 1024, sb = b % 1024, swz = sb ^ (((sb >> 9) & 1) << 5); R = (st >> 1) * 16 + swz / 64; C = (st & 1) * 32 + (swz % 64) / 2; }

struct Unit { const char* A; const char* B; int i0, i1, i2, i3; unsigned va[2][2]; };

struct TileOrder {
    int nM, nN, nwg, G, c;
    __device__ __forceinline__ void init(int nM_, int nN_, int G_, int c_) { nM = nM_; nN = nN_; nwg = nM * nN; G = G_; c = c_; }
    __device__ __forceinline__ bool tile(int i, int& pm, int& pn) const {
        const long L = (long)i * G + c; if (L >= nwg) return false;
        int wgid = (int)L; { const int q = nwg / NXCD, r = nwg % NXCD, xcd = wgid % NXCD, off = wgid / NXCD; wgid = (xcd < r ? xcd * (q + 1) : r * (q + 1) + (xcd - r) * q) + off; }
        const int nig = WGM * nN, gid = wgid / nig, fm = gid * WGM, gsz = (nM - fm) < WGM ? (nM - fm) : WGM;
        pm = fm + ((wgid % nig) % gsz); pn = (wgid % nig) / gsz; return true;
    }
};

template <class Epi, class Sched, bool GATHER, bool PERM = false>
__device__ __forceinline__ void gemm_phase(LAS char* lds, const int K, const Sched& S, const Epi& E) {
    const int tid = threadIdx.x, wid = __builtin_amdgcn_readfirstlane(tid >> 6), lane = tid & 63, wr = wid >> 2, wc = wid & 3, fr = lane & 15, fq = lane >> 4;
    const int nt = K / BK;
    unsigned voff[2], voffb[2];
#pragma unroll
    for (int i = 0; i < 2; ++i) { int R_, C_; stage_rc(tid * 16 + i * 8192, R_, C_); voff[i] = (unsigned)(R_ * K + C_) * 2u;
        const int rho = R_ & 31, Rb = PERM ? ((R_ & ~31) + 8 * ((rho & 15) >> 2) + 4 * (rho >> 4) + (rho & 3)) : R_; voffb[i] = (unsigned)(Rb * K + C_) * 2u; }
    const size_t kstep = (size_t)(BK * 2);
    const size_t hstep = (size_t)HALF * K * 2;
    const unsigned ldsw = (unsigned)wid * 1024u;
    const int aoff = lds_byte(wr * 64 + fr, fq * 8), boff = lds_byte(wc * 32 + fr, fq * 8);
#define G8_SA(b, h) (((b) * 2 + (h)) * HTB)
#define G8_SB(b, h) ((4 + (b) * 2 + (h)) * HTB)
#define G8_GLDS(bufoff, ptr, i_) __builtin_amdgcn_global_load_lds((const unsigned*)(ptr), (LAS unsigned*)(lds + (bufoff) + ldsw + (i_) * 8192), 16, 0, 0)
#define G8_STAGE_B(bufoff, gbase) do { _Pragma("unroll") for (int _i = 0; _i < 2; ++_i) G8_GLDS(bufoff, (const char*)(gbase) + voffb[_i], _i); } while (0)
#define G8_STAGE_A(bufoff, abase, vA, h) do { _Pragma("unroll") for (int _i = 0; _i < 2; ++_i) \
        G8_GLDS(bufoff, GATHER ? ((const char*)(abase) + (vA)[h][_i]) : ((const char*)(abase) + (size_t)(h) * hstep + voff[_i]), _i); } while (0)
#define G8_LDA(dst, b, h) do { _Pragma("unroll") for (int m = 0; m < 4; ++m) _Pragma("unroll") for (int k = 0; k < 2; ++k) dst[m][k] = *(const LAS bf16x8*)(lds + G8_SA(b, h) + aoff + m * 2048 + k * 1024); } while (0)
#define G8_LDB(dst, b, h) do { _Pragma("unroll") for (int n = 0; n < 2; ++n) _Pragma("unroll") for (int k = 0; k < 2; ++k) dst[n][k] = *(const LAS bf16x8*)(lds + G8_SB(b, h) + boff + n * 2048 + k * 1024); } while (0)
#define G8_MMA(ai, bj, At, Bt) do { __builtin_amdgcn_s_setprio(1); _Pragma("unroll") for (int m = 0; m < 4; ++m) _Pragma("unroll") for (int n = 0; n < 2; ++n) _Pragma("unroll") for (int k = 0; k < 2; ++k) \
        acc[ai][bj][m][n] = __builtin_amdgcn_mfma_f32_16x16x32_bf16(Bt[n][k], At[m][k], acc[ai][bj][m][n], 0, 0, 0); __builtin_amdgcn_s_setprio(0); } while (0)
#define G8_WAIT_V(n) asm volatile("s_waitcnt vmcnt(" #n ")" ::: "memory")
#define G8_WAIT_L(n) asm volatile("s_waitcnt lgkmcnt(" #n ")" ::: "memory")
#define G8_BAR __builtin_amdgcn_s_barrier()
#define G8_SCHED __builtin_amdgcn_sched_barrier(0)
    Unit cur, nxt; int ui = 0;
    cur.A = nullptr; cur.B = nullptr; cur.i0 = cur.i1 = cur.i2 = cur.i3 = 0; cur.va[0][0] = cur.va[0][1] = cur.va[1][0] = cur.va[1][1] = 0u; nxt = cur;
    if (!S.next(0, cur, tid)) return;
    S.a_ready(cur);
    f32x4 acc[2][2][4][2];
#pragma unroll
    for (int a = 0; a < 2; ++a)
#pragma unroll
        for (int b = 0; b < 2; ++b)
#pragma unroll
            for (int m = 0; m < 4; ++m)
#pragma unroll
                for (int n = 0; n < 2; ++n) acc[a][b][m][n] = (f32x4){0.f, 0.f, 0.f, 0.f};
    bf16x8 At[4][2], B0[2][2], B1[2][2];
    G8_STAGE_B(G8_SB(0, 0), cur.B); G8_STAGE_B(G8_SB(0, 1), cur.B + hstep); G8_STAGE_A(G8_SA(0, 0), cur.A, cur.va, 0); G8_STAGE_A(G8_SA(0, 1), cur.A, cur.va, 1);
    if (wr == 1) G8_BAR;
    G8_WAIT_V(2); G8_BAR;
    G8_STAGE_B(G8_SB(1, 0), cur.B + kstep); G8_STAGE_A(G8_SA(1, 0), cur.A + kstep, cur.va, 0); G8_STAGE_B(G8_SB(1, 1), cur.B + hstep + kstep);
    G8_WAIT_V(6); G8_BAR;
    for (;;) {
        const bool has_next = S.next(ui + 1, nxt, tid);
        if (!has_next) nxt = cur;
#pragma unroll 1
        for (int t = 0; t < nt; t += 2) {
            const bool last = (t == nt - 2);
            if (last && has_next) S.a_ready(nxt);
            const char* a1 = cur.A + (size_t)(t + 1) * kstep;
            const char* a2 = last ? nxt.A : cur.A + (size_t)(t + 2) * kstep; const char* b2 = last ? nxt.B : cur.B + (size_t)(t + 2) * kstep;
            const char* a3 = a2 + kstep; const char* b3 = b2 + kstep;
            G8_LDB(B0, 0, 0); G8_LDB(B1, 0, 1); G8_SCHED; G8_LDA(At, 0, 0); G8_STAGE_A(G8_SA(1, 1), a1, cur.va, 1);
            if (GATHER && last) {
#pragma unroll
                for (int h = 0; h < 2; ++h)
#pragma unroll
                    for (int i = 0; i < 2; ++i) cur.va[h][i] = nxt.va[h][i];
            }
            G8_WAIT_V(8); G8_WAIT_L(0); G8_BAR; G8_MMA(0, 0, At, B0); G8_MMA(0, 1, At, B1); G8_BAR; G8_SCHED;
            G8_LDA(At, 0, 1); G8_STAGE_B(G8_SB(0, 0), b2); G8_STAGE_B(G8_SB(0, 1), b2 + hstep); G8_STAGE_A(G8_SA(0, 0), a2, cur.va, 0);
            G8_WAIT_V(8); G8_WAIT_L(0); G8_BAR; G8_MMA(1, 0, At, B0); G8_MMA(1, 1, At, B1); G8_BAR; G8_SCHED;
            G8_LDB(B0, 1, 0); G8_LDB(B1, 1, 1); G8_SCHED; G8_LDA(At, 1, 0); G8_STAGE_A(G8_SA(0, 1), a2, cur.va, 1);
            G8_WAIT_V(8); G8_WAIT_L(0); G8_BAR; G8_MMA(0, 0, At, B0); G8_MMA(0, 1, At, B1); G8_BAR; G8_SCHED;
            G8_LDA(At, 1, 1); G8_STAGE_B(G8_SB(1, 0), b3); G8_STAGE_B(G8_SB(1, 1), b3 + hstep); G8_STAGE_A(G8_SA(1, 0), a3, cur.va, 0);
            G8_WAIT_V(8); G8_WAIT_L(0); G8_BAR; G8_MMA(1, 0, At, B0); G8_MMA(1, 1, At, B1); G8_BAR; G8_SCHED;
        }
        if (wr == 0) G8_BAR;
        bool keep = false;
        { int efr = fr, efq = fq; asm volatile("" : "+v"(efr), "+v"(efq));
          keep = E(acc, cur, wr, wc, efr, efq, lds + STAGE_BYTES); }
        if (!has_next) break;
        if (!keep) {
#pragma unroll
        for (int a = 0; a < 2; ++a)
#pragma unroll
            for (int b = 0; b < 2; ++b)
#pragma unroll
                for (int m = 0; m < 4; ++m)
#pragma unroll
                    for (int n = 0; n < 2; ++n) acc[a][b][m][n] = (f32x4){0.f, 0.f, 0.f, 0.f};
        }
        cur = nxt; ++ui;
        if (wr == 1) G8_BAR;
    }
    G8_WAIT_V(0);
    G8_BAR;
#undef G8_SA
#undef G8_SB
#undef G8_GLDS
#undef G8_STAGE_A
#undef G8_STAGE_B
#undef G8_LDA
#undef G8_LDB
#undef G8_MMA
#undef G8_WAIT_V
#undef G8_WAIT_L
#undef G8_BAR
#undef G8_SCHED
}
}
constexpr int GX_OFF = g8::STAGE_BYTES;

#define FOR_ACC(ai, bj, m, n) \
    _Pragma("unroll") for (int ai = 0; ai < 2; ++ai) _Pragma("unroll") for (int bj = 0; bj < 2; ++bj) \
    _Pragma("unroll") for (int m = 0; m < 4; ++m) _Pragma("unroll") for (int n = 0; n < 2; ++n)
__device__ __forceinline__ int vcu_id() { const int G = gridDim.x, bx = blockIdx.x; return (G % 8 == 0) ? (bx % 8) * (G / 8) + bx / 8 : bx; }

struct P1Sched {
    __device__ __forceinline__ void a_ready(const g8::Unit&) const {}
    g8::TileOrder T; const char* U; const char* W;
    __device__ __forceinline__ bool next(int i, g8::Unit& u, int) const {
        int pm, pn; if (!T.tile(i, pm, pn)) return false;
        u.A = U + (size_t)pm * 256 * 1024 * 2; u.B = W + (size_t)pn * 256 * 1024 * 2; u.i0 = pm; u.i1 = pn; return true;
    }
};
struct P1Epi {
    const Params* pp;
    __device__ __forceinline__ bool operator()(f32x4 (&acc)[2][2][4][2], const g8::Unit& u, int wr, int wc, int fr, int fq, LAS char* xl) const {
        const Params& p = *pp;
        bf16_t* Q = (bf16_t*)(p.ws + WS_Q); bf16_t* C = (bf16_t*)(p.ws + WS_C); bf16_t* IQ = (bf16_t*)(p.ws + WS_IQ); bf16_t* IK = (bf16_t*)(p.ws + WS_IK);
        float* IW = (float*)(p.ws + WS_IW); bf16_t* PV = (bf16_t*)(p.ws + WS_PV); bf16_t* GT = (bf16_t*)(p.ws + WS_GATES);
        const int pm = u.i0, pn = u.i1;
        const int rowb = pm * 256 + wr * 64 + fr, colb = wc * 32 + 4 * fq;
        if (pn < 2) {
            FOR_ACC(ai, bj, m, n) st4bf(Q + (size_t)(rowb + ai * 128 + m * 16) * 512 + pn * 256 + bj * 128 + colb + n * 16, acc[ai][bj][m][n]);
        } else if (pn == 2) {
            LAS float* part = (LAS float*)xl;
#pragma unroll
            for (int ai = 0; ai < 2; ++ai)
#pragma unroll
                for (int m = 0; m < 4; ++m) {
                    float s = 0.f;
#pragma unroll
                    for (int n = 0; n < 2; ++n) { const f32x4 v = acc[ai][0][m][n]; s += v[0] * v[0] + v[1] * v[1] + v[2] * v[2] + v[3] * v[3]; }
                    s += __shfl_xor(s, 16); s += __shfl_xor(s, 32);
                    if (fq == 0) part[(ai * 128 + wr * 64 + m * 16 + fr) * 4 + wc] = s;
                }
            __syncthreads();
#pragma unroll
            for (int ai = 0; ai < 2; ++ai)
#pragma unroll
                for (int m = 0; m < 4; ++m) {
                    const int lr = ai * 128 + wr * 64 + m * 16 + fr;
                    const f32x4 ps = *(LAS f32x4*)(part + lr * 4);
                    const float rstd = rsqrtf((ps[0] + ps[1] + ps[2] + ps[3]) * (1.f / 128.f) + EPS);
                    const size_t R = (size_t)(rowb + ai * 128 + m * 16);
#pragma unroll
                    for (int n = 0; n < 2; ++n) {
                        const f32x4 g = *(const f32x4*)(p.kv_norm_g + colb + n * 16);
                        st4bf(C + R * 128 + colb + n * 16, acc[ai][0][m][n] * rstd * g);
                        st4bf(IQ + R * 256 + colb + n * 16, acc[ai][1][m][n]);
                    }
                }
            __syncthreads();
        } else if (pn == 3) {
#pragma unroll
            for (int ai = 0; ai < 2; ++ai)
#pragma unroll
                for (int m = 0; m < 4; ++m) {
                    const size_t R = (size_t)(rowb + ai * 128 + m * 16);
#pragma unroll
                    for (int n = 0; n < 2; ++n) {
                        st4bf(IQ + R * 256 + 128 + colb + n * 16, acc[ai][0][m][n]);
                        if (wc == 0) st4bf(IK + R * 32 + n * 16 + 4 * fq, acc[ai][1][m][n]);
                        if (wc == 1 && n == 0 && fq < 2) *(f32x4*)(IW + R * 8 + 4 * fq) = acc[ai][1][m][n] * IDX_SCALE;
                    }
                }
        } else if (pn < 6) {
            FOR_ACC(ai, bj, m, n) st4bf(PV + (size_t)(rowb + ai * 128 + m * 16) * 512 + (pn - 4) * 256 + bj * 128 + colb + n * 16, acc[ai][bj][m][n]);
        } else {
            FOR_ACC(ai, bj, m, n) {
                f32x4 v = acc[ai][bj][m][n];
#pragma unroll
                for (int r = 0; r < 4; ++r) v[r] = __builtin_amdgcn_rcpf(1.f + __expf(-v[r]));
                st4bf(GT + (size_t)(rowb + ai * 128 + m * 16) * 2048 + (pn - 6) * 256 + bj * 128 + colb + n * 16, v);
            }
        }
            return false;
    }
};
__device__ __forceinline__ void p1_phase(const Params& p, LAS char* lds) {
    P1Sched S; S.T.init(MPAD / 256, INP / 256, gridDim.x, blockIdx.x); S.U = (const char*)(p.ws + WS_U); S.W = (const char*)(p.ws + WS_WIN);
    P1Epi E{&p};
    g8::gemm_phase<P1Epi, P1Sched, false>(lds, 1024, S, E);
}
constexpr int SC_STRIDE = 2068;
constexpr int SC_BYTES = 16 * SC_STRIDE * 4;
constexpr int MASK_OFF = SC_BYTES;
constexpr int QS_STRIDE = 136;
constexpr float DEFER_THR = 6.0f;

__device__ __forceinline__ int kv_off(int row, int ch) { return 256 * row + 16 * (ch ^ (((row & 3) << 2) | ((row >> 2) & 3))); }
__device__ __forceinline__ unsigned f2ord(float f) { const unsigned u = __float_as_uint(f); return (u & 0x80000000u) ? ~u : (u | 0x80000000u); }
__device__ __forceinline__ int wave_sum_dpp(int v) {
    v += __builtin_amdgcn_update_dpp(0, v, 0x111, 0xf, 0xf, false);
    v += __builtin_amdgcn_update_dpp(0, v, 0x112, 0xf, 0xf, false);
    v += __builtin_amdgcn_update_dpp(0, v, 0x114, 0xf, 0xf, false);
    v += __builtin_amdgcn_update_dpp(0, v, 0x118, 0xf, 0xf, false);
    v += __builtin_amdgcn_update_dpp(0, v, 0x142, 0xa, 0xf, false);
    v += __builtin_amdgcn_update_dpp(0, v, 0x143, 0xc, 0xf, false);
    return __builtin_amdgcn_readlane(v, 63);
}

__device__ __forceinline__ float wave_sum_dpp_f(float v) {
    v += __int_as_float(__builtin_amdgcn_update_dpp(0, __float_as_int(v), 0x111, 0xf, 0xf, false));
    v += __int_as_float(__builtin_amdgcn_update_dpp(0, __float_as_int(v), 0x112, 0xf, 0xf, false));
    v += __int_as_float(__builtin_amdgcn_update_dpp(0, __float_as_int(v), 0x114, 0xf, 0xf, false));
    v += __int_as_float(__builtin_amdgcn_update_dpp(0, __float_as_int(v), 0x118, 0xf, 0xf, false));
    v += __int_as_float(__builtin_amdgcn_update_dpp(0, __float_as_int(v), 0x142, 0xa, 0xf, false));
    v += __int_as_float(__builtin_amdgcn_update_dpp(0, __float_as_int(v), 0x143, 0xc, 0xf, false));
    return __int_as_float(__builtin_amdgcn_readlane(__float_as_int(v), 63));
}

__device__ __forceinline__ void attn_item(const Params& p, int b, int j, int half, LAS char* lds) {
    int tid_ = threadIdx.x; asm volatile("" : "+v"(tid_));
    const int tid = tid_, wid = __builtin_amdgcn_readfirstlane(tid >> 6), lane = tid & 63, fr = lane & 15, fq = lane >> 4;
    const int nadm = 16 + 64 * j;
    const int t0 = 16 + 64 * (j - 1) + 32 * half;
    const size_t Rq0 = (size_t)b * TT + t0, Rk0 = (size_t)b * TT;
    const bf16_t* Q = (const bf16_t*)(p.ws + WS_Q); const bf16_t* C = (const bf16_t*)(p.ws + WS_C); const bf16_t* IQ = (const bf16_t*)(p.ws + WS_IQ);
    const bf16_t* IK = (const bf16_t*)(p.ws + WS_IK); const float* IW = (const float*)(p.ws + WS_IW);
    LAS unsigned* maskw = (LAS unsigned*)(lds + MASK_OFF);
    const int h = wid;

    MEAS_T0(21)
    {
        const bf16_t* Wuk = (const bf16_t*)(p.ws + WS_WUK) + (size_t)h * 128 * 64;
        bf16x8 bq[2][2];
#pragma unroll
        for (int qt = 0; qt < 2; ++qt)
#pragma unroll
            for (int ks = 0; ks < 2; ++ks) bq[qt][ks] = *(const bf16x8*)(Q + (Rq0 + qt * 16 + fr) * 512 + h * 64 + ks * 32 + fq * 8);
        LAS bf16_t* qs = (LAS bf16_t*)lds + (size_t)h * 32 * QS_STRIDE;
#pragma unroll
        for (int ct = 0; ct < 8; ++ct) {
            const bf16x8 a0 = *(const bf16x8*)(Wuk + (ct * 16 + fr) * 64 + fq * 8), a1 = *(const bf16x8*)(Wuk + (ct * 16 + fr) * 64 + 32 + fq * 8);
#pragma unroll
            for (int qt = 0; qt < 2; ++qt) {
                f32x4 d = {0.f, 0.f, 0.f, 0.f};
                d = mfma16(a0, bq[qt][0], d); d = mfma16(a1, bq[qt][1], d);
                d = d * (ATTN_SCALE * LOG2E);
                u32x2 o; o.x = cvt_pk_bf16(d[0], d[1]); o.y = cvt_pk_bf16(d[2], d[3]);
                *(LAS u32x2*)(qs + (qt * 16 + fr) * QS_STRIDE + ct * 16 + 4 * fq) = o;
            }
        }
    }
    __syncthreads();
    bf16x8 qf[8];
    {
        const LAS bf16_t* qs = (const LAS bf16_t*)lds + (size_t)h * 32 * QS_STRIDE + (lane & 31) * QS_STRIDE + (lane >> 5) * 8;
#pragma unroll
        for (int ks = 0; ks < 8; ++ks) qf[ks] = *(const LAS bf16x8*)(qs + ks * 16);
    }
    __syncthreads();

    MEAS_T1(21, p.ws)
    MEAS_T0(22)
    if (nadm <= 256) {
        for (int idx = tid; idx < 32 * 66; idx += 512) {
            const int w = idx % 66; const int lo = w * 32;
            unsigned v = 0u;
            if (lo + 32 <= nadm) v = 0xffffffffu; else if (lo < nadm) v = (1u << (nadm - lo)) - 1u;
            maskw[idx] = v;
        }
    } else {
        LAS float* sc = (LAS float*)lds;
        const int nkt = nadm >> 4;
        const int ni = (nadm + 63) >> 6;
#pragma unroll 1
        for (int sub = 0; sub < 2; ++sub) {
            MEAS_T0(25)
            {
                bf16x8 bq[8]; float wq[8];
                const size_t Rq = Rq0 + sub * 16 + fr;
#pragma unroll
                for (int hh = 0; hh < 8; ++hh) { bq[hh] = *(const bf16x8*)(IQ + Rq * 256 + hh * 32 + fq * 8); }
                { const f32x4 w0 = *(const f32x4*)(IW + Rq * 8), w1 = *(const f32x4*)(IW + Rq * 8 + 4);
                  wq[0] = w0[0]; wq[1] = w0[1]; wq[2] = w0[2]; wq[3] = w0[3]; wq[4] = w1[0]; wq[5] = w1[1]; wq[6] = w1[2]; wq[7] = w1[3]; }
                const bf16_t* ikp = IK + (Rk0 + fr) * 32 + fq * 8;
#pragma unroll 1
                for (int kb = wid; kb < nkt; kb += 64) {
                    bf16x8 a[8];
#pragma unroll
                    for (int i = 0; i < 8; ++i) { const int kt = kb + 8 * i; a[i] = *(const bf16x8*)(ikp + (size_t)(kt < nkt ? kt : kb) * 16 * 32); }
#pragma unroll
                    for (int i = 0; i < 8; ++i) {
                        const int kt = kb + 8 * i;
                        if (kt < nkt) {
                            f32x4 s = {0.f, 0.f, 0.f, 0.f};
#pragma unroll
                            for (int hh = 0; hh < 8; ++hh) {
                                f32x4 d = {0.f, 0.f, 0.f, 0.f};
                                d = mfma16(a[i], bq[hh], d);
#pragma unroll
                                for (int r = 0; r < 4; ++r) { const int di = __float_as_int(d[r]); s[r] += __int_as_float(di > 0 ? di : 0) * wq[hh]; }
                            }
                            *(LAS f32x4*)(sc + fr * SC_STRIDE + kt * 16 + 4 * fq) = s;
                        }
                    }
                }
            }
            __syncthreads();
            MEAS_T1(25, p.ws)
            MEAS_T0(26)
#pragma unroll 1
            for (int qq = 0; qq < 2; ++qq) {
                const int ql = 2 * wid + qq;
                LAS unsigned* mrow = maskw + (sub * 16 + ql) * 66;
                int nadm_q = nadm; asm volatile("" : "+s"(nadm_q));
                const float NEG_BIG = -9223372036854775808.f;
                f32x2 sp[17];
#pragma unroll
                for (int i = 0; i < 34; ++i) {
                    const int k = lane + 64 * i;
                    float x = NEG_BIG;
                    if (i < 33) { const float sx = sc[ql * SC_STRIDE + k] + 0.f; x = (k < nadm_q) ? sx : NEG_BIG; }
                    sp[i >> 1][i & 1] = x;
                }
                const int npair = (ni + 1) >> 1;
                const f32x2 Hp = {18446744073709551616.f, 18446744073709551616.f};
#define COUNT_GE(cnd_, out_) do { const unsigned cq_ = (cnd_); \
                    if (cq_ >= 0xDE800000u) (out_) = 0; else if (cq_ <= 0x217FFFFFu) (out_) = nadm; else { \
                        const float t_ = __uint_as_float((cq_ & 0x80000000u) ? (cq_ & 0x7fffffffu) : ~cq_); \
                          \
                        const float hs_ = (__builtin_fabsf(t_) < 9.094947e-13f) ? 8.507059e37f : 18446744073709551616.f; const float th_ = t_ * hs_; \
                        f32x2 hp_; hp_[0] = __int_as_float(__builtin_amdgcn_readfirstlane(__float_as_int(hs_))); hp_[1] = hp_[0]; \
                        const f32x2 tv_ = {th_, th_}; f32x2 acc_ = {0.f, 0.f}; \
                        _Pragma("unroll") for (int g_ = 0; g_ < 17; g_ += 4) if (g_ < npair) { \
                            _Pragma("unroll") for (int p_ = g_; p_ < g_ + 4 && p_ < 17; ++p_) { f32x2 x_; \
                                asm("v_pk_fma_f32 %0, %1, %2, %3 op_sel_hi:[1,0,1] neg_lo:[1,0,0] neg_hi:[1,0,0] clamp" : "=v"(x_) : "v"(sp[p_]), "s"(hp_), "v"(tv_)); acc_ += x_; } } \
                        const int grp_ = (npair + 3) >> 2; const int tot_ = (grp_ * 4 < 17 ? grp_ * 4 : 17) * 128; \
                        (out_) = tot_ - (int)wave_sum_dpp_f(acc_[0] + acc_[1]); } } while (0)
                unsigned prefix = 0u; bool exact = false, force_fb = false;
#pragma unroll 1
                for (int bit = 31; bit >= 0; --bit) {
                    const unsigned cand = prefix | (1u << bit);
                    if (cand > 0x80000000u && cand < 0x80800000u) {
                        int cd = 0;
#pragma unroll
                        for (int i = 0; i < 33; ++i) { const float sx = sp[i >> 1][i & 1]; cd += (sx > 0.f && sx < 1.17549435e-38f) ? 1 : 0; }
                        force_fb = wave_sum_dpp(cd) != 0;
                        break;
                    }
                    int c; COUNT_GE(cand, c);
                    if (c >= 256) prefix = cand;
                    if (c == 256) { exact = true; break; }
                }
#undef COUNT_GE
                const float tf = __uint_as_float((prefix & 0x80000000u) ? (prefix & 0x7fffffffu) : ~prefix);
                int mlo = 0, mhi = 0, nsel = 0;
                if (exact) {
#pragma unroll
                    for (int g = 0; g < 33; g += 8)
                        if (g < ni) {
#pragma unroll
                            for (int i = g; i < g + 8 && i < 33; ++i) {
                                const unsigned long long bs = __ballot(sp[i >> 1][i & 1] >= tf);
                                nsel += __popcll(bs);
                                mlo = (lane == i) ? (int)(unsigned)bs : mlo; mhi = (lane == i) ? (int)(unsigned)(bs >> 32) : mhi;
                            }
                        }
                } else {
                    int cg = 0;
#pragma unroll
                    for (int i = 0; i < 33; ++i) cg += __popcll(__ballot(sp[i >> 1][i & 1] > tf));
                    const int need = 256 - cg;
                    int running = 0;
                    const unsigned long long lt = (1ull << lane) - 1ull;
#pragma unroll
                    for (int i = 0; i < 33; ++i) {
                        const float sx = sp[i >> 1][i & 1];
                        const bool eq = sx == tf;
                        const unsigned long long be = __ballot(eq);
                        const int rank = running + __popcll(be & lt);
                        const bool sel = (sx > tf) || (eq && rank < need);
                        running += __popcll(be);
                        const unsigned long long bs = __ballot(sel);
                        nsel += __popcll(bs);
                        mlo = (lane == i) ? (int)(unsigned)bs : mlo; mhi = (lane == i) ? (int)(unsigned)(bs >> 32) : mhi;
                        __builtin_amdgcn_sched_barrier(0);
                    }
                }
                if (lane < 33) { u32x2 mw; mw.x = (unsigned)mlo; mw.y = (unsigned)mhi; *(LAS u32x2*)(mrow + 2 * lane) = mw; }
                if (nsel != 256 || force_fb) {
                    const LAS float* srow = sc + ql * SC_STRIDE;
                    unsigned pf2 = 0u;
#pragma unroll 1
                    for (int bit = 31; bit >= 0; --bit) {
                        const unsigned cnd = pf2 | (1u << bit);
                        int c = 0;
#pragma unroll 1
                        for (int i = 0; i < 33; ++i) { const int k = lane + 64 * i; c += (k < nadm_q && f2ord(srow[k] + 0.f) >= cnd) ? 1 : 0; }
                        c = wave_sum_dpp(c);
                        if (c >= 256) pf2 = cnd;
                    }
                    int cg = 0;
#pragma unroll 1
                    for (int i = 0; i < 33; ++i) { const int k = lane + 64 * i; cg += (k < nadm_q && f2ord(srow[k] + 0.f) > pf2) ? 1 : 0; }
                    const int need = 256 - wave_sum_dpp(cg);
                    int run2 = 0;
                    const unsigned long long lt = (1ull << lane) - 1ull;
#pragma unroll 1
                    for (int i = 0; i < 33; ++i) {
                        const int k = lane + 64 * i; const bool ok = k < nadm_q; const unsigned kk = f2ord(srow[k] + 0.f);
                        const bool eq = ok && kk == pf2;
                        const unsigned long long be = __ballot(eq);
                        const int rank = run2 + __popcll(be & lt);
                        const bool sel = ok && ((kk > pf2) || (eq && rank < need));
                        run2 += __popcll(be);
                        const unsigned long long bs = __ballot(sel);
                        if (lane == 0) { mrow[2 * i] = (unsigned)bs; mrow[2 * i + 1] = (unsigned)(bs >> 32); }
                    }
                }
            }
            MEAS_T1(26, p.ws)
            __syncthreads();
        }
    }
    __syncthreads();

    MEAS_T1(22, p.ws)
    MEAS_T0(23)
    const int ntile = (nadm + 63) >> 6;
    f32x16 O[4];
#pragma unroll
    for (int mt = 0; mt < 4; ++mt)
#pragma unroll
        for (int r = 0; r < 16; ++r) O[mt][r] = 0.f;
    float mrun = 0.f, lrun = 0.f;
    {
        const bf16_t* kvsrc = C + (Rk0 + (tid >> 4)) * 128 + (tid & 15) * 8;
        const int kvdst0 = kv_off(tid >> 4, tid & 15), kvdst1 = kv_off((tid >> 4) + 32, tid & 15);
        u32x4 rr0 = *(const u32x4*)kvsrc, rr1 = *(const u32x4*)(kvsrc + 32 * 128);
        *(LAS u32x4*)(lds + kvdst0) = rr0; *(LAS u32x4*)(lds + kvdst1) = rr1;
        __syncthreads();
        const int hq = lane >> 5, ql = lane & 31;
        const int tg = lane >> 4, ti = lane & 15, tq = ti >> 2, tp = ti & 3;
#pragma unroll 1
        for (int T = 0; T < ntile; ++T) {
            const bool more = T + 1 < ntile;
            if (more) { rr0 = *(const u32x4*)(kvsrc + (size_t)(T + 1) * 64 * 128); rr1 = *(const u32x4*)(kvsrc + (size_t)(T + 1) * 64 * 128 + 32 * 128); }
            LAS char* kb = lds + (T & 1) * 16384;
            const u32x2 mw2 = *(LAS u32x2*)(maskw + ql * 66 + 2 * T);
            const float nm = -mrun;
            f32x16 S[2];
#pragma unroll
            for (int kh = 0; kh < 2; ++kh) {
                const int mw = (int)((kh ? mw2.y : mw2.x) >> (4 * hq));
#pragma unroll
                for (int r = 0; r < 16; ++r) {
                    const unsigned m = (unsigned)__builtin_amdgcn_sbfe(mw, (r & 3) + 8 * (r >> 2), 1);
                    S[kh][r] = __uint_as_float((__float_as_uint(nm) & m) | (0xf149f2cau & ~m));
                }
#pragma unroll
                for (int ks = 0; ks < 8; ++ks) {
                    const bf16x8 a = *(LAS bf16x8*)(kb + kv_off(32 * kh + ql, 2 * ks + hq));
                    S[kh] = mfma32(a, qf[ks], S[kh]);
                }
            }
            float mx = -3e38f;
#pragma unroll
            for (int kh = 0; kh < 2; ++kh)
#pragma unroll
                for (int r = 0; r < 16; r += 2) mx = fmaxf(fmaxf(mx, S[kh][r]), S[kh][r + 1]);
            mx = fmaxf(mx, __shfl_xor(mx, 32));
            if (__any(mx > DEFER_THR)) {
                const float dm = fmaxf(mx, 0.f);
                const float alpha = __builtin_amdgcn_exp2f(-dm);
                lrun *= alpha; mrun += dm;
#pragma unroll
                for (int mt = 0; mt < 4; ++mt)
#pragma unroll
                    for (int r = 0; r < 16; ++r) O[mt][r] *= alpha;
#pragma unroll
                for (int kh = 0; kh < 2; ++kh)
#pragma unroll
                    for (int r = 0; r < 16; ++r) S[kh][r] -= dm;
            }
            float rs0 = 0.f, rs1 = 0.f;
#pragma unroll
            for (int kh = 0; kh < 2; ++kh)
#pragma unroll
                for (int r = 0; r < 16; r += 2) { S[kh][r] = __builtin_amdgcn_exp2f(S[kh][r]); S[kh][r + 1] = __builtin_amdgcn_exp2f(S[kh][r + 1]); rs0 += S[kh][r]; rs1 += S[kh][r + 1]; }
            float rs = rs0 + rs1;
            rs += __shfl_xor(rs, 32);
            lrun += rs;
            bf16x8 pf[4];
#pragma unroll
            for (int s2 = 0; s2 < 4; ++s2) {
                const int kh = s2 >> 1, o = 8 * (s2 & 1);
                u32x4 w;
                w.x = cvt_pk_bf16(S[kh][o + 0], S[kh][o + 1]); w.y = cvt_pk_bf16(S[kh][o + 2], S[kh][o + 3]);
                w.z = cvt_pk_bf16(S[kh][o + 4], S[kh][o + 5]); w.w = cvt_pk_bf16(S[kh][o + 6], S[kh][o + 7]);
                pf[s2] = __builtin_bit_cast(bf16x8, w);
            }
#pragma unroll
            for (int mt = 0; mt < 4; ++mt)
#pragma unroll
                for (int s2 = 0; s2 < 4; ++s2) {
                    const int colb = 32 * mt + 16 * (tg & 1) + 4 * tp;
                    const int row1 = 16 * s2 + 4 * (tg >> 1) + tq;
                    const s16x4 v0 = __builtin_amdgcn_ds_read_tr16_b64_v4i16((LAS s16x4*)(kb + kv_off(row1, colb >> 3) + (colb & 7) * 2));
                    const s16x4 v1 = __builtin_amdgcn_ds_read_tr16_b64_v4i16((LAS s16x4*)(kb + kv_off(row1 + 8, colb >> 3) + (colb & 7) * 2));
                    bf16x8 a; a[0] = v0[0]; a[1] = v0[1]; a[2] = v0[2]; a[3] = v0[3]; a[4] = v1[0]; a[5] = v1[1]; a[6] = v1[2]; a[7] = v1[3];
                    O[mt] = mfma32(a, pf[s2], O[mt]);
                }
            if (more) { LAS char* nb = lds + ((T + 1) & 1) * 16384; *(LAS u32x4*)(nb + kvdst0) = rr0; *(LAS u32x4*)(nb + kvdst1) = rr1; }
            __syncthreads();
        }
    }
    MEAS_T1(23, p.ws)
    MEAS_T0(24)
    {
        const float inv = 1.f / lrun;
        const int hq = lane >> 5, ql = lane & 31;
        LAS bf16_t* os = (LAS bf16_t*)(lds + 32768) + (size_t)h * 32 * QS_STRIDE;
#pragma unroll
        for (int mt = 0; mt < 4; ++mt)
#pragma unroll
            for (int rg = 0; rg < 4; ++rg) {
                u32x2 o; o.x = cvt_pk_bf16(O[mt][4 * rg] * inv, O[mt][4 * rg + 1] * inv); o.y = cvt_pk_bf16(O[mt][4 * rg + 2] * inv, O[mt][4 * rg + 3] * inv);
                *(LAS u32x2*)(os + ql * QS_STRIDE + 32 * mt + 8 * rg + 4 * hq) = o;
            }
        __syncthreads();
        const bf16_t* Wuv = (const bf16_t*)(p.ws + WS_WUV) + (size_t)h * 64 * 128;
        bf16_t* AT = (bf16_t*)(p.ws + WS_ATTN);
        const size_t n0 = (size_t)b * SEQ + (t0 - 16);
        bf16x8 bo[2][4];
#pragma unroll
        for (int qt = 0; qt < 2; ++qt)
#pragma unroll
            for (int ks = 0; ks < 4; ++ks) bo[qt][ks] = *(LAS bf16x8*)(os + (qt * 16 + fr) * QS_STRIDE + ks * 32 + fq * 8);
#pragma unroll
        for (int dt = 0; dt < 4; ++dt) {
            bf16x8 a[4];
#pragma unroll
            for (int ks = 0; ks < 4; ++ks) a[ks] = *(const bf16x8*)(Wuv + (dt * 16 + fr) * 128 + ks * 32 + fq * 8);
#pragma unroll
            for (int qt = 0; qt < 2; ++qt) {
                f32x4 d = {0.f, 0.f, 0.f, 0.f};
#pragma unroll
                for (int ks = 0; ks < 4; ++ks) d = mfma16(a[ks], bo[qt][ks], d);
                st4bf(AT + (n0 + qt * 16 + fr) * 512 + h * 64 + dt * 16 + 4 * fq, d);
            }
        }
    }
    __syncthreads();
    MEAS_T1(24, p.ws)
}

__device__ __forceinline__ void p2_phase(const Params& p, LAS char* lds) {
    const int tid = threadIdx.x;
    {
        const bf16_t* PV = (const bf16_t*)(p.ws + WS_PV); bf16_t* DD = (bf16_t*)(p.ws + WS_DD);
        for (int rc = blockIdx.x; rc < NTOK / 64; rc += gridDim.x) {
            const int n0 = rc * 64, b = n0 >> 11, s0 = n0 & 2047;
            const size_t R0 = (size_t)b * TT + 16 + s0 - 15;
            for (int idx = tid; idx < 79 * 64; idx += 512) *(LAS u32x4*)(lds + idx * 16) = *(const u32x4*)(PV + R0 * 512 + (size_t)idx * 8);
            __syncthreads();
#pragma unroll 1
            for (int it = 0; it < 8; ++it) {
                const int idx = tid + 512 * it, r = idx >> 6, ch8 = idx & 63;
                const int g = ch8 >> 4, w = 2 << g;
                float a[8];
#pragma unroll
                for (int e = 0; e < 8; ++e) a[e] = 0.f;
                const LAS char* src = lds + ((r + 15) * 64 + ch8) * 16;
                const u32x4 self = *(const LAS u32x4*)src;
                for (int i = 0; i < w; ++i) {
                    const u32x4 v = *(const LAS u32x4*)(src - i * 1024);
                    a[0] += bf_lo(v.x); a[1] += bf_hi(v.x); a[2] += bf_lo(v.y); a[3] += bf_hi(v.y); a[4] += bf_lo(v.z); a[5] += bf_hi(v.z); a[6] += bf_lo(v.w); a[7] += bf_hi(v.w);
                }
                const float iw = 1.f / (float)w;
                u32x4 o;
                o.x = cvt_pk_bf16(a[0] * iw - bf_lo(self.x), a[1] * iw - bf_hi(self.x)); o.y = cvt_pk_bf16(a[2] * iw - bf_lo(self.y), a[3] * iw - bf_hi(self.y));
                o.z = cvt_pk_bf16(a[4] * iw - bf_lo(self.z), a[5] * iw - bf_hi(self.z)); o.w = cvt_pk_bf16(a[6] * iw - bf_lo(self.w), a[7] * iw - bf_hi(self.w));
                *(u32x4*)(DD + (size_t)(n0 + r) * 512 + ch8 * 8) = o;
            }
            __syncthreads();
        }
    }
    for (int x = blockIdx.x; x < 256; x += gridDim.x) {
        const int b = x & 7, r = x >> 3;
#pragma unroll 1
        for (int rep = 0; rep < 2; ++rep) attn_item(p, b, rep == 0 ? 32 - (r >> 1) : 1 + (r >> 1), r & 1, lds);
    }
}

__device__ __forceinline__ void wave_arrive(int* cnt) { asm volatile("s_waitcnt vmcnt(0)" ::: "memory"); if ((threadIdx.x & 63) == 0) __hip_atomic_fetch_add(cnt, 1, __ATOMIC_RELAXED, __HIP_MEMORY_SCOPE_AGENT); }
__device__ __forceinline__ void panel_wait(int* cnt, int want) {
    if (__builtin_amdgcn_readfirstlane(threadIdx.x >> 6) == 0) {
        unsigned sp = 0;
        while (__hip_atomic_load(cnt, __ATOMIC_RELAXED, __HIP_MEMORY_SCOPE_AGENT) < want) { __builtin_amdgcn_s_sleep(8); if (++sp > (1u << 21)) break; }
        __builtin_amdgcn_fence(__ATOMIC_ACQUIRE, "agent");
        asm volatile("s_waitcnt vmcnt(0)" ::: "memory");
    }
    __builtin_amdgcn_s_barrier();
}
__device__ __forceinline__ void st8bf_sc1(const __amdgpu_buffer_rsrc_t rsrc, size_t elem_off, f32x4 a, f32x4 b) {
    u32x4 o; o[0] = cvt_pk_bf16(a[0], a[1]); o[1] = cvt_pk_bf16(a[2], a[3]); o[2] = cvt_pk_bf16(b[0], b[1]); o[3] = cvt_pk_bf16(b[2], b[3]);
    __builtin_amdgcn_raw_buffer_store_b128(o, rsrc, (int)(elem_off * 2), 0, 16);
}

struct P3Sched {
    __device__ __forceinline__ void a_ready(const g8::Unit&) const {}
    g8::TileOrder T; const char *AT, *DD, *WA, *WF;
    __device__ __forceinline__ bool next(int i, g8::Unit& u, int) const {
        int pm, pn; if (!T.tile(i >> 1, pm, pn)) return false;
        const int br = i & 1;
        u.A = (br ? DD : AT) + (size_t)pm * 256 * 512 * 2; u.B = (br ? WF : WA) + (size_t)pn * 256 * 512 * 2; u.i0 = pm; u.i1 = pn; u.i2 = br; return true;
    }
};
struct P3Epi {
    const Params* pp;
    __device__ __forceinline__ bool operator()(f32x4 (&acc)[2][2][4][2], const g8::Unit& u, int wr, int wc, int fr, int fq, LAS char*) const {
        const Params& p = *pp;
        const bf16_t* GT = (const bf16_t*)(p.ws + WS_GATES);
        const __amdgpu_buffer_rsrc_t rs = __builtin_amdgcn_make_buffer_rsrc((void*)(p.ws + WS_U), 0, (int)((size_t)NTOK * 1024 * 2), 0x00020000);
        const int rowb = u.i0 * 256 + wr * 64 + fr, colb = u.i1 * 256 + wc * 32 + 8 * fq, br = u.i2;
#pragma unroll
        for (int ai = 0; ai < 2; ++ai)
#pragma unroll
            for (int bj = 0; bj < 2; ++bj)
#pragma unroll
                for (int m = 0; m < 4; ++m) {
                    const int nrow = rowb + ai * 128 + m * 16, col = colb + bj * 128;
                    const size_t R = (size_t)nrow + 16 + 16 * (nrow >> 11);
                    const u32x4 gp = *(const u32x4*)(GT + R * 2048 + 1024 + col);
                    f32x4 v0 = acc[ai][bj][m][0], v1 = acc[ai][bj][m][1];
                    if (br == 0) {
                        const u32x4 ga = *(const u32x4*)(GT + R * 2048 + col);
                        v0[0] *= bf_lo(ga[0]) * __builtin_amdgcn_rcpf(bf_lo(gp[0])); v0[1] *= bf_hi(ga[0]) * __builtin_amdgcn_rcpf(bf_hi(gp[0]));
                        v0[2] *= bf_lo(ga[1]) * __builtin_amdgcn_rcpf(bf_lo(gp[1])); v0[3] *= bf_hi(ga[1]) * __builtin_amdgcn_rcpf(bf_hi(gp[1]));
                        v1[0] *= bf_lo(ga[2]) * __builtin_amdgcn_rcpf(bf_lo(gp[2])); v1[1] *= bf_hi(ga[2]) * __builtin_amdgcn_rcpf(bf_hi(gp[2]));
                        v1[2] *= bf_lo(ga[3]) * __builtin_amdgcn_rcpf(bf_lo(gp[3])); v1[3] *= bf_hi(ga[3]) * __builtin_amdgcn_rcpf(bf_hi(gp[3]));
                        acc[ai][bj][m][0] = v0; acc[ai][bj][m][1] = v1;
                    } else {
                        v0[0] *= bf_lo(gp[0]); v0[1] *= bf_hi(gp[0]); v0[2] *= bf_lo(gp[1]); v0[3] *= bf_hi(gp[1]);
                        v1[0] *= bf_lo(gp[2]); v1[1] *= bf_hi(gp[2]); v1[2] *= bf_lo(gp[3]); v1[3] *= bf_hi(gp[3]);
                        st8bf_sc1(rs, (size_t)nrow * 1024 + col, v0, v1);
                    }
                }
        if (br) wave_arrive((int*)(p.ws + WS_READY3) + u.i0);
        return br == 0;
    }
};
__device__ __forceinline__ void p3_phase(const Params& p, LAS char* lds) {
    P3Sched S; S.T.init(NTOK / 256, 4, gridDim.x, blockIdx.x);
    S.AT = (const char*)(p.ws + WS_ATTN); S.DD = (const char*)(p.ws + WS_DD); S.WA = (const char*)(p.ws + WS_WA); S.WF = (const char*)(p.ws + WS_WF);
    P3Epi E{&p};
    g8::gemm_phase<P3Epi, P3Sched, false, true>(lds, 512, S, E);
}

struct P4Sched {
    g8::TileOrder T; const char *MG, *WO; int* ready3;
    __device__ __forceinline__ void a_ready(const g8::Unit& u) const { panel_wait(ready3 + u.i0, 32); }
    __device__ __forceinline__ bool next(int i, g8::Unit& u, int) const {
        int pm, pn; if (!T.tile(i, pm, pn)) return false;
        u.A = MG + (size_t)pm * 256 * 1024 * 2; u.B = WO + (size_t)pn * 256 * 1024 * 2; u.i0 = pm; u.i1 = pn; return true;
    }
};
struct P4Epi {
    const Params* pp;
    __device__ __forceinline__ bool operator()(f32x4 (&acc)[2][2][4][2], const g8::Unit& u, int wr, int wc, int fr, int fq, LAS char*) const {
        const Params& p = *pp;
        const __amdgpu_buffer_rsrc_t rs = __builtin_amdgcn_make_buffer_rsrc((void*)(p.ws + WS_H2), 0, (int)((size_t)NTOK * 1024 * 2), 0x00020000);
        const int rowb = u.i0 * 256 + wr * 64 + fr, colb = u.i1 * 256 + wc * 32 + 8 * fq;
#pragma unroll
        for (int ai = 0; ai < 2; ++ai)
#pragma unroll
            for (int bj = 0; bj < 2; ++bj)
#pragma unroll
                for (int m = 0; m < 4; ++m) {
                    const size_t off = (size_t)(rowb + ai * 128 + m * 16) * 1024 + colb + bj * 128;
                    st8bf_sc1(rs, off, *(const f32x4*)(p.x + off) + acc[ai][bj][m][0], *(const f32x4*)(p.x + off + 4) + acc[ai][bj][m][1]);
                }
        wave_arrive((int*)(p.ws + WS_READY4) + u.i0);
        return false;
    }
};
__device__ __forceinline__ void p4_phase(const Params& p, LAS char* lds) {
    P4Sched S; S.T.init(NTOK / 256, 4, gridDim.x, blockIdx.x); S.MG = (const char*)(p.ws + WS_U); S.WO = (const char*)(p.ws + WS_WO); S.ready3 = (int*)(p.ws + WS_READY3);
    P4Epi E{&p};
    g8::gemm_phase<P4Epi, P4Sched, false, true>(lds, 1024, S, E);
}

constexpr int P5_USTR = 1032;
constexpr int P5_ULO = 32 * P5_USTR * 2;
constexpr int P5_PART = 2 * P5_ULO;
constexpr int P5_MISC = P5_PART + 4 * 48 * 32 * 4;
__device__ __forceinline__ void p5_phase(const Params& p, LAS char* lds) {
    const int tid = threadIdx.x, wid = __builtin_amdgcn_readfirstlane(tid >> 6), lane = tid & 63, fr0 = lane & 15, fq0 = lane >> 4;
    LAS bf16_t* Uhi = (LAS bf16_t*)lds; LAS bf16_t* Ulo = (LAS bf16_t*)(lds + P5_ULO);
    LAS float* part = (LAS float*)(lds + P5_PART);
    LAS int* lcnt = (LAS int*)(lds + P5_MISC);
    LAS int* lbase = lcnt + 32;
    LAS int* tk_e = lbase + 32;
    LAS int* tk_r = tk_e + 128;
    LAS float* tk_w = (LAS float*)(tk_r + 128);
    bf16_t* U2 = (bf16_t*)(p.ws + WS_U);
    const bf16_t* WRH = (const bf16_t*)(p.ws + WS_WRH); const bf16_t* WRL = (const bf16_t*)(p.ws + WS_WRL);
    int* cnt = (int*)(p.ws + WS_CNT); int* list = (int*)(p.ws + WS_LIST); float* wts = (float*)(p.ws + WS_WTS); int* tokrow = (int*)(p.ws + WS_TOKROW);
    for (int chunk = blockIdx.x; chunk < NTOK / 64; chunk += gridDim.x) {
        panel_wait((int*)(p.ws + WS_READY4) + (chunk >> 2), 32);
        if (tid < 32) lcnt[tid] = 0;
        f32x4 gg[4];
#pragma unroll
        for (int j = 0; j < 4; ++j) gg[j] = *(const f32x4*)(p.norm2_g + j * 256 + lane * 4);
#pragma unroll 1
        for (int pass = 0; pass < 2; ++pass) {
            const int tb0 = chunk * 64 + pass * 32;
            f32x4 v[4][4];
#pragma unroll
            for (int t = 0; t < 4; ++t)
#pragma unroll
                for (int j = 0; j < 4; ++j) { const u32x2 hb = *(const u32x2*)((const bf16_t*)(p.ws + WS_H2) + (size_t)(tb0 + wid * 4 + t) * 1024 + j * 256 + lane * 4);
                    v[t][j] = (f32x4){bf_lo(hb.x), bf_hi(hb.x), bf_lo(hb.y), bf_hi(hb.y)}; }
#pragma unroll
            for (int t = 0; t < 4; ++t) {
                float ss = 0.f;
#pragma unroll
                for (int j = 0; j < 4; ++j) ss += v[t][j][0] * v[t][j][0] + v[t][j][1] * v[t][j][1] + v[t][j][2] * v[t][j][2] + v[t][j][3] * v[t][j][3];
                ss = wave_sum(ss);
                const float rstd = rsqrtf(ss * (1.f / 1024.f) + EPS);
                const int tl = wid * 4 + t;
#pragma unroll
                for (int j = 0; j < 4; ++j) {
                    const f32x4 u = v[t][j] * rstd * gg[j];
                    u32x2 hi; hi.x = cvt_pk_bf16(u[0], u[1]); hi.y = cvt_pk_bf16(u[2], u[3]);
                    u32x2 lo; lo.x = cvt_pk_bf16(u[0] - bf_lo(hi.x), u[1] - bf_hi(hi.x)); lo.y = cvt_pk_bf16(u[2] - bf_lo(hi.y), u[3] - bf_hi(hi.y));
                    *(u32x2*)(U2 + (size_t)(tb0 + tl) * 1024 + j * 256 + lane * 4) = hi;
                    *(LAS u32x2*)(Uhi + tl * P5_USTR + j * 256 + lane * 4) = hi;
                    *(LAS u32x2*)(Ulo + tl * P5_USTR + j * 256 + lane * 4) = lo;
                }
            }
            __syncthreads();
            {
                const int tw = wid & 1, kq = wid >> 1;
                int fr = fr0, fq = fq0; asm volatile("" : "+v"(fr), "+v"(fq));
                f32x4 acc[3];
#pragma unroll
                for (int ot = 0; ot < 3; ++ot) acc[ot] = (f32x4){0.f, 0.f, 0.f, 0.f};
                const LAS bf16_t* bh = Uhi + (tw * 16 + fr) * P5_USTR + kq * 256 + fq * 8;
                const LAS bf16_t* bl = Ulo + (tw * 16 + fr) * P5_USTR + kq * 256 + fq * 8;
                const bf16_t* ah = WRH + (size_t)fr * 1024 + kq * 256 + fq * 8;
                const bf16_t* al = WRL + (size_t)fr * 1024 + kq * 256 + fq * 8;
#pragma unroll 2
                for (int ks = 0; ks < 8; ++ks) {
                    const bf16x8 bhi = *(const LAS bf16x8*)(bh + ks * 32), blo = *(const LAS bf16x8*)(bl + ks * 32);
#pragma unroll
                    for (int ot = 0; ot < 3; ++ot) {
                        const bf16x8 ahi = *(const bf16x8*)(ah + (size_t)ot * 16 * 1024 + ks * 32), alo = *(const bf16x8*)(al + (size_t)ot * 16 * 1024 + ks * 32);
                        acc[ot] = mfma16(ahi, bhi, acc[ot]); acc[ot] = mfma16(alo, bhi, acc[ot]); acc[ot] = mfma16(ahi, blo, acc[ot]);
                    }
                }
#pragma unroll
                for (int ot = 0; ot < 3; ++ot)
#pragma unroll
                    for (int r = 0; r < 4; ++r) part[(kq * 48 + ot * 16 + 4 * fq + r) * 32 + tw * 16 + fr] = acc[ot][r];
            }
            __syncthreads();
            if (tid < 32) {
                float L[36];
                int tq = tid; asm volatile("" : "+v"(tq));
                const LAS float* pt = part + tq;
#pragma unroll
                for (int o = 0; o < 36; ++o) L[o] = (pt[o * 32] + pt[(48 + o) * 32]) + (pt[(96 + o) * 32] + pt[(144 + o) * 32]);
                float gl[4];
#pragma unroll
                for (int g = 0; g < 4; ++g) gl[g] = L[g] + p.b_gr[g];
                int gs = 0; float gm = gl[0];
#pragma unroll
                for (int g = 1; g < 4; ++g) if (gl[g] > gm) { gm = gl[g]; gs = g; }
                float gsum = 0.f;
#pragma unroll
                for (int g = 0; g < 4; ++g) gsum += __expf(gl[g] - gm);
                const float pg = 1.f / gsum;
                float el[8];
#pragma unroll
                for (int e = 0; e < 8; ++e) {
                    const float l0 = L[4 + e] + p.b_er[e], l1 = L[12 + e] + p.b_er[8 + e], l2 = L[20 + e] + p.b_er[16 + e], l3 = L[28 + e] + p.b_er[24 + e];
                    el[e] = gs == 0 ? l0 : (gs == 1 ? l1 : (gs == 2 ? l2 : l3));
                }
                int i1 = 0; float v1 = el[0];
#pragma unroll
                for (int e = 1; e < 8; ++e) if (el[e] > v1) { v1 = el[e]; i1 = e; }
                int i2 = (i1 == 0) ? 1 : 0; float v2 = -INFINITY;
#pragma unroll
                for (int e = 0; e < 8; ++e) if (e != i1 && el[e] > v2) { v2 = el[e]; i2 = e; }
                const float e2 = __expf(v2 - v1), p1 = 1.f / (1.f + e2), p2 = e2 * p1;
                const int tl = pass * 32 + tid, ea = gs * 8 + i1, eb = gs * 8 + i2;
                tk_e[tl * 2] = ea; tk_e[tl * 2 + 1] = eb;
                tk_r[tl * 2] = __hip_atomic_fetch_add(&lcnt[ea], 1, __ATOMIC_RELAXED, __HIP_MEMORY_SCOPE_WORKGROUP); tk_r[tl * 2 + 1] = __hip_atomic_fetch_add(&lcnt[eb], 1, __ATOMIC_RELAXED, __HIP_MEMORY_SCOPE_WORKGROUP);
                tk_w[tl * 2] = pg * p1; tk_w[tl * 2 + 1] = pg * p2;
            }
            __syncthreads();
        }
        if (tid < 32) lbase[tid] = atomicAdd(&cnt[tid], lcnt[tid]);
        __syncthreads();
        if (tid < 128) {
            const int e = tk_e[tid], slot = lbase[e] + tk_r[tid], n = chunk * 64 + (tid >> 1);
            list[e * LISTCAP + slot] = n; wts[e * LISTCAP + slot] = tk_w[tid]; tokrow[n * 2 + (tid & 1)] = e * LISTCAP + slot;
        }
        __syncthreads();
    }
}

__device__ __forceinline__ void moe_tables(const Params& p, LAS int* tb) {
    if (threadIdx.x == 0) {
        const int* cnt = (const int*)(p.ws + WS_CNT);
        int acc = 0;
        for (int e = 0; e < 32; ++e) { const int c = __hip_atomic_load(cnt + e, __ATOMIC_RELAXED, __HIP_MEMORY_SCOPE_AGENT); tb[e] = c; tb[32 + e] = acc; acc += (c + 255) >> 8; }
        tb[64] = acc;
    }
    __syncthreads();
}

struct P6Sched {
    __device__ __forceinline__ void a_ready(const g8::Unit&) const {}
    const LAS int* tb; const char *U2, *W1; const int* list; int G, c, nunits;
    __device__ __forceinline__ bool next(int i, g8::Unit& u, int tid) const {
        const int g = i * G + c; if (g >= nunits) return false;
        int e = 0;
#pragma unroll 1
        for (int q = 1; q < 32; ++q) if (2 * tb[32 + q] <= g) e = q;
        const int nte = tb[33 + e] - tb[32 + e], l = g - 2 * tb[32 + e], pn = l / nte, rt = l - pn * nte, ce = tb[e];
        u.A = U2; u.B = W1 + ((size_t)e * 512 + pn * 256) * 1024 * 2; u.i0 = e; u.i1 = rt; u.i2 = pn; u.i3 = tb[32 + e] + rt;
#pragma unroll
        for (int h = 0; h < 2; ++h)
#pragma unroll
            for (int k = 0; k < 2; ++k) { int sR, sC; g8::stage_rc(tid * 16 + k * 8192, sR, sC); const int slot = rt * 256 + h * 128 + sR; const int tok = slot < ce ? list[e * LISTCAP + slot] : 0; u.va[h][k] = (unsigned)(tok * 1024 + sC) * 2u; }
        return true;
    }
};
struct P6Epi {
    const Params* pp; const LAS int* tb;
    __device__ __forceinline__ bool operator()(f32x4 (&acc)[2][2][4][2], const g8::Unit& u, int wr, int wc, int fr, int fq, LAS char*) const {
        const Params& p = *pp;
        const float* wts = (const float*)(p.ws + WS_WTS);
        const int e = u.i0, rt = u.i1, pn = u.i2, ce = tb[e];
        const size_t rowbase = (size_t)u.i3 * 256;
        const __amdgpu_buffer_rsrc_t rsrc = __builtin_amdgcn_make_buffer_rsrc((void*)(p.ws + WS_HID), 0, (int)((size_t)YROWS * 256 * 2), 0x00020000);
#pragma unroll
        for (int ai = 0; ai < 2; ++ai)
#pragma unroll
            for (int m = 0; m < 4; ++m) {
                const int lr = ai * 128 + wr * 64 + m * 16 + fr, slot = rt * 256 + lr;
                const float w = slot < ce ? wts[e * LISTCAP + slot] : 0.f;
                u32x4 o;
#pragma unroll
                for (int n = 0; n < 2; ++n) {
                    const f32x4 g = acc[ai][0][m][n], uu = acc[ai][1][m][n]; f32x4 hv;
#pragma unroll
                    for (int r = 0; r < 4; ++r) hv[r] = g[r] * __builtin_amdgcn_rcpf(1.f + __expf(-g[r])) * uu[r] * w;
                    o[2 * n] = cvt_pk_bf16(hv[0], hv[1]); o[2 * n + 1] = cvt_pk_bf16(hv[2], hv[3]);
                }
                __builtin_amdgcn_raw_buffer_store_b128(o, rsrc, (int)(((rowbase + lr) * 256 + pn * 128 + wc * 32 + 8 * fq) * 2), 0, 16);
            }
        asm volatile("s_waitcnt vmcnt(0)" ::: "memory");
        if (fr == 0 && fq == 0) __hip_atomic_fetch_add((int*)(p.ws + WS_READY) + u.i3, 1, __ATOMIC_RELAXED, __HIP_MEMORY_SCOPE_AGENT);
            return false;
    }
};
__device__ __forceinline__ void p6_phase(const Params& p, LAS char* lds) {
    LAS int* tb = (LAS int*)(lds + GX_OFF);
    moe_tables(p, tb);
    P6Sched S; S.tb = tb; S.U2 = (const char*)(p.ws + WS_U); S.W1 = (const char*)(p.ws + WS_W1); S.list = (const int*)(p.ws + WS_LIST); S.G = gridDim.x; S.c = vcu_id(); S.nunits = tb[64] * 2;
    P6Epi E{&p, tb};
    g8::gemm_phase<P6Epi, P6Sched, true, true>(lds, 1024, S, E);
}

struct P7Sched {
    const LAS int* tb; const char *HID, *W2; int* ready; int G, c, nunits, nheavy;
    __device__ __forceinline__ void a_ready(const g8::Unit& u) const {
        if (__builtin_amdgcn_readfirstlane(threadIdx.x >> 6) == 0) {
            int* w = ready + u.i0; unsigned sp = 0;
            while (__hip_atomic_load(w, __ATOMIC_RELAXED, __HIP_MEMORY_SCOPE_AGENT) < 16) { __builtin_amdgcn_s_sleep(8); if (++sp > (1u << 21)) break; }
            __builtin_amdgcn_fence(__ATOMIC_ACQUIRE, "agent");
            asm volatile("s_waitcnt vmcnt(0)" ::: "memory");
        }
        __builtin_amdgcn_s_barrier();
    }
    __device__ __forceinline__ bool next(int i, g8::Unit& u, int) const {
        if (c < nheavy) return false;
        const int g = i * (G - nheavy) + (c - nheavy); if (g >= nunits) return false;
        int e = 0;
#pragma unroll 1
        for (int q = 1; q < 32; ++q) if (4 * tb[32 + q] <= g) e = q;
        const int nte = tb[33 + e] - tb[32 + e], l = g - 4 * tb[32 + e], pn = l / nte, rt = l - pn * nte, ti = tb[32 + e] + rt;
        u.A = HID + (size_t)ti * 256 * 256 * 2; u.B = W2 + ((size_t)e * 1024 + pn * 256) * 256 * 2; u.i0 = ti; u.i1 = pn; return true;
    }
};
struct P7Epi {
    const Params* pp;
    __device__ __forceinline__ bool operator()(f32x4 (&acc)[2][2][4][2], const g8::Unit& u, int wr, int wc, int fr, int fq, LAS char*) const {
        bf16_t* Y = (bf16_t*)(pp->ws + WS_Y);
        FOR_ACC(ai, bj, m, n) st4bf(Y + ((size_t)u.i0 * 256 + ai * 128 + wr * 64 + m * 16 + fr) * 1024 + u.i1 * 256 + bj * 128 + wc * 32 + n * 16 + 4 * fq, acc[ai][bj][m][n]);
            return false;
    }
};
__device__ __forceinline__ void p7_phase(const Params& p, LAS char* lds) {
    LAS int* tb = (LAS int*)(lds + GX_OFF);
    moe_tables(p, tb);
    P7Sched S; S.tb = tb; S.HID = (const char*)(p.ws + WS_HID); S.W2 = (const char*)(p.ws + WS_W2); S.ready = (int*)(p.ws + WS_READY); S.G = gridDim.x; S.c = vcu_id(); S.nunits = tb[64] * 4; { const int n6 = tb[64] * 2 - (int)gridDim.x; S.nheavy = n6 < 0 ? 0 : (n6 > (int)gridDim.x / 2 ? (int)gridDim.x / 2 : n6); }
    P7Epi E{&p};
    g8::gemm_phase<P7Epi, P7Sched, false>(lds, 256, S, E);
}

__device__ __forceinline__ void p8_phase(const Params& p, LAS char* lds) {
    const int tid = threadIdx.x, wid = tid >> 6, lane = tid & 63;
    LAS int* tb = (LAS int*)lds;
    moe_tables(p, tb);
    const bf16_t* Y = (const bf16_t*)(p.ws + WS_Y); const bf16_t* H2 = (const bf16_t*)(p.ws + WS_H2); const int* tokrow = (const int*)(p.ws + WS_TOKROW);
    f32x4 g[4];
#pragma unroll
    for (int j = 0; j < 4; ++j) g[j] = *(const f32x4*)(p.final_g + j * 256 + lane * 4);
    const int stride = gridDim.x * 8;
    for (int n0 = blockIdx.x * 8 + wid; n0 < NTOK; n0 += 4 * stride) {
        u32x2 hb[4][4], ya[4][4], yc[4][4]; bool ok[4];
#pragma unroll
        for (int q = 0; q < 4; ++q) {
            const int n = n0 + q * stride; ok[q] = n < NTOK;
            const int nn = ok[q] ? n : n0;
            const int r1 = tokrow[nn * 2], r2 = tokrow[nn * 2 + 1];
            const size_t y1 = (size_t)tb[32 + (r1 >> 14)] * 256 + (r1 & 16383), y2 = (size_t)tb[32 + (r2 >> 14)] * 256 + (r2 & 16383);
#pragma unroll
            for (int j = 0; j < 4; ++j) {
                hb[q][j] = *(const u32x2*)(H2 + (size_t)nn * 1024 + j * 256 + lane * 4);
                ya[q][j] = *(const u32x2*)(Y + y1 * 1024 + j * 256 + lane * 4); yc[q][j] = *(const u32x2*)(Y + y2 * 1024 + j * 256 + lane * 4);
            }
        }
#pragma unroll
        for (int q = 0; q < 4; ++q) {
            f32x4 v[4]; float ss = 0.f;
#pragma unroll
            for (int j = 0; j < 4; ++j) {
                v[j][0] = bf_lo(hb[q][j].x) + bf_lo(ya[q][j].x) + bf_lo(yc[q][j].x); v[j][1] = bf_hi(hb[q][j].x) + bf_hi(ya[q][j].x) + bf_hi(yc[q][j].x);
                v[j][2] = bf_lo(hb[q][j].y) + bf_lo(ya[q][j].y) + bf_lo(yc[q][j].y); v[j][3] = bf_hi(hb[q][j].y) + bf_hi(ya[q][j].y) + bf_hi(yc[q][j].y);
                ss += v[j][0] * v[j][0] + v[j][1] * v[j][1] + v[j][2] * v[j][2] + v[j][3] * v[j][3];
            }
            ss = wave_sum(ss);
            const float rstd = rsqrtf(ss * (1.f / 1024.f) + EPS);
            if (ok[q]) {
#pragma unroll
                for (int j = 0; j < 4; ++j) *(f32x4*)(p.out + (size_t)(n0 + q * stride) * 1024 + j * 256 + lane * 4) = v[j] * rstd * g[j];
            }
        }
    }
}

__global__ void __launch_bounds__(512, 2) fwd_kernel(Params p) {
    extern __shared__ __attribute__((aligned(16))) unsigned char smem[];
    LAS char* lds = (LAS char*)smem;
    volatile LAS unsigned* barw = (volatile LAS unsigned*)(lds + LDS_BARW);
    if (threadIdx.x < 2) barw[threadIdx.x] = 0u;
    __syncthreads();
    XcdBarrier bar; bar.bar = (unsigned*)(p.ws + WS_BAR); bar.x = 0; bar.st = nullptr;
    if (N_LAUNCHES == 1) bar = xcd_barrier_post((unsigned*)(p.ws + WS_BAR), barw);
    const int lo = p.ph_lo, hi = p.ph_hi;
    unsigned long long _kstart = 0; if (MEAS_SEC >= 50 && MEAS_SEC < 60) _kstart = __builtin_amdgcn_s_memtime();
#define MEAS_SEAM(k) if (MEAS_SEC == 50 + (k)) { __builtin_amdgcn_s_waitcnt(0); const unsigned long long _d = __builtin_amdgcn_s_memtime() - _kstart; \
    if (blockIdx.x == MEAS_BLK && threadIdx.x == 0) { unsigned long long* _slot = (unsigned long long*)(p.ws + WS_CNT + 128); if (*_slot == 0ull) *_slot = _d; } }
#define IN(k) (lo <= (k) && (k) < hi)
#define SEAM(k) do { if (IN(k) && IN((k) + 1)) xcd_barrier(bar); } while (0)
#ifndef PH_MASK
#define PH_MASK 0x7ff
#endif
#define HAS(k) ((PH_MASK >> (k)) & 1)
    if (HAS(0) && IN(0)) { MEAS_T0(10) p0_phase(p, lds); MEAS_T1(10, p.ws) if (DUP_PHASE == 0) { xcd_barrier(bar); p0_phase(p, lds); } } SEAM(0); MEAS_SEAM(0)
    if (HAS(1) && IN(1)) { MEAS_T0(11) p1_phase(p, lds); MEAS_T1(11, p.ws) if (DUP_PHASE == 1) { xcd_barrier(bar); p1_phase(p, lds); } } SEAM(1); MEAS_SEAM(1)
    if (HAS(2) && IN(2)) { MEAS_T0(12) p2_phase(p, lds); MEAS_T1(12, p.ws) if (DUP_PHASE == 2) { xcd_barrier(bar); p2_phase(p, lds); } } SEAM(2); MEAS_SEAM(2)
    if (HAS(3) && IN(3)) { MEAS_T0(13) p3_phase(p, lds); MEAS_T1(13, p.ws) if (DUP_PHASE == 3) { xcd_barrier(bar); p3_phase(p, lds); } }   MEAS_SEAM(3)
    if (HAS(4) && IN(4)) { MEAS_T0(14) p4_phase(p, lds); MEAS_T1(14, p.ws) if (DUP_PHASE == 4) { xcd_barrier(bar); p4_phase(p, lds); } }   MEAS_SEAM(4)
    if (HAS(5) && IN(5)) { MEAS_T0(15) p5_phase(p, lds); MEAS_T1(15, p.ws) if (DUP_PHASE == 5) { xcd_barrier(bar); if (blockIdx.x == 0 && threadIdx.x < 32) ((int*)(p.ws + WS_CNT))[threadIdx.x] = 0; xcd_barrier(bar); p5_phase(p, lds); } } SEAM(5); MEAS_SEAM(5)
    if (HAS(6) && IN(6)) { MEAS_T0(16) p6_phase(p, lds); MEAS_T1(16, p.ws) }   MEAS_SEAM(6)
    if (HAS(7) && IN(7)) { MEAS_T0(17) p7_phase(p, lds); MEAS_T1(17, p.ws) if (DUP_PHASE == 7) { xcd_barrier(bar); p7_phase(p, lds); } } SEAM(7); MEAS_SEAM(7)
    if (HAS(8) && IN(8)) { MEAS_T0(18) p8_phase(p, lds); MEAS_T1(18, p.ws) } MEAS_SEAM(8)
    if (MEAS_SEC != 0 && blockIdx.x == 0 && threadIdx.x == 0) {
        const unsigned long long d = *(volatile unsigned long long*)(p.ws + WS_CNT + 128);
        const unsigned long long t0 = __builtin_amdgcn_s_memtime();
        while (__builtin_amdgcn_s_memtime() - t0 < d * MEAS_MULT) __builtin_amdgcn_s_sleep(8);
    }
}

extern "C" void kernel_launch(void* const* d_in, const int* in_sizes, int n_in, void* d_out, int out_size, void* d_ws, size_t ws_size, hipStream_t stream) {
    static int grid = 0;
    if (grid == 0) {
        if (n_in != 21 || ws_size < WS_END) { fprintf(stderr, "kernel_launch: unexpected n_in %d or ws_size %zu (< %zu)\n", n_in, ws_size, (size_t)WS_END); grid = -1; return; }
        int dev = 0, cus = 0;
        if (hipGetDevice(&dev) != hipSuccess || hipDeviceGetAttribute(&cus, hipDeviceAttributeMultiprocessorCount, dev) != hipSuccess) { grid = -1; return; }
        if (hipFuncSetAttribute((const void*)fwd_kernel, hipFuncAttributeMaxDynamicSharedMemorySize, LDS_BYTES) != hipSuccess) { fprintf(stderr, "kernel_launch: hipFuncSetAttribute failed\n"); grid = -1; return; }
        grid = cus;
    }
    if (grid < 0) return;
    (void)hipMemsetAsync((char*)d_ws + WS_BAR, 0, WS_ZERO_BYTES, stream);
#if EXTRA_MEMSET
    (void)hipMemsetAsync((char*)d_ws + WS_BAR, 0, WS_ZERO_BYTES, stream);
#endif
    Params p{};
    const float** f = (const float**)&p;
    for (int i = 0; i < 21; ++i) f[i] = (const float*)d_in[i];
    p.out = (float*)d_out; p.ws = (unsigned char*)d_ws;
    if (N_LAUNCHES == 1) { p.ph_lo = 0; p.ph_hi = NPH; hipLaunchKernelGGL(fwd_kernel, dim3(grid), dim3(512), LDS_BYTES, stream, p); }
    else for (int k = 0; k < NPH; ++k) { p.ph_lo = k; p.ph_hi = k + 1; hipLaunchKernelGGL(fwd_kernel, dim3(grid), dim3(512), LDS_BYTES, stream, p); }
}
```
